# Optimizing an MI355X kernel written in HIP

```python
import jax, jax.numpy as jnp
from jax import lax
import numpy as np


D_MODEL = 2048
BATCH = 1
SEQ = 16384
DEPTH = 2

HEAD_DIM = 128
FOX_WIDTH = D_MODEL // 2
MLSTM_WIDTH = D_MODEL // 2
FOX_HEADS = FOX_WIDTH // HEAD_DIM
MLSTM_HEADS = MLSTM_WIDTH // HEAD_DIM
Q_BLOCK = 128
MLSTM_CHUNK = 64
GATE_SOFTCAP = 15.0
POOL_WINDOWS = (2, 4, 8, 16)
N_POOL_GROUPS = len(POOL_WINDOWS)
POOL_GROUP = D_MODEL // N_POOL_GROUPS
N_GROUPS = 4
EXPERTS_PER_GROUP = 8
N_EXPERTS = N_GROUPS * EXPERTS_PER_GROUP
TOP_K = 2
D_EXPERT = D_MODEL // 2
MOE_BLOCK = 128
RMS_EPS = 1e-6
N_EVEN = (DEPTH + 1) // 2
N_ODD = DEPTH // 2
IN_COLS = 3 * FOX_WIDTH + FOX_HEADS + 3 * MLSTM_WIDTH + 2 * MLSTM_HEADS + MLSTM_WIDTH

kernel_name = 'fox_mlstm_pool_hmoe_hybrid'


def rms_norm(x, g):
    xf = x.astype(jnp.float32)
    y = xf * lax.rsqrt(jnp.mean(xf * xf, axis=-1, keepdims=True) + RMS_EPS)
    return (y * g.astype(jnp.float32)).astype(x.dtype)


def soft_cap(x):
    return GATE_SOFTCAP * jnp.tanh(x / GATE_SOFTCAP)


def forgetting_attention(q, k, v, log_f):
    B, S, H, Dh = q.shape
    nb = S // Q_BLOCK
    scale = Dh ** -0.5
    c = jnp.cumsum(log_f, axis=1)
    c_keys = c.transpose(0, 2, 1)
    qb = jnp.moveaxis(q.reshape(B, nb, Q_BLOCK, H, Dh), 1, 0)
    cb = jnp.moveaxis(c.reshape(B, nb, Q_BLOCK, H), 1, 0)
    kpos = jnp.arange(S)

    def block(args):
        i, q_i, c_i = args
        s = jnp.einsum('bqhd,bkhd->bhqk', q_i, k, preferred_element_type=jnp.float32) * scale
        s = s + c_i.transpose(0, 2, 1)[..., None] - c_keys[:, :, None, :]
        qpos = i * Q_BLOCK + jnp.arange(Q_BLOCK)
        s = jnp.where(kpos[None, :] <= qpos[:, None], s, -jnp.inf)
        p = jax.nn.softmax(s, axis=-1)
        return jnp.einsum('bhqk,bkhd->bqhd', p.astype(v.dtype), v)

    out = lax.map(block, (jnp.arange(nb), qb, cb))
    return jnp.moveaxis(out, 0, 1).reshape(B, S, H, Dh)


def mlstm_chunkwise(q, k, v, i_pre, log_f):
    B, S, H, Dh = q.shape
    L = MLSTM_CHUNK
    nc = S // L

    def to_chunks(a):
        a = a.reshape((B, nc, L, H) + a.shape[3:])
        return jnp.swapaxes(jnp.moveaxis(a, 1, 0), 2, 3)

    qc = to_chunks(q.astype(jnp.float32))
    kc = to_chunks(k.astype(jnp.float32) * (Dh ** -0.5))
    vc = to_chunks(v.astype(jnp.float32))
    ic = to_chunks(i_pre)
    fc = to_chunks(log_f)
    causal = jnp.tril(jnp.ones((L, L), dtype=bool))

    def step(carry, xs):
        C, n, m = carry
        q_c, k_c, v_c, i_c, f_c = xs
        b = jnp.cumsum(f_c, axis=-1)
        log_intra = b[..., :, None] - b[..., None, :] + i_c[..., None, :]
        log_intra = jnp.where(causal, log_intra, -jnp.inf)
        log_inter = b + m[..., None]
        m_t = jnp.maximum(log_inter, jnp.max(log_intra, axis=-1))
        w_intra = jnp.exp(log_intra - m_t[..., None])
        w_inter = jnp.exp(log_inter - m_t)
        qk = jnp.einsum('bhtd,bhsd->bhts', q_c, k_c) * w_intra
        num = (jnp.einsum('bhts,bhsv->bhtv', qk, v_c)
               + w_inter[..., None] * jnp.einsum('bhtd,bhdv->bhtv', q_c, C))
        den = jnp.sum(qk, axis=-1) + w_inter * jnp.einsum('bhtd,bhd->bht', q_c, n)
        h = num / jnp.maximum(jnp.abs(den), jnp.exp(-m_t))[..., None]
        b_last = b[..., -1]
        log_w_state = b_last[..., None] - b + i_c
        m_new = jnp.maximum(b_last + m, jnp.max(log_w_state, axis=-1))
        decay = jnp.exp(b_last + m - m_new)
        w_s = jnp.exp(log_w_state - m_new[..., None])
        C_new = decay[..., None, None] * C + jnp.einsum('bhs,bhsd,bhsv->bhdv', w_s, k_c, v_c)
        n_new = decay[..., None] * n + jnp.einsum('bhs,bhsd->bhd', w_s, k_c)
        return (C_new, n_new, m_new), h

    init = (jnp.zeros((B, H, Dh, Dh), jnp.float32),
            jnp.zeros((B, H, Dh), jnp.float32),
            jnp.zeros((B, H), jnp.float32))
    _, hs = lax.scan(step, init, (qc, kc, vc, ic, fc))
    hs = jnp.moveaxis(jnp.swapaxes(hs, 2, 3), 0, 1)
    return hs.reshape(B, S, H, Dh)


def fox_mlstm_mixer(h, w_in, fox_f_bias, fox_q_gain, fox_k_gain,
                    mlstm_i_bias, mlstm_f_bias, mlstm_out_gain, w_out):
    B, S, _ = h.shape
    proj = jnp.einsum('bsd,dc->bsc', h, w_in)
    sizes = ([FOX_WIDTH] * 3 + [FOX_HEADS] + [MLSTM_WIDTH] * 3
             + [MLSTM_HEADS] * 2 + [MLSTM_WIDTH])
    cuts = np.cumsum(sizes)[:-1].tolist()
    fq, fk, fv, ff, mq, mk, mv, mi, mf, mo = jnp.split(proj, cuts, axis=-1)

    def heads(a, n_heads):
        return a.reshape(B, S, n_heads, HEAD_DIM)

    fq = rms_norm(heads(fq, FOX_HEADS), fox_q_gain)
    fk = rms_norm(heads(fk, FOX_HEADS), fox_k_gain)
    fox_log_f = jax.nn.log_sigmoid(ff.astype(jnp.float32) + fox_f_bias)
    y_fox = forgetting_attention(fq, fk, heads(fv, FOX_HEADS), fox_log_f)
    y_fox = y_fox.reshape(B, S, FOX_WIDTH).astype(h.dtype)

    i_pre = soft_cap(mi.astype(jnp.float32) + mlstm_i_bias)
    m_log_f = jax.nn.log_sigmoid(soft_cap(mf.astype(jnp.float32) + mlstm_f_bias))
    hm = mlstm_chunkwise(heads(mq, MLSTM_HEADS), heads(mk, MLSTM_HEADS),
                         heads(mv, MLSTM_HEADS), i_pre, m_log_f)
    hm = rms_norm(hm, mlstm_out_gain.reshape(MLSTM_HEADS, HEAD_DIM)).reshape(B, S, MLSTM_WIDTH)
    y_mlstm = (jax.nn.sigmoid(mo.astype(jnp.float32)) * hm).astype(h.dtype)

    y = jnp.concatenate([y_fox, y_mlstm], axis=-1)
    return jnp.einsum('bsc,cd->bsd', y, w_out)


def multiscale_pool_mixer(h, pool_w, pool_b, pool_scale):
    B, S, _ = h.shape
    hf = h.astype(jnp.float32)
    cs = jnp.pad(jnp.cumsum(hf, axis=1), ((0, 0), (1, 0), (0, 0)))
    t = jnp.arange(S)
    outs = []
    for g, w in enumerate(POOL_WINDOWS):
        lo, hi = g * POOL_GROUP, (g + 1) * POOL_GROUP
        c = cs[:, :, lo:hi]
        start = jnp.maximum(t + 1 - w, 0)
        window_sum = c[:, 1:] - c[:, start]
        count = (t + 1 - start).astype(jnp.float32)
        pooled = window_sum / count[None, :, None] - hf[:, :, lo:hi]
        outs.append(jnp.einsum('bsc,ce->bse', pooled.astype(h.dtype), pool_w[g]) + pool_b[g])
    return jnp.concatenate(outs, axis=-1) * pool_scale


def hierarchical_moe(h, router_group_w, router_group_b, router_expert_w, router_expert_b,
                     w_gate, w_up, w_down):
    B, S, D = h.shape
    T = B * S
    xt = h.reshape(T, D)
    g_logits = jnp.einsum('td,dg->tg', xt, router_group_w).astype(jnp.float32) + router_group_b
    g_prob = jax.nn.softmax(g_logits, axis=-1)
    g_top, g_sel = lax.top_k(g_logits, 1)
    g_sel = g_sel[:, 0]
    g_w = jnp.take_along_axis(g_prob, g_sel[:, None], axis=-1)[:, 0]
    e_logits = jnp.einsum('td,de->te', xt, router_expert_w).astype(jnp.float32) + router_expert_b
    e_logits = e_logits.reshape(T, N_GROUPS, EXPERTS_PER_GROUP)
    e_in = jnp.take_along_axis(e_logits, g_sel[:, None, None], axis=1)[:, 0]
    top_v, top_i = lax.top_k(e_in, TOP_K)
    combine = g_w[:, None] * jax.nn.softmax(top_v, axis=-1)
    expert_id = g_sel[:, None] * EXPERTS_PER_GROUP + top_i

    n_assign = T * TOP_K
    flat_e = expert_id.reshape(-1)
    flat_tok = jnp.repeat(jnp.arange(T, dtype=jnp.int32), TOP_K)
    flat_w = combine.reshape(-1)
    order = jnp.argsort(flat_e)
    sorted_e = flat_e[order]
    counts = jnp.bincount(flat_e, length=N_EXPERTS)
    padded = (counts + MOE_BLOCK - 1) // MOE_BLOCK * MOE_BLOCK
    starts = jnp.cumsum(counts) - counts
    pends = jnp.cumsum(padded)
    pstarts = pends - padded
    dest = pstarts[sorted_e] + (jnp.arange(n_assign) - starts[sorted_e])
    n_rows = (n_assign + N_EXPERTS * (MOE_BLOCK - 1) + MOE_BLOCK - 1) // MOE_BLOCK * MOE_BLOCK
    n_blocks = n_rows // MOE_BLOCK
    row_tok = jnp.full((n_rows,), T, jnp.int32).at[dest].set(flat_tok[order])
    row_w = jnp.zeros((n_rows,), jnp.float32).at[dest].set(flat_w[order])
    block_e = jnp.clip(jnp.searchsorted(pends, jnp.arange(n_blocks) * MOE_BLOCK, side='right'),
                       0, N_EXPERTS - 1)
    x_pad = jnp.concatenate([xt, jnp.zeros((1, D), xt.dtype)], axis=0)
    xb = x_pad[row_tok].reshape(n_blocks, MOE_BLOCK, D)

    def expert_block(args):
        x_blk, e = args
        a = x_blk @ w_gate[e]
        u = x_blk @ w_up[e]
        return (jax.nn.silu(a) * u) @ w_down[e]

    yb = lax.map(expert_block, (xb, block_e)).reshape(n_rows, D)
    y = jnp.zeros((T + 1, D), jnp.float32).at[row_tok].add(yb.astype(jnp.float32) * row_w[:, None])
    return y[:T].astype(h.dtype).reshape(B, S, D)


def setup_inputs(seed: int = 0) -> dict:
    key = jax.random.key(seed)
    ks = jax.random.split(key, 24)
    f32 = jnp.float32
    D = D_MODEL
    MIX = FOX_WIDTH + MLSTM_WIDTH

    def nrm(k, shape, scale):
        return jax.random.normal(k, shape, f32) * scale

    return {
        'x': nrm(ks[0], (BATCH, SEQ, D), 1.0),
        'norm_mix': 1.0 + nrm(ks[1], (DEPTH, D), 0.05),
        'norm_ffn': 1.0 + nrm(ks[2], (DEPTH, D), 0.05),
        'w_in': nrm(ks[3], (N_EVEN, D, IN_COLS), D ** -0.5),
        'fox_f_bias': jax.random.uniform(ks[4], (N_EVEN, FOX_HEADS), f32, 2.0, 5.0),
        'fox_q_gain': 1.0 + nrm(ks[5], (N_EVEN, HEAD_DIM), 0.05),
        'fox_k_gain': 1.0 + nrm(ks[6], (N_EVEN, HEAD_DIM), 0.05),
        'mlstm_i_bias': nrm(ks[7], (N_EVEN, MLSTM_HEADS), 0.1) - 1.0,
        'mlstm_f_bias': jax.random.uniform(ks[8], (N_EVEN, MLSTM_HEADS), f32, 3.0, 6.0),
        'mlstm_out_gain': 1.0 + nrm(ks[9], (N_EVEN, MLSTM_WIDTH), 0.05),
        'w_out': nrm(ks[10], (N_EVEN, MIX, D), MIX ** -0.5),
        'pool_w': nrm(ks[11], (N_ODD, N_POOL_GROUPS, POOL_GROUP, POOL_GROUP), POOL_GROUP ** -0.5),
        'pool_b': nrm(ks[12], (N_ODD, N_POOL_GROUPS, POOL_GROUP), 0.01),
        'pool_scale': 1.0 + nrm(ks[13], (N_ODD, D), 0.1),
        'router_group_w': nrm(ks[14], (DEPTH, D, N_GROUPS), D ** -0.5),
        'router_group_b': nrm(ks[15], (DEPTH, N_GROUPS), 0.01),
        'router_expert_w': nrm(ks[16], (DEPTH, D, N_EXPERTS), D ** -0.5),
        'router_expert_b': nrm(ks[17], (DEPTH, N_EXPERTS), 0.01),
        'w_gate': nrm(ks[18], (DEPTH, N_EXPERTS, D, D_EXPERT), D ** -0.5),
        'w_up': nrm(ks[19], (DEPTH, N_EXPERTS, D, D_EXPERT), D ** -0.5),
        'w_down': nrm(ks[20], (DEPTH, N_EXPERTS, D_EXPERT, D), D_EXPERT ** -0.5),
    }


def reference(x, norm_mix, norm_ffn, w_in, fox_f_bias, fox_q_gain, fox_k_gain,
              mlstm_i_bias, mlstm_f_bias, mlstm_out_gain, w_out,
              pool_w, pool_b, pool_scale,
              router_group_w, router_group_b, router_expert_w, router_expert_b,
              w_gate, w_up, w_down):
    for layer in range(DEPTH):
        hn = rms_norm(x, norm_mix[layer])
        j = layer // 2
        if layer % 2 == 0:
            mix = fox_mlstm_mixer(hn, w_in[j], fox_f_bias[j], fox_q_gain[j], fox_k_gain[j],
                                  mlstm_i_bias[j], mlstm_f_bias[j], mlstm_out_gain[j], w_out[j])
        else:
            mix = multiscale_pool_mixer(hn, pool_w[j], pool_b[j], pool_scale[j])
        x = x + mix.astype(x.dtype)
        ffn = hierarchical_moe(rms_norm(x, norm_ffn[layer]),
                               router_group_w[layer], router_group_b[layer],
                               router_expert_w[layer], router_expert_b[layer],
                               w_gate[layer], w_up[layer], w_down[layer])
        x = x + ffn.astype(x.dtype)
    return x
```

```cpp
#include <hip/hip_runtime.h>
#include <cstdio>
#include <cstdint>

constexpr int T = 16384, D = 2048, HD = 128, NH = 8;
constexpr int INC = 7192;
constexpr int NPROJ = 7168;
constexpr int NGATE = 24;
constexpr int NEXP = 32, EPG = 8, NGRP = 4, DEXP = 1024, NROUTE = 36;
constexpr int CAP = 16384;
constexpr int MAXTILES = 160, MAXROWS = MAXTILES * 256;
constexpr float RMS_EPS = 1e-6f, SOFTCAP = 15.0f, QK_SCALE = 0.08838834764831845f;

typedef unsigned short bf16_t;
typedef float f32x4 __attribute__((ext_vector_type(4)));
typedef unsigned u32x4 __attribute__((ext_vector_type(4)));
typedef unsigned u32x2 __attribute__((ext_vector_type(2)));

constexpr size_t al256(size_t x) { return (x + 255) & ~(size_t)255; }
constexpr size_t WS_CTL = 0, CTL_BYTES = 1u << 20;
constexpr size_t WS_WG = WS_CTL + CTL_BYTES;
constexpr size_t WS_WR = WS_WG + al256((size_t)NGATE * D * 4);
constexpr size_t WS_WINP = WS_WR + al256((size_t)2 * NROUTE * D * 4);
constexpr size_t WS_WOUT = WS_WINP + al256((size_t)NPROJ * D * 2);
constexpr size_t WS_WPOOL = WS_WOUT + al256((size_t)D * D * 2);
constexpr size_t WS_WGU = WS_WPOOL + al256((size_t)4 * 512 * 512 * 2);
constexpr size_t WS_WD = WS_WGU + al256((size_t)2 * NEXP * 2048 * D * 2);
constexpr size_t WS_HN = WS_WD + al256((size_t)2 * NEXP * D * DEXP * 2);
constexpr size_t WS_GATES = WS_HN + al256((size_t)T * D * 2);
constexpr size_t WS_RPROJ = WS_GATES + al256((size_t)T * NGATE * 4);
constexpr size_t WS_P7 = WS_RPROJ + al256((size_t)T * NROUTE * 4);
constexpr size_t WS_CF = WS_P7 + al256((size_t)56 * T * HD * 2);
constexpr size_t WS_BM = WS_CF + al256((size_t)NH * T * 4);
constexpr size_t WS_IP = WS_BM + al256((size_t)NH * T * 4);
constexpr size_t WS_Y = WS_IP + al256((size_t)NH * T * 4);
constexpr size_t WS_ASGE = WS_Y + al256((size_t)T * D * 2);
constexpr size_t WS_ASGR = WS_ASGE + al256((size_t)T * 2 * 4);
constexpr size_t WS_ASGW = WS_ASGR + al256((size_t)T * 2 * 4);
constexpr size_t WS_CAPT = WS_ASGW + al256((size_t)T * 2 * 4);
constexpr size_t WS_CAPW = WS_CAPT + al256((size_t)NEXP * CAP * 4);
constexpr size_t WS_H = WS_CAPW + al256((size_t)NEXP * CAP * 4);
constexpr size_t WS_YS = WS_H + al256((size_t)MAXROWS * DEXP * 2);
constexpr size_t WS_POOLED = WS_YS + al256((size_t)MAXROWS * D * 2);
constexpr size_t WS_DC = WS_POOLED + al256((size_t)T * D * 2);
constexpr size_t WS_ND = WS_DC + al256((size_t)NH * 64 * HD * HD * 4);
constexpr size_t WS_CST = WS_ND + al256((size_t)NH * 64 * HD * 4);
constexpr size_t WS_NST = WS_CST + al256((size_t)NH * 64 * HD * HD * 2);
constexpr size_t WS_END = WS_NST + al256((size_t)NH * 64 * HD * 4);
static_assert(WS_END <= 2147483648ull, "d_ws map exceeds the guaranteed 2 GiB");
constexpr int CW_CNT = 64;

__device__ __forceinline__ float bf2f(bf16_t v) { return __uint_as_float(((unsigned)v) << 16); }
__device__ __forceinline__ unsigned f2bf(float f) { unsigned u = __float_as_uint(f); return (u + 0x7fffu + ((u >> 16) & 1u)) >> 16; }
__device__ __forceinline__ unsigned pk2(float lo, float hi) { return f2bf(lo) | (f2bf(hi) << 16); }
__device__ __forceinline__ float wave_sum(float v) {
#pragma unroll
    for (int o = 1; o < 64; o <<= 1) v += __shfl_xor(v, o);
    return v;
}
__device__ __forceinline__ float log_sigmoid(float x) { return fminf(x, 0.f) - log1pf(expf(-fabsf(x))); }
__device__ __forceinline__ float soft_cap(float x) { return SOFTCAP * tanhf(x * (1.0f / SOFTCAP)); }
__device__ __forceinline__ float sigmoidf(float x) { return 1.0f / (1.0f + expf(-x)); }

__device__ __forceinline__ void transpose_item(const float* W, int ldn, int col0, bf16_t* WT, int ldk, int row0, int k0, float* scr, int lane) {
#pragma unroll 8
    for (int i = 0; i < 32; ++i) { const int kk = 2 * i + (lane >> 5); scr[kk * 33 + (lane & 31)] = W[(size_t)(k0 + kk) * ldn + col0 + (lane & 31)]; }
    asm volatile("s_waitcnt lgkmcnt(0)" ::: "memory");
    const int c = lane & 7;
#pragma unroll
    for (int j = 0; j < 4; ++j) { const int n = (lane >> 3) + 8 * j; const float* s = scr + (8 * c) * 33 + n;
        u32x4 o; o.x = pk2(s[0 * 33], s[1 * 33]); o.y = pk2(s[2 * 33], s[3 * 33]); o.z = pk2(s[4 * 33], s[5 * 33]); o.w = pk2(s[6 * 33], s[7 * 33]);
        *(u32x4*)(WT + (size_t)(row0 + n) * ldk + k0 + 8 * c) = o; }
    asm volatile("s_waitcnt lgkmcnt(0)" ::: "memory");
}
struct PrepArgs { const float *w_in, *w_out, *pool_w, *w_gate, *w_up, *w_down, *rgw, *rew; unsigned char* ws; };
constexpr int IT_INP = (D / 64) * (NPROJ / 32);
constexpr int IT_OUT = (D / 64) * (D / 32);
constexpr int IT_POOL = 4 * (512 / 64) * (512 / 32);
constexpr int IT_G = (D / 64) * (DEXP / 32);
constexpr int IT_DN = (DEXP / 64) * (D / 32);
constexpr int IT_EXP = 2 * NEXP * (2 * IT_G + IT_DN);
constexpr int IT_TOTAL = IT_INP + IT_OUT + IT_POOL + IT_EXP;
__device__ __forceinline__ void prep_item(const PrepArgs& a, int it, float* scr, int lane) {
    unsigned char* ws = a.ws;
    if (it < IT_INP) {
        const int nblk = NPROJ / 32, kb = it / nblk, nb = it % nblk, n0 = nb * 32, blk = n0 >> 10;
        const int src_off[7] = {0, 1024, 2048, 3080, 4104, 5128, 6168};
        int so = 0;
#pragma unroll
        for (int j = 0; j < 7; ++j) so = (blk == j) ? src_off[j] : so;
        transpose_item(a.w_in, INC, so + (n0 & 1023), (bf16_t*)(ws + WS_WINP), D, n0, kb * 64, scr, lane); return; }
    it -= IT_INP;
    if (it < IT_OUT) { const int nblk = D / 32, kb = it / nblk, nb = it % nblk; transpose_item(a.w_out, D, nb * 32, (bf16_t*)(ws + WS_WOUT), D, nb * 32, kb * 64, scr, lane); return; }
    it -= IT_OUT;
    if (it < IT_POOL) { const int g = it / 128, r = it % 128, kb = r / 16, nb = r % 16;
        transpose_item(a.pool_w + (size_t)g * 512 * 512, 512, nb * 32, (bf16_t*)(ws + WS_WPOOL) + (size_t)g * 512 * 512, 512, nb * 32, kb * 64, scr, lane); return; }
    it -= IT_POOL;
    { const int per = 2 * IT_G + IT_DN, le = it / per; int r = it % per;
        if (r < 2 * IT_G) { const int g = r / IT_G; r %= IT_G; const int nblk = DEXP / 32, kb = r / nblk, nb = r % nblk, n0 = nb * 32;
            const float* W = (g ? a.w_up : a.w_gate) + (size_t)le * D * DEXP;
            transpose_item(W, DEXP, n0, (bf16_t*)(ws + WS_WGU) + (size_t)le * 2048 * D, D, 256 * (n0 >> 7) + 128 * g + (n0 & 127), kb * 64, scr, lane); return; }
        r -= 2 * IT_G;
        { const int nblk = D / 32, kb = r / nblk, nb = r % nblk;
            transpose_item(a.w_down + (size_t)le * DEXP * D, D, nb * 32, (bf16_t*)(ws + WS_WD) + (size_t)le * D * DEXP, DEXP, nb * 32, kb * 64, scr, lane); } }
}
__global__ void __launch_bounds__(256) k_prep(PrepArgs a) {
    __shared__ float scr_all[4][64 * 33];
    const int lane = threadIdx.x & 63, wave = threadIdx.x >> 6;
    const int gw = blockIdx.x * 4 + wave, ngw = gridDim.x * 4;
    for (int it = gw; it < IT_TOTAL; it += ngw) prep_item(a, it, scr_all[wave], lane);
    float* WG = (float*)(a.ws + WS_WG); float* WR = (float*)(a.ws + WS_WR);
    const int gt = blockIdx.x * blockDim.x + threadIdx.x, ngt = gridDim.x * blockDim.x;
    for (int i = gt; i < NGATE * D; i += ngt) { const int c = i / D, k = i % D; const int col = c < 8 ? 3072 + c : 6152 + (c - 8); WG[i] = a.w_in[(size_t)k * INC + col]; }
    for (int i = gt; i < 2 * NROUTE * D; i += ngt) { const int l = i / (NROUTE * D), r = i % (NROUTE * D), c = r / D, k = r % D;
        WR[i] = c < 4 ? a.rgw[((size_t)l * D + k) * NGRP + c] : a.rew[((size_t)l * D + k) * NEXP + (c - 4)]; }
}

template <int NC>
__global__ void __launch_bounds__(256) k_norm_proj(const float* __restrict__ x, const float* __restrict__ g, const float* __restrict__ Wc, bf16_t* __restrict__ hn, float* __restrict__ proj) {
    const int lane = threadIdx.x & 63, row = blockIdx.x * 4 + (threadIdx.x >> 6);
    const f32x4* xr = (const f32x4*)(x + (size_t)row * D) + lane; const f32x4* gr = (const f32x4*)g + lane;
    f32x4 v[8]; float s = 0.f;
#pragma unroll
    for (int j = 0; j < 8; ++j) { v[j] = xr[64 * j]; s += (v[j].x * v[j].x + v[j].y * v[j].y) + (v[j].z * v[j].z + v[j].w * v[j].w); }
    const float rstd = 1.0f / sqrtf(wave_sum(s) * (1.0f / D) + RMS_EPS);
    u32x2* o8 = (u32x2*)(hn + (size_t)row * D) + lane;
#pragma unroll
    for (int j = 0; j < 8; ++j) { const f32x4 gg = gr[64 * j]; v[j] = v[j] * rstd * gg; u32x2 w; w.x = pk2(v[j].x, v[j].y); w.y = pk2(v[j].z, v[j].w); o8[64 * j] = w; }
    for (int c = 0; c < NC; ++c) { const f32x4* wr = (const f32x4*)(Wc + (size_t)c * D) + lane; float a = 0.f;
#pragma unroll
        for (int j = 0; j < 8; ++j) { const f32x4 w = wr[64 * j]; a += (v[j].x * w.x + v[j].y * w.y) + (v[j].z * w.z + v[j].w * w.w); }
        a = wave_sum(a); if (lane == 0) proj[(size_t)row * NC + c] = a; }
}

struct RG { const bf16_t* A; int lda; const bf16_t* Bt; int ldb; int M, N, K;
    int mode;
    void* out; int ldc; const float* res; const float* bias; const float* scale;
    const unsigned* cnt;
    const int* capt; const float* capw; size_t bstride; int moe_gather; };
__device__ __forceinline__ void moe_tile_lookup(const unsigned* cnt, int tile256, int& e, int& lt, int& total) {
    int acc = 0; e = -1; lt = 0;
    for (int i = 0; i < NEXP; ++i) { const int nt = ((int)cnt[i] + 255) >> 8; if (e < 0 && tile256 < acc + nt) { e = i; lt = tile256 - acc; } acc += nt; }
    total = acc;
}
__global__ void __launch_bounds__(256) k_ref_gemm(RG g) {
    __shared__ float As[32][68], Bs[32][68];
    const int tid = threadIdx.x, tx = tid & 15, ty = tid >> 4;
    const int m0 = blockIdx.y * 64, n0 = blockIdx.x * 64;
    const bf16_t* Bt = g.Bt; int e = 0, lt = 0, cnt_e = 0;
    if (g.cnt) { int total; moe_tile_lookup(g.cnt, m0 >> 8, e, lt, total); if (e < 0) return; Bt += (size_t)e * g.bstride; cnt_e = (int)g.cnt[e]; }
    const int lr = tid >> 2, lk = (tid & 3) * 8;
    size_t arow = (size_t)(m0 + lr);
    if (g.cnt && g.moe_gather) { const int rank = lt * 256 + ((m0 & 255) + lr); arow = rank < cnt_e ? (size_t)g.capt[(size_t)e * CAP + rank] : 0; }
    const bf16_t* Ap = g.A + arow * g.lda + lk; const bf16_t* Bp = Bt + (size_t)(n0 + lr) * g.ldb + lk;
    float acc[4][4] = {};
    for (int k0 = 0; k0 < g.K; k0 += 32) {
        const u32x4 av = *(const u32x4*)(Ap + k0), bv = *(const u32x4*)(Bp + k0);
        __syncthreads();
        const unsigned aw[4] = {av.x, av.y, av.z, av.w}, bw[4] = {bv.x, bv.y, bv.z, bv.w};
#pragma unroll
        for (int j = 0; j < 4; ++j) { As[lk + 2 * j][lr] = __uint_as_float(aw[j] << 16); As[lk + 2 * j + 1][lr] = __uint_as_float(aw[j] & 0xffff0000u);
            Bs[lk + 2 * j][lr] = __uint_as_float(bw[j] << 16); Bs[lk + 2 * j + 1][lr] = __uint_as_float(bw[j] & 0xffff0000u); }
        __syncthreads();
#pragma unroll 8
        for (int k = 0; k < 32; ++k) { const f32x4 a = *(const f32x4*)&As[k][ty * 4], b = *(const f32x4*)&Bs[k][tx * 4];
#pragma unroll
            for (int i = 0; i < 4; ++i) { acc[i][0] += a[i] * b[0]; acc[i][1] += a[i] * b[1]; acc[i][2] += a[i] * b[2]; acc[i][3] += a[i] * b[3]; } }
    }
#pragma unroll
    for (int i = 0; i < 4; ++i) { const int m = m0 + ty * 4 + i;
#pragma unroll
        for (int j = 0; j < 4; ++j) { const int n = n0 + tx * 4 + j; const float v = acc[i][j];
            if (g.mode == 0) { ((bf16_t*)g.out)[((size_t)(n >> 7) * T + m) * HD + (n & 127)] = (bf16_t)f2bf(v); }
            else if (g.mode == 1) { ((float*)g.out)[(size_t)m * g.ldc + n] = g.res[(size_t)m * g.ldc + n] + v; }
            else if (g.mode == 2) { ((bf16_t*)g.out)[(size_t)m * g.ldc + n] = (bf16_t)f2bf(v); }
            else if (g.mode == 3) { const int rank = lt * 256 + (m & 255); const float w = rank < cnt_e ? g.capw[(size_t)e * CAP + rank] : 0.f; ((bf16_t*)g.out)[(size_t)m * g.ldc + n] = (bf16_t)f2bf(v * w); }
            else { ((float*)g.out)[(size_t)m * g.ldc + n] = g.res[(size_t)m * g.ldc + n] + (v + g.bias[n]) * g.scale[n]; } } }
}

__global__ void __launch_bounds__(256) k_qknorm(bf16_t* P7, const float* gq, const float* gk) {
    const int lane = threadIdx.x & 63; const size_t row = (size_t)blockIdx.x * 4 + (threadIdx.x >> 6);
    const float* g = (row / T) < 8 ? gq : gk;
    unsigned* p = (unsigned*)(P7 + row * HD) + lane; const unsigned w = *p;
    const float a = __uint_as_float(w << 16), b = __uint_as_float(w & 0xffff0000u);
    const float rstd = 1.0f / sqrtf(wave_sum(a * a + b * b) * (1.0f / HD) + RMS_EPS);
    *p = pk2(a * rstd * g[2 * lane], b * rstd * g[2 * lane + 1]);
}
__global__ void __launch_bounds__(1024) k_gates_scan(const float* gates, const float* fox_fb, const float* m_ib, const float* m_fb, float* CF, float* BM, float* IP) {
    __shared__ float part[1024];
    const int seq = blockIdx.x, h = seq & 7, tid = threadIdx.x; const bool ml = seq >= 8;
    float v[16]; float s = 0.f;
    for (int j = 0; j < 16; ++j) { const int t = tid * 16 + j; float lf;
        if (!ml) lf = log_sigmoid(gates[(size_t)t * NGATE + h] + fox_fb[h]);
        else { lf = log_sigmoid(soft_cap(gates[(size_t)t * NGATE + 16 + h] + m_fb[h])); IP[(size_t)h * T + t] = soft_cap(gates[(size_t)t * NGATE + 8 + h] + m_ib[h]); }
        s += lf; v[j] = s; }
    part[tid] = s; __syncthreads();
    for (int o = 1; o < 1024; o <<= 1) { const float a = tid >= o ? part[tid - o] : 0.f; __syncthreads(); part[tid] += a; __syncthreads(); }
    const float base = tid ? part[tid - 1] : 0.f; float* out = (ml ? BM : CF) + (size_t)h * T;
    for (int j = 0; j < 16; ++j) out[tid * 16 + j] = base + v[j];
}
template <int MODE>
__global__ void __launch_bounds__(256) k_ref_mix(const bf16_t* P7, const float* CB, const float* IP, const float* ogain, bf16_t* Y) {
    const int lane = threadIdx.x & 63; const int gi = blockIdx.x * 4 + (threadIdx.x >> 6); const int h = gi / T, t = gi % T;
    const bf16_t* Q = P7 + (size_t)((MODE ? 24 : 0) + h) * T * HD; const bf16_t* K = P7 + (size_t)((MODE ? 32 : 8) + h) * T * HD; const bf16_t* V = P7 + (size_t)((MODE ? 40 : 16) + h) * T * HD;
    const unsigned qw = ((const unsigned*)(Q + (size_t)t * HD))[lane]; const float q0 = __uint_as_float(qw << 16), q1 = __uint_as_float(qw & 0xffff0000u);
    const float* cb = CB + (size_t)h * T; const float ct = cb[t];
    float o0 = 0.f, o1 = 0.f, l = 0.f, m = -1e30f;
    for (int s = 0; s <= t; ++s) {
        const unsigned kw = ((const unsigned*)(K + (size_t)s * HD))[lane], vw = ((const unsigned*)(V + (size_t)s * HD))[lane];
        const float dot = wave_sum(q0 * __uint_as_float(kw << 16) + q1 * __uint_as_float(kw & 0xffff0000u)) * QK_SCALE;
        const float v0 = __uint_as_float(vw << 16), v1 = __uint_as_float(vw & 0xffff0000u);
        if (MODE == 0) { const float sv = dot + (ct - cb[s]); const float mn = fmaxf(m, sv), al = expf(m - mn), p = expf(sv - mn); o0 = o0 * al + p * v0; o1 = o1 * al + p * v1; l = l * al + p; m = mn; }
        else { const float a = dot * expf(ct - cb[s] + IP[(size_t)h * T + s]); o0 += a * v0; o1 += a * v1; l += a; }
    }
    if (MODE == 0) { const float r = 1.0f / l; ((unsigned*)(Y + (size_t)t * D + h * HD))[lane] = pk2(o0 * r, o1 * r); }
    else { const float r = 1.0f / fmaxf(fabsf(l), 1.0f); const float h0 = o0 * r, h1 = o1 * r;
        const float rstd = 1.0f / sqrtf(wave_sum(h0 * h0 + h1 * h1) * (1.0f / HD) + RMS_EPS);
        const unsigned mw = ((const unsigned*)(P7 + (size_t)(48 + h) * T * HD + (size_t)t * HD))[lane];
        const float g0 = sigmoidf(__uint_as_float(mw << 16)), g1 = sigmoidf(__uint_as_float(mw & 0xffff0000u));
        ((unsigned*)(Y + (size_t)t * D + 1024 + h * HD))[lane] = pk2(g0 * h0 * rstd * ogain[h * HD + 2 * lane], g1 * h1 * rstd * ogain[h * HD + 2 * lane + 1]); }
}
__global__ void __launch_bounds__(256) k_router(const float* rproj, const float* gb, const float* eb, unsigned* cnt, int* asg_e, int* asg_r, float* asg_w, int* capt, float* capw) {
    const int t = blockIdx.x * blockDim.x + threadIdx.x; if (t >= T) return;
    const float* p = rproj + (size_t)t * NROUTE;
    float gl[4]; int gs = 0;
    for (int i = 0; i < 4; ++i) { gl[i] = p[i] + gb[i]; if (gl[i] > gl[gs]) gs = i; }
    float se = 0.f; for (int i = 0; i < 4; ++i) se += expf(gl[i] - gl[gs]);
    const float gw = 1.0f / se;
    float el[8]; for (int i = 0; i < 8; ++i) el[i] = p[4 + gs * 8 + i] + eb[gs * 8 + i];
    int i0 = 0; for (int i = 1; i < 8; ++i) if (el[i] > el[i0]) i0 = i;
    int i1 = -1; for (int i = 0; i < 8; ++i) if (i != i0 && (i1 < 0 || el[i] > el[i1])) i1 = i;
    const float e1 = expf(el[i1] - el[i0]); const float w0 = gw / (1.0f + e1), w1 = gw * e1 / (1.0f + e1);
    const int ex[2] = {gs * 8 + i0, gs * 8 + i1}; const float ww[2] = {w0, w1};
    for (int k = 0; k < 2; ++k) { const int r = (int)atomicAdd(&cnt[ex[k]], 1u); asg_e[t * 2 + k] = ex[k]; asg_r[t * 2 + k] = r; asg_w[t * 2 + k] = ww[k];
        capt[(size_t)ex[k] * CAP + r] = t; capw[(size_t)ex[k] * CAP + r] = ww[k]; }
}
__global__ void __launch_bounds__(256) k_silu_mul(const bf16_t* GU, bf16_t* H, const unsigned* cnt) {
    int tot = 0; for (int i = 0; i < NEXP; ++i) tot += ((int)cnt[i] + 255) >> 8;
    const size_t n = (size_t)tot * 256 * DEXP;
    for (size_t i = (size_t)blockIdx.x * blockDim.x + threadIdx.x; i < n; i += (size_t)gridDim.x * blockDim.x) { const size_t row = i / DEXP; const int j = (int)(i % DEXP);
        const float a = bf2f(GU[row * 2048 + 256 * (j >> 7) + (j & 127)]), u = bf2f(GU[row * 2048 + 256 * (j >> 7) + 128 + (j & 127)]);
        H[i] = (bf16_t)f2bf(a * sigmoidf(a) * u); }
}
__device__ __forceinline__ int moe_row(const unsigned* cnt, int e, int r) { int ts = 0; for (int i = 0; i < e; ++i) ts += ((int)cnt[i] + 255) >> 8; return ts * 256 + r; }
__global__ void __launch_bounds__(256) k_combine(float* xres, const bf16_t* YS, const unsigned* cnt, const int* asg_e, const int* asg_r) {
    const int lane = threadIdx.x & 63, t = blockIdx.x * 4 + (threadIdx.x >> 6);
    const int r0 = moe_row(cnt, asg_e[2 * t], asg_r[2 * t]), r1 = moe_row(cnt, asg_e[2 * t + 1], asg_r[2 * t + 1]);
    for (int j = 0; j < 8; ++j) { const int c = (j * 64 + lane) * 4; f32x4 x = *(f32x4*)(xres + (size_t)t * D + c);
        const u32x2 a = *(const u32x2*)(YS + (size_t)r0 * D + c), b = *(const u32x2*)(YS + (size_t)r1 * D + c);
        x.x += __uint_as_float(a.x << 16) + __uint_as_float(b.x << 16); x.y += __uint_as_float(a.x & 0xffff0000u) + __uint_as_float(b.x & 0xffff0000u);
        x.z += __uint_as_float(a.y << 16) + __uint_as_float(b.y << 16); x.w += __uint_as_float(a.y & 0xffff0000u) + __uint_as_float(b.y & 0xffff0000u);
        *(f32x4*)(xres + (size_t)t * D + c) = x; }
}
__global__ void __launch_bounds__(256) k_rstd(const float* x, float* rstd) {
    const int lane = threadIdx.x & 63, row = blockIdx.x * 4 + (threadIdx.x >> 6); const f32x4* xr = (const f32x4*)(x + (size_t)row * D) + lane; float s = 0.f;
    for (int j = 0; j < 8; ++j) { const f32x4 v = xr[64 * j]; s += (v.x * v.x + v.y * v.y) + (v.z * v.z + v.w * v.w); }
    s = wave_sum(s); if (lane == 0) rstd[row] = 1.0f / sqrtf(s * (1.0f / D) + RMS_EPS);
}
__global__ void __launch_bounds__(256) k_pool(const float* x, const float* rstd, const float* g, bf16_t* pooled) {
    const size_t i = (size_t)blockIdx.x * blockDim.x + threadIdx.x; const int t = (int)(i / (D / 4)), c = (int)(i % (D / 4)) * 4;
    const int w = 2 << (c >> 9); const int start = t + 1 - w > 0 ? t + 1 - w : 0; const f32x4 gg = *(const f32x4*)(g + c);
    f32x4 s = {0.f, 0.f, 0.f, 0.f}, self = s;
    for (int u = start; u <= t; ++u) { const f32x4 v = *(const f32x4*)(x + (size_t)u * D + c) * rstd[u] * gg; s += v; if (u == t) self = v; }
    const float inv = 1.0f / (float)(t + 1 - start); const f32x4 p = s * inv - self;
    u32x2 o; o.x = pk2(p.x, p.y); o.y = pk2(p.z, p.w); *(u32x2*)(pooled + (size_t)t * D + c) = o;
}

namespace pg {
#define LAS __attribute__((address_space(3)))
typedef short bf16x8 __attribute__((ext_vector_type(8)));
constexpr int BM = 256, BK = 64, HALF = 128, HTB = HALF * BK * 2, STAGE_BYTES = 8 * HTB, NXCD = 8, WGM = 8;
__host__ __device__ __forceinline__ int lds_byte(int r, int c) { const int st = (r >> 4) * 2 + (c >> 5), rr = r & 15, cc = c & 31, ob = rr * 64 + cc * 2; return st * 1024 + (ob ^ (((ob >> 9) & 1) << 5)); }
__host__ __device__ __forceinline__ void stage_rc(int b, int& R, int& C) { const int st = b / 1024, sb = b % 1024, swz = sb ^ (((sb >> 9) & 1) << 5); R = (st >> 1) * 16 + swz / 64; C = (st & 1) * 32 + (swz % 64) / 2; }
__host__ __device__ __forceinline__ int perm32(int rho) { const int n = rho >> 4, i = rho & 15; return 8 * (i >> 2) + 4 * n + (i & 3); }
__device__ __forceinline__ unsigned cvt_pk_bf16(float lo, float hi) { unsigned r; asm volatile("v_cvt_pk_bf16_f32 %0, %1, %2" : "=v"(r) : "v"(lo), "v"(hi)); return r; }

struct Unit { int pm, pn, ak; };
struct Gemm { const bf16_t* A; const bf16_t* Bt; int lda, ldb, K; };
__device__ __forceinline__ int xcd_remap(int L, int nwg) { const int q = nwg / NXCD, r = nwg % NXCD, xcd = L % NXCD, off = L / NXCD; return (xcd < r ? xcd * (q + 1) : r * (q + 1) + (xcd - r) * q) + off; }
struct StaticOrder {
    int nM, nN, nwg, G, c, akdiv;
    __device__ void init(int M, int N, int G_, int c_, int akdiv_ = 0) { nM = M / BM; nN = N / BM; nwg = nM * nN; G = G_; c = c_; akdiv = akdiv_; }
    __device__ bool next(int i, Unit& u) const {
        const long L = (long)i * G + c; if (L >= nwg) return false;
        const int wgid = xcd_remap((int)L, nwg);
        const int nig = WGM * nN, gid = wgid / nig, fm = gid * WGM, gsz = (nM - fm) < WGM ? (nM - fm) : WGM;
        u.pm = fm + ((wgid % nig) % gsz); u.pn = (wgid % nig) / gsz; u.ak = akdiv ? (u.pn / akdiv) * 512 : 0; return true;
    }
};
struct MoeOrder {
    int nwg, G, c; const LAS int* tileE;
    __device__ bool next(int i, Unit& u) const {
        const long L = (long)i * G + c; if (L >= nwg) return false;
        const int wgid = xcd_remap((int)L, nwg); const int ti = wgid >> 3;
        u.pm = ti; u.pn = tileE[ti] * 8 + (wgid & 7); u.ak = 0; return true;
    }
};
struct EpiP7 {
    static constexpr bool PERM = true; bf16_t* P7;
    __device__ __forceinline__ void operator()(const f32x4 (&acc)[2][2][4][2], const Unit& u, int, int wr, int wc, int fr, int fq, const LAS float*) const {
#pragma unroll
        for (int ai = 0; ai < 2; ++ai)
#pragma unroll
            for (int m = 0; m < 4; ++m) { const int row = u.pm * BM + ai * HALF + wr * 64 + m * 16 + fr;
#pragma unroll
                for (int bj = 0; bj < 2; ++bj) { const f32x4 v0 = acc[ai][bj][m][0], v1 = acc[ai][bj][m][1];
                    u32x4 w; w.x = cvt_pk_bf16(v0[0], v0[1]); w.y = cvt_pk_bf16(v0[2], v0[3]); w.z = cvt_pk_bf16(v1[0], v1[1]); w.w = cvt_pk_bf16(v1[2], v1[3]);
                    *(u32x4*)(P7 + ((size_t)(2 * u.pn + bj) * T + row) * HD + wc * 32 + 8 * fq) = w; } }
    }
};
struct EpiRes {
    static constexpr bool PERM = false; const float* res; float* out; int ldc; const float* bias; const float* scale;
    __device__ __forceinline__ void operator()(const f32x4 (&acc)[2][2][4][2], const Unit& u, int, int wr, int wc, int fr, int fq, const LAS float*) const {
        const int col0 = u.pn * BM + wc * 32 + 4 * fq;
        f32x4 bv[2][2], sv[2][2];
#pragma unroll
        for (int bj = 0; bj < 2; ++bj)
#pragma unroll
            for (int n = 0; n < 2; ++n) { bv[bj][n] = bias ? *(const f32x4*)(bias + col0 + bj * HALF + n * 16) : (f32x4){0.f, 0.f, 0.f, 0.f}; sv[bj][n] = scale ? *(const f32x4*)(scale + col0 + bj * HALF + n * 16) : (f32x4){1.f, 1.f, 1.f, 1.f}; }
#pragma unroll
        for (int ai = 0; ai < 2; ++ai)
#pragma unroll
            for (int m = 0; m < 4; ++m) { const size_t off = (size_t)(u.pm * BM + ai * HALF + wr * 64 + m * 16 + fr) * ldc + col0;
#pragma unroll
                for (int bj = 0; bj < 2; ++bj)
#pragma unroll
                    for (int n = 0; n < 2; ++n) { const f32x4 r = *(const f32x4*)(res + off + bj * HALF + n * 16); *(f32x4*)(out + off + bj * HALF + n * 16) = r + (acc[ai][bj][m][n] + bv[bj][n]) * sv[bj][n]; }
                if (m & 1) asm volatile("" ::: "memory"); }
    }
};
struct EpiSilu {
    static constexpr bool PERM = true; bf16_t* Hb;
    __device__ __forceinline__ void operator()(const f32x4 (&acc)[2][2][4][2], const Unit& u, int, int wr, int wc, int fr, int fq, const LAS float*) const {
        const int col0 = (u.pn & 7) * HALF + wc * 32 + 8 * fq;
#pragma unroll
        for (int ai = 0; ai < 2; ++ai)
#pragma unroll
            for (int m = 0; m < 4; ++m) { const size_t row = (size_t)u.pm * BM + ai * HALF + wr * 64 + m * 16 + fr; float h[8];
#pragma unroll
                for (int n = 0; n < 2; ++n)
#pragma unroll
                    for (int j = 0; j < 4; ++j) { const float a = acc[ai][0][m][n][j], up = acc[ai][1][m][n][j]; h[n * 4 + j] = a * __builtin_amdgcn_rcpf(1.0f + __expf(-a)) * up; }
                u32x4 w; w.x = cvt_pk_bf16(h[0], h[1]); w.y = cvt_pk_bf16(h[2], h[3]); w.z = cvt_pk_bf16(h[4], h[5]); w.w = cvt_pk_bf16(h[6], h[7]);
                *(u32x4*)(Hb + row * DEXP + col0) = w; }
    }
};
struct EpiDown {
    static constexpr bool PERM = true; bf16_t* YSb;
    __device__ __forceinline__ void operator()(const f32x4 (&acc)[2][2][4][2], const Unit& u, int ui, int wr, int wc, int fr, int fq, const LAS float* roww) const {
        const int col0 = (u.pn & 7) * BM + wc * 32 + 8 * fq;
#pragma unroll
        for (int ai = 0; ai < 2; ++ai)
#pragma unroll
            for (int m = 0; m < 4; ++m) { const int r = ai * HALF + wr * 64 + m * 16 + fr; const float w8 = roww[ui * 256 + r]; bf16_t* rowp = YSb + ((size_t)u.pm * BM + r) * D + col0;
#pragma unroll
                for (int bj = 0; bj < 2; ++bj) { const f32x4 v0 = acc[ai][bj][m][0] * w8, v1 = acc[ai][bj][m][1] * w8;
                    u32x4 w; w.x = cvt_pk_bf16(v0[0], v0[1]); w.y = cvt_pk_bf16(v0[2], v0[3]); w.z = cvt_pk_bf16(v1[0], v1[1]); w.w = cvt_pk_bf16(v1[2], v1[3]);
                    *(u32x4*)(rowp + bj * HALF) = w; } }
    }
};

template <class Epi, class Sched, bool GATHER>
__device__ __forceinline__ void gemm_phase(LAS unsigned char* lds, const Gemm g, const Sched& S, const Epi& E, const LAS unsigned* rowoff, const LAS float* roww) {
    const int tid = threadIdx.x, wid = __builtin_amdgcn_readfirstlane(tid >> 6), lane = tid & 63, wr = wid >> 2, wc = wid & 3, fr = lane & 15, fq = lane >> 4;
    const int K = g.K, nt = K / BK;
    unsigned voffA[2], voffB[2]; int Rst[2]; unsigned Cst2[2];
#pragma unroll
    for (int i = 0; i < 2; ++i) { int R, C; stage_rc(tid * 16 + i * 8192, R, C); const int Rb = Epi::PERM ? ((R & ~31) + perm32(R & 31)) : R;
        voffA[i] = (unsigned)(R * g.lda + C) * 2u; voffB[i] = (unsigned)(Rb * g.ldb + C) * 2u; Rst[i] = R; Cst2[i] = (unsigned)C * 2u; }
    const size_t kstep = (size_t)(BK * 2);
    const size_t hstepA = (size_t)HALF * g.lda * 2, hstepB = (size_t)HALF * g.ldb * 2, tstepA = 2 * hstepA, tstepB = 2 * hstepB;
    const unsigned ldsw = (unsigned)wid * 1024u;
    const int aoff = lds_byte(wr * 64 + fr, fq * 8), boff = lds_byte(wc * 32 + fr, fq * 8);
#define PG_SA(b, h) (((b) * 2 + (h)) * HTB)
#define PG_SB(b, h) ((4 + (b) * 2 + (h)) * HTB)
#define PG_STAGE_B(bufoff, gbase) do { _Pragma("unroll") for (int _i = 0; _i < 2; ++_i) \
        __builtin_amdgcn_global_load_lds((const unsigned*)((const char*)(gbase) + voffB[_i]), (LAS unsigned*)(lds + (bufoff) + ldsw + _i * 8192), 16, 0, 0); } while (0)
#define PG_STAGE_A(bufoff, gbase, h, OFS) do { _Pragma("unroll") for (int _i = 0; _i < 2; ++_i) \
        __builtin_amdgcn_global_load_lds((const unsigned*)((const char*)(gbase) + (OFS)[h][_i]), (LAS unsigned*)(lds + (bufoff) + ldsw + _i * 8192), 16, 0, 0); } while (0)
#define PG_LDA(dst, b, h) do { _Pragma("unroll") for (int m = 0; m < 4; ++m) _Pragma("unroll") for (int k = 0; k < 2; ++k) dst[m][k] = *(const LAS bf16x8*)(lds + PG_SA(b, h) + aoff + m * 2048 + k * 1024); } while (0)
#define PG_LDB(dst, b, h) do { _Pragma("unroll") for (int n = 0; n < 2; ++n) _Pragma("unroll") for (int k = 0; k < 2; ++k) dst[n][k] = *(const LAS bf16x8*)(lds + PG_SB(b, h) + boff + n * 2048 + k * 1024); } while (0)
#define PG_MMA(ai, bj, At, Bt) do { __builtin_amdgcn_s_setprio(1); _Pragma("unroll") for (int m = 0; m < 4; ++m) _Pragma("unroll") for (int n = 0; n < 2; ++n) _Pragma("unroll") for (int k = 0; k < 2; ++k) \
        acc[ai][bj][m][n] = __builtin_amdgcn_mfma_f32_16x16x32_bf16(Bt[n][k], At[m][k], acc[ai][bj][m][n], 0, 0, 0); __builtin_amdgcn_s_setprio(0); } while (0)
#define PG_WAIT_V(n) asm volatile("s_waitcnt vmcnt(" #n ")" ::: "memory")
#define PG_WAIT_L(n) asm volatile("s_waitcnt lgkmcnt(" #n ")" ::: "memory")
#define PG_BAR __builtin_amdgcn_s_barrier()
#define PG_SCHED __builtin_amdgcn_sched_barrier(0)
#define PG_LOAD_OFS(o, slot) do { _Pragma("unroll") for (int _h = 0; _h < 2; ++_h) _Pragma("unroll") for (int _i = 0; _i < 2; ++_i) \
        o[_h][_i] = GATHER ? (rowoff[(slot) * 256 + _h * HALF + Rst[_i]] + Cst2[_i]) : (voffA[_i] + (unsigned)(_h * hstepA)); } while (0)
#define PG_ABASE(u) (GATHER ? (const char*)g.A + (size_t)(u).ak * 2 : (const char*)g.A + (size_t)(u).pm * tstepA + (size_t)(u).ak * 2)
    Unit cur, nxt; int ui = 0;
    if (!S.next(0, cur)) return;
    f32x4 acc[2][2][4][2];
#pragma unroll
    for (int a = 0; a < 2; ++a)
#pragma unroll
        for (int b = 0; b < 2; ++b)
#pragma unroll
            for (int m = 0; m < 4; ++m)
#pragma unroll
                for (int n = 0; n < 2; ++n) acc[a][b][m][n] = (f32x4){0.f, 0.f, 0.f, 0.f};
    bf16x8 At[4][2], B0[2][2], B1[2][2];
    unsigned ofsC[2][2], ofsN[2][2];
    PG_LOAD_OFS(ofsC, 0);
    const char* cA = PG_ABASE(cur); const char* cB = (const char*)g.Bt + (size_t)cur.pn * tstepB;
    PG_STAGE_B(PG_SB(0, 0), cB); PG_STAGE_B(PG_SB(0, 1), cB + hstepB); PG_STAGE_A(PG_SA(0, 0), cA, 0, ofsC); PG_STAGE_A(PG_SA(0, 1), cA, 1, ofsC);
    if (wr == 1) PG_BAR;
    PG_WAIT_V(2); PG_BAR;
    PG_STAGE_B(PG_SB(1, 0), cB + kstep); PG_STAGE_A(PG_SA(1, 0), cA + kstep, 0, ofsC); PG_STAGE_B(PG_SB(1, 1), cB + hstepB + kstep);
    PG_WAIT_V(6); PG_BAR;
    for (;;) {
        const bool has_next = S.next(ui + 1, nxt);
        const char* nA = has_next ? PG_ABASE(nxt) : cA; const char* nB = has_next ? (const char*)g.Bt + (size_t)nxt.pn * tstepB : cB;
        PG_LOAD_OFS(ofsN, (has_next ? ui + 1 : ui));
        for (int t = 0; t < nt; t += 2) {
            const bool last = (t == nt - 2);
            const char* a1 = cA + (size_t)(t + 1) * kstep;
            const char* a2 = last ? nA : cA + (size_t)(t + 2) * kstep; const char* b2 = last ? nB : cB + (size_t)(t + 2) * kstep;
            const char* a3 = a2 + kstep; const char* b3 = b2 + kstep;
            unsigned ofs2[2][2];
#pragma unroll
            for (int h = 0; h < 2; ++h)
#pragma unroll
                for (int i = 0; i < 2; ++i) ofs2[h][i] = GATHER ? (last ? ofsN[h][i] : ofsC[h][i]) : ofsC[h][i];
            PG_LDB(B0, 0, 0); PG_LDB(B1, 0, 1); PG_SCHED; PG_LDA(At, 0, 0); PG_STAGE_A(PG_SA(1, 1), a1, 1, ofsC);
            PG_WAIT_V(8); PG_WAIT_L(0); PG_BAR; PG_MMA(0, 0, At, B0); PG_MMA(0, 1, At, B1); PG_BAR; PG_SCHED;
            PG_LDA(At, 0, 1); PG_STAGE_B(PG_SB(0, 0), b2); PG_STAGE_B(PG_SB(0, 1), b2 + hstepB); PG_STAGE_A(PG_SA(0, 0), a2, 0, ofs2);
            PG_WAIT_V(8); PG_WAIT_L(0); PG_BAR; PG_MMA(1, 0, At, B0); PG_MMA(1, 1, At, B1); PG_BAR; PG_SCHED;
            PG_LDB(B0, 1, 0); PG_LDB(B1, 1, 1); PG_SCHED; PG_LDA(At, 1, 0); PG_STAGE_A(PG_SA(0, 1), a2, 1, ofs2);
            PG_WAIT_V(8); PG_WAIT_L(0); PG_BAR; PG_MMA(0, 0, At, B0); PG_MMA(0, 1, At, B1); PG_BAR; PG_SCHED;
            PG_LDA(At, 1, 1); PG_STAGE_B(PG_SB(1, 0), b3); PG_STAGE_B(PG_SB(1, 1), b3 + hstepB); PG_STAGE_A(PG_SA(1, 0), a3, 0, ofs2);
            PG_WAIT_V(8); PG_WAIT_L(0); PG_BAR; PG_MMA(1, 0, At, B0); PG_MMA(1, 1, At, B1); PG_BAR; PG_SCHED;
        }
        if (wr == 0) PG_BAR;
        E(acc, cur, ui, wr, wc, fr, fq, roww);
        if (!has_next) break;
#pragma unroll
        for (int a = 0; a < 2; ++a)
#pragma unroll
            for (int b = 0; b < 2; ++b)
#pragma unroll
                for (int m = 0; m < 4; ++m)
#pragma unroll
                    for (int n = 0; n < 2; ++n) acc[a][b][m][n] = (f32x4){0.f, 0.f, 0.f, 0.f};
        cur = nxt; cA = nA; cB = nB; ++ui;
#pragma unroll
        for (int h = 0; h < 2; ++h)
#pragma unroll
            for (int i = 0; i < 2; ++i) ofsC[h][i] = ofsN[h][i];
        if (wr == 1) PG_BAR;
    }
    PG_WAIT_V(0);
    PG_BAR;
#undef PG_SA
#undef PG_SB
#undef PG_STAGE_A
#undef PG_STAGE_B
#undef PG_LDA
#undef PG_LDB
#undef PG_MMA
#undef PG_WAIT_V
#undef PG_WAIT_L
#undef PG_BAR
#undef PG_SCHED
#undef PG_LOAD_OFS
#undef PG_ABASE
}
}

namespace at {
constexpr int NTHREADS_C = 512;
typedef short bf16x8 __attribute__((ext_vector_type(8)));
typedef short s16x4 __attribute__((ext_vector_type(4)));
typedef float f32x16 __attribute__((ext_vector_type(16)));
constexpr int NW = 8, QBLK = 32, KVBLK = 64, QB = NW * QBLK, DH = 128;
constexpr int SHM_V = KVBLK * DH * 2, SHM_K = KVBLK * DH * 2;
constexpr int OFF_WS = 2 * SHM_V + 2 * SHM_K, OFF_BIAS = OFF_WS + NW * 64 * 4, BIAS_BYTES = 65536, ATT_LDS = OFF_BIAS + BIAS_BYTES;
constexpr float LOG2E = 1.4426950408889634f, C2 = LOG2E * QK_SCALE, THR2 = 8.f * LOG2E;
#define KSWZ(row, colB) ((row) * 256 + ((colB) ^ (((row) & 7) << 4)))
#define SBAR() __builtin_amdgcn_sched_barrier(0)
__device__ __forceinline__ int v_st(int k, int c) { const int kk = (k & ~0xC) | ((k & 4) << 1) | ((k & 8) >> 1); return ((kk >> 3) * 4 + (c >> 5)) * 512 + ((kk & 7) * 32 + (c & 31)) * 2; }
__device__ __forceinline__ int v_rd_base(int lane) { return ((lane & 3) << 3) | (((lane >> 2) & 3) << 6) | (((lane >> 4) & 1) << 5) | (((lane >> 5) & 1) << 8); }
constexpr int v_rd_off(int d0, int ks, int half) { return d0 * 512 + ks * 4096 + half * 2048; }
__device__ __forceinline__ int crow(int r, int hi) { return (r & 3) + 8 * (r >> 2) + 4 * hi; }
__device__ __forceinline__ unsigned cvtpk(float lo, float hi) { unsigned r; asm volatile("v_cvt_pk_bf16_f32 %0, %1, %2" : "=v"(r) : "v"(lo), "v"(hi)); return r; }
__device__ __forceinline__ bf16x8 load8(const bf16_t* p) { return *reinterpret_cast<const bf16x8*>(p); }
__device__ __forceinline__ void mask_tile(f32x16& p0, f32x16& p1, int dq) {
    const float NEG = -__builtin_inff();
#pragma unroll
    for (int r = 0; r < 16; ++r) { const int c = (r & 3) + 8 * (r >> 2); if (dq - c < 0) p0[r] = NEG; if (dq - c - 32 < 0) p1[r] = NEG; }
}
__device__ __forceinline__ void bias_scale(f32x16& p0, f32x16& p1, const float* bt, int hi) {
#pragma unroll
    for (int g = 0; g < 4; ++g) { const f32x4 b0 = *(const f32x4*)(bt + 8 * g + 4 * hi);
#pragma unroll
        for (int j = 0; j < 4; ++j) p0[4 * g + j] = fmaf(p0[4 * g + j], C2, b0[j]); }
#pragma unroll
    for (int g = 0; g < 4; ++g) { const f32x4 b1 = *(const f32x4*)(bt + 32 + 8 * g + 4 * hi);
#pragma unroll
        for (int j = 0; j < 4; ++j) p1[4 * g + j] = fmaf(p1[4 * g + j], C2, b1[j]); }
}
__device__ __forceinline__ void partialSM(f32x16& p0, f32x16& p1, float& m_reg, float& mn, float& alpha) {
    float pmax = p0[0]; for (int r = 1; r < 16; ++r) pmax = fmaxf(pmax, p0[r]); for (int r = 0; r < 16; ++r) pmax = fmaxf(pmax, p1[r]);
    { auto rr = __builtin_amdgcn_permlane32_swap(__float_as_uint(pmax), __float_as_uint(pmax), false, false); pmax = fmaxf(__uint_as_float(rr[0]), __uint_as_float(rr[1])); }
    if (__builtin_expect(__all((pmax - m_reg) <= THR2), 1)) { mn = m_reg; alpha = 1.f; }
    else { mn = fmaxf(m_reg, pmax); alpha = __builtin_amdgcn_exp2f(m_reg - mn); m_reg = mn; }
    for (int r = 0; r < 16; ++r) p0[r] = p0[r] - mn; for (int r = 0; r < 16; ++r) p1[r] = p1[r] - mn;
    for (int r = 0; r < 16; ++r) p0[r] = __builtin_amdgcn_exp2f(p0[r]);
}
__device__ __forceinline__ void finishSM(f32x16& p0, f32x16& p1, float alpha, float& l_reg, bf16x8& pa0, bf16x8& pa1, bf16x8& pa2, bf16x8& pa3) {
    for (int r = 0; r < 16; ++r) p1[r] = __builtin_amdgcn_exp2f(p1[r]);
    float ps = 0; for (int r = 0; r < 16; ++r) ps += p0[r]; for (int r = 0; r < 16; ++r) ps += p1[r];
    { auto rr = __builtin_amdgcn_permlane32_swap(__float_as_uint(ps), __float_as_uint(ps), false, false); ps = __uint_as_float(rr[0]) + __uint_as_float(rr[1]); }
    l_reg = l_reg * alpha + ps;
#define PK4(P, B_, OUT) do { unsigned a0 = cvtpk(P[B_+0], P[B_+1]), a1 = cvtpk(P[B_+2], P[B_+3]);                          \
        unsigned b0 = cvtpk(P[B_+4], P[B_+5]), b1 = cvtpk(P[B_+6], P[B_+7]);                                             \
        auto r0 = __builtin_amdgcn_permlane32_swap(a0, b0, false, false); auto r1 = __builtin_amdgcn_permlane32_swap(a1, b1, false, false); \
        u32x4 w = {r0[0], r1[0], r0[1], r1[1]}; OUT = *reinterpret_cast<bf16x8*>(&w); } while (0)
    PK4(p0, 0, pa0); PK4(p0, 8, pa1); PK4(p1, 0, pa2); PK4(p1, 8, pa3);
#undef PK4
}
template <int KB>
__device__ __forceinline__ void qkt(f32x16& p0, f32x16& p1, const char* K_lds, int r32, int hi, const bf16x8* qr) {
    p0 = f32x16{}; p1 = f32x16{};
    const char* kb[4];
#pragma unroll
    for (int dd = 0; dd < 4; ++dd) kb[dd] = K_lds + KB * SHM_K + KSWZ(r32, (dd * 16 + hi * 8) * 2);
#pragma unroll
    for (int d0 = 0; d0 < 8; ++d0) { const char* a = kb[d0 & 3] + (d0 >> 2) * 128;
        bf16x8 b0 = *reinterpret_cast<const bf16x8*>(a);
        bf16x8 b1 = *reinterpret_cast<const bf16x8*>(a + 32 * 256);
        p0 = __builtin_amdgcn_mfma_f32_32x32x16_bf16(b0, qr[d0], p0, 0, 0, 0);
        p1 = __builtin_amdgcn_mfma_f32_32x32x16_bf16(b1, qr[d0], p1, 0, 0, 0); }
}
template <int VB>
__device__ __forceinline__ void pv_tile(f32x16* o, int vb0, bf16x8 pa0, bf16x8 pa1, bf16x8 pa2, bf16x8 pa3) {
#define TRRD(dst, off) asm volatile("ds_read_b64_tr_b16 %0, %1 offset:%2" : "=&v"(dst) : "v"(vb0), "i"(off) : "memory")
#define PV_D0(d0) do { s16x4 l0, l1, l2, l3, h0, h1, h2, h3; constexpr int b_ = VB * SHM_V + v_rd_off(d0, 0, 0); \
        TRRD(l0, b_); TRRD(h0, b_ + 2048); TRRD(l1, b_ + 4096); TRRD(h1, b_ + 6144); TRRD(l2, b_ + 8192); TRRD(h2, b_ + 10240); TRRD(l3, b_ + 12288); TRRD(h3, b_ + 14336); \
        asm volatile("s_waitcnt lgkmcnt(0)" ::: "memory"); SBAR();   \
        o[d0] = __builtin_amdgcn_mfma_f32_32x32x16_bf16(pa0, (bf16x8){l0[0], l0[1], l0[2], l0[3], h0[0], h0[1], h0[2], h0[3]}, o[d0], 0, 0, 0);   \
        o[d0] = __builtin_amdgcn_mfma_f32_32x32x16_bf16(pa1, (bf16x8){l1[0], l1[1], l1[2], l1[3], h1[0], h1[1], h1[2], h1[3]}, o[d0], 0, 0, 0);   \
        o[d0] = __builtin_amdgcn_mfma_f32_32x32x16_bf16(pa2, (bf16x8){l2[0], l2[1], l2[2], l2[3], h2[0], h2[1], h2[2], h2[3]}, o[d0], 0, 0, 0);   \
        o[d0] = __builtin_amdgcn_mfma_f32_32x32x16_bf16(pa3, (bf16x8){l3[0], l3[1], l3[2], l3[3], h3[0], h3[1], h3[2], h3[3]}, o[d0], 0, 0, 0); } while (0)
    PV_D0(0); PV_D0(1); PV_D0(2); PV_D0(3);
#undef PV_D0
#undef TRRD
}
struct BlockRef { const bf16_t* Q; const bf16_t* K; const bf16_t* V; bf16_t* O; const float* cb; int P0, jlo; };
struct Seam { bf16x8 qr[8]; bf16x8 st_v0, st_v1, st_k0, st_k1; };
#define LDG8(ubase, voff) (*(const bf16x8*)((const char*)(ubase) + (voff)))
#define VMW() asm volatile("s_waitcnt vmcnt(0)" ::: "memory")
#define VMWN(n) asm volatile("s_waitcnt vmcnt(%0)" :: "i"(n) : "memory")
#define SLOAD_H(Kp, Vp, k0) do { const bf16_t* vb_ = (Vp) + (size_t)(k0) * DH; const bf16_t* kb_ = (Kp) + (size_t)(k0) * DH; \
        S.st_v0 = LDG8(vb_, stoff); S.st_v1 = LDG8(vb_, stoff + 32 * DH * 2); S.st_k0 = LDG8(kb_, stoff); S.st_k1 = LDG8(kb_, stoff + 32 * DH * 2); } while (0)
#define SWRITE_HK(bf) do { *(bf16x8*)(K_lds + (bf) * SHM_K + kws) = S.st_k0; *(bf16x8*)(K_lds + (bf) * SHM_K + kws + 32 * 256) = S.st_k1; } while (0)
#define SWRITE_HV(bf) do { *(bf16x8*)(V_lds + (bf) * SHM_V + vst0) = S.st_v0; *(bf16x8*)(V_lds + (bf) * SHM_V + vst1) = S.st_v1; } while (0)
#define SWRITE_H(bf) do { SWRITE_HV(bf); SWRITE_HK(bf); } while (0)
__device__ __forceinline__ void attn_prime(const BlockRef& cur, char* lds, Seam& S) {
    const int tid = threadIdx.x, wid = __builtin_amdgcn_readfirstlane(tid >> 6), lane = tid & 63, r32 = lane & 31, hi = lane >> 5;
    const int sr = tid >> 4, sc = (tid & 15) * 8, kws = KSWZ(sr, sc * 2); char* K_lds = lds + 2 * SHM_V;
    const unsigned stoff = (unsigned)(sr * DH + sc) * 2u, qoff = (unsigned)(r32 * DH + hi * 8) * 2u;
    const int kb0 = cur.jlo * KVBLK;
    { const bf16_t* qb_ = cur.Q + (size_t)(wid * QBLK) * DH;
#pragma unroll
      for (int d0 = 0; d0 < 8; ++d0) S.qr[d0] = LDG8(qb_, qoff + d0 * 32); }
    SLOAD_H(cur.K, cur.V, kb0); VMW(); SWRITE_HK(0);
    __syncthreads();
}
__device__ __forceinline__ void attn_block(const BlockRef& cur, const BlockRef& nxt, int ldo, char* lds, Seam& S) {
    const int tid = threadIdx.x, wid = __builtin_amdgcn_readfirstlane(tid >> 6), lane = tid & 63, r32 = lane & 31, hi = lane >> 5;
    const int j_lo = cur.jlo, j_hi = (cur.P0 + QB - 1) / KVBLK + 1;
    const int NT = j_hi - j_lo;
    const int kbn = nxt.jlo * KVBLK;
    const int qlo = cur.P0 + wid * QBLK, qm = qlo + r32 - 4 * hi;
    char* V_lds = lds; char* K_lds = lds + 2 * SHM_V;
    float* ws = (float*)(lds + OFF_WS) + wid * 64; float* li_l = ws, * al_l = ws + 32;
    float* bias_l = (float*)(lds + OFF_BIAS);
    { const float cref = cur.cb[cur.P0]; const int nk = (j_hi - j_lo) * KVBLK; const float* csrc = cur.cb + j_lo * KVBLK;
      for (int i = tid * 4; i < nk; i += 512 * 4) { const f32x4 c4 = *(const f32x4*)(csrc + i); *(f32x4*)(bias_l + i) = (cref - c4) * LOG2E; } }
    float m_reg = -1e30f, l_reg = 0; f32x16 o[4] = {};
    const int sr = tid >> 4, sc = (tid & 15) * 8, vst0 = v_st(sr, sc), vst1 = v_st(32 + sr, sc), kws = KSWZ(sr, sc * 2);
    const unsigned stoff = (unsigned)(sr * DH + sc) * 2u, qoff = (unsigned)(r32 * DH + hi * 8) * 2u;
    const int vb0 = (int)(uintptr_t)V_lds + v_rd_base(lane);
    const bf16_t* Kh = cur.K; const bf16_t* Vh = cur.V;
#define RESC(a) do { if (__any((a) < 1.f)) { if (hi == 0) al_l[r32] = (a); asm volatile("s_waitcnt lgkmcnt(0)" ::: "memory");              \
                     for (int d_ = 0; d_ < 4; ++d_) for (int r = 0; r < 16; ++r) o[d_][r] *= al_l[crow(r, hi)]; } } while (0)
#define KBASE(t) ((j_lo + (t)) * KVBLK)
#define MASKT(P0_, P1_, t) do { const int kb_ = KBASE(t); bias_scale(P0_, P1_, bias_l + (t) * KVBLK, hi); if (kb_ + KVBLK - 1 > qlo) mask_tile(P0_, P1_, qm - kb_); } while (0)
    constexpr int NQL = 8;
#define SEAM_K0() do { VMWN(NQL); SWRITE_HK(0); SBAR(); } while (0)
    f32x16 pA0, pA1, pB0, pB1; float mnA, mnB, alA, alB; bf16x8 pa0, pa1, pa2, pa3;
    SWRITE_HV(0); SBAR();
    if (NT > 1) SLOAD_H(Kh, Vh, KBASE(1));
    SBAR(); qkt<0>(pA0, pA1, K_lds, r32, hi, S.qr);
    __syncthreads();
    MASKT(pA0, pA1, 0); partialSM(pA0, pA1, m_reg, mnA, alA);
    if (NT > 1) { VMW(); SWRITE_H(1); }
    __syncthreads();
#define HALF_STEP(PX0, PX1, mnX, alX, PY0, PY1, alY, t, KB, VB, SB) do {                                                      \
        SBAR(); qkt<KB>(PX0, PX1, K_lds, r32, hi, S.qr);                                             \
        finishSM(PY0, PY1, alY, l_reg, pa0, pa1, pa2, pa3); SBAR();                                                           \
        if ((t) + 1 < NT) { SLOAD_H(Kh, Vh, KBASE((t) + 1)); SBAR(); }                                               \
        pv_tile<VB>(o, vb0, pa0, pa1, pa2, pa3); MASKT(PX0, PX1, (t)); partialSM(PX0, PX1, m_reg, mnX, alX);                                        \
        __syncthreads();                                                                                                      \
        if ((t) + 1 < NT) { VMW(); SWRITE_H(SB); }                                                                          \
        RESC(alX); __syncthreads(); } while (0)
    for (int t = 1; t + 1 < NT; t += 2) {
        HALF_STEP(pB0, pB1, mnB, alB, pA0, pA1, alA, t, 1, 0, 0);
        HALF_STEP(pA0, pA1, mnA, alA, pB0, pB1, alB, t + 1, 0, 1, 1);
    }
    const bool even = (NT & 1) == 0;
    if (even) { SBAR(); qkt<1>(pB0, pB1, K_lds, r32, hi, S.qr); SBAR(); }
    { SLOAD_H(nxt.K, nxt.V, kbn); SBAR();
      const bf16_t* qb_ = nxt.Q + (size_t)(wid * QBLK) * DH;
#pragma unroll
        for (int d0 = 0; d0 < 8; ++d0) S.qr[d0] = LDG8(qb_, qoff + d0 * 32); }
    SBAR();
    finishSM(pA0, pA1, alA, l_reg, pa0, pa1, pa2, pa3); SBAR();
    pv_tile<0>(o, vb0, pa0, pa1, pa2, pa3);
    if (even) { MASKT(pB0, pB1, NT - 1); partialSM(pB0, pB1, m_reg, mnB, alB); __syncthreads(); RESC(alB);
        finishSM(pB0, pB1, alB, l_reg, pa0, pa1, pa2, pa3); SBAR(); pv_tile<1>(o, vb0, pa0, pa1, pa2, pa3); }
    SBAR(); SEAM_K0();
    if (hi == 0) li_l[r32] = l_reg; asm volatile("s_waitcnt lgkmcnt(0)" ::: "memory");
    float rli[16];
#pragma unroll
    for (int r = 0; r < 16; ++r) rli[r] = __builtin_amdgcn_rcpf(li_l[crow(r, hi)]);
    bf16_t* Ow = cur.O + (size_t)(wid * QBLK) * ldo; const unsigned ooff = (unsigned)(4 * hi * ldo + r32) * 2u;
#pragma unroll
    for (int r = 0; r < 16; ++r) { const int orow0 = (r & 3) + 8 * (r >> 2);
#pragma unroll
        for (int d0 = 0; d0 < 4; ++d0) { const float v = o[d0][r] * rli[r]; const float vn = __shfl_xor(v, 1);
            if ((r32 & 1) == 0) *(unsigned*)((char*)(Ow + (size_t)orow0 * ldo + d0 * 32) + ooff) = cvtpk(v, vn); } }
    __syncthreads();
#undef RESC
#undef KBASE
#undef MASKT
#undef SEAM_K0
#undef HALF_STEP
}
#undef LDG8
#undef VMW
#undef VMWN
#undef SLOAD_H
#undef SWRITE_HK
#undef SWRITE_HV
#undef SWRITE_H
__device__ __forceinline__ BlockRef make_ref(const bf16_t* P7, const float* CF, bf16_t* Y, int h, int qb) {
    BlockRef r; r.Q = P7 + ((size_t)h * T + (size_t)qb * QB) * DH; r.K = P7 + (size_t)(8 + h) * T * DH; r.V = P7 + (size_t)(16 + h) * T * DH;
    r.O = Y + (size_t)qb * QB * D + h * DH; r.cb = CF + (size_t)h * T; r.P0 = qb * QB; r.jlo = 0; return r;
}
__device__ __forceinline__ void attn_phase(char* lds, const bf16_t* P7, const float* CF, bf16_t* Y, int G, int c) {
    constexpr int NQB = T / QB, NX = NQB / 2, TOTAL = NH * NX;
    int L = c; if (L >= TOTAL) return;
    int pass = 0;
    BlockRef cur = make_ref(P7, CF, Y, L / NX, L % NX);
    Seam S;
    attn_prime(cur, lds, S);
    for (;;) {
        const bool more_pass = pass == 0, more_item = L + G < TOTAL, last = !more_pass && !more_item;
        int Ln = L, passn = pass + 1;
        if (!more_pass) { passn = 0; Ln = more_item ? L + G : L; }
        const int hn = Ln / NX, xn = Ln % NX;
        const BlockRef nxt = last ? cur : make_ref(P7, CF, Y, hn, passn ? NQB - 1 - xn : xn);
        attn_block(cur, nxt, D, lds, S);
        if (last) break;
        cur = nxt; pass = passn; L = Ln;
    }
}
constexpr int MCH = 256, NCH = T / MCH;
#define TRRDB(dst, base, off) asm volatile("ds_read_b64_tr_b16 %0, %1 offset:%2" : "=&v"(dst) : "v"(base), "i"(off) : "memory")
#define FRAG8(l, h) (bf16x8){l[0], l[1], l[2], l[3], h[0], h[1], h[2], h[3]}
__device__ __forceinline__ bf16x8 scale8(bf16x8 v, float w) {
    u32x4 u = *reinterpret_cast<u32x4*>(&v); u32x4 o;
#pragma unroll
    for (int j = 0; j < 4; ++j) o[j] = cvtpk(__uint_as_float(u[j] << 16) * w, __uint_as_float(u[j] & 0xffff0000u) * w);
    return *reinterpret_cast<bf16x8*>(&o);
}
__device__ __forceinline__ void mlstm_c1_unit(char* lds, const bf16_t* P7, const float* BM, const float* IP, float* DC, float* NDp, int h, int c) {
    const int tid = threadIdx.x, wid = __builtin_amdgcn_readfirstlane(tid >> 6), lane = tid & 63, r32 = lane & 31, hi = lane >> 5;
    const int sr = tid >> 4, sc = (tid & 15) * 8, vst0 = v_st(sr, sc), vst1 = v_st(32 + sr, sc);
    const unsigned stoff = (unsigned)(sr * DH + sc) * 2u;
    char* V_lds = lds; char* K_lds = lds + 2 * SHM_V;
    const bf16_t* Kh = P7 + (size_t)(32 + h) * T * DH; const bf16_t* Vh = P7 + (size_t)(40 + h) * T * DH;
    const float* bm = BM + (size_t)h * T; const float* ip = IP + (size_t)h * T;
    const int t0 = c * MCH; const float bmend = bm[t0 + MCH - 1];
    const int db = wid & 3, vg = wid >> 2;
    const int kbase = (int)(uintptr_t)K_lds + v_rd_base(lane) + db * 512, vbase = (int)(uintptr_t)V_lds + v_rd_base(lane) + vg * 1024;
    f32x16 acc0 = {}, acc1 = {}, accn = {};
    const bf16x8 ones = (bf16x8){0x3F80, 0x3F80, 0x3F80, 0x3F80, 0x3F80, 0x3F80, 0x3F80, 0x3F80};
    for (int j = 0; j < 4; ++j) {
        const int k0 = t0 + j * KVBLK; const bf16_t* vb_ = Vh + (size_t)k0 * DH; const bf16_t* kb_ = Kh + (size_t)k0 * DH;
        bf16x8 v0 = *(const bf16x8*)((const char*)vb_ + stoff), v1 = *(const bf16x8*)((const char*)vb_ + stoff + 32 * DH * 2);
        bf16x8 kk0 = *(const bf16x8*)((const char*)kb_ + stoff), kk1 = *(const bf16x8*)((const char*)kb_ + stoff + 32 * DH * 2);
        const float w0 = __expf(bmend - bm[k0 + sr] + ip[k0 + sr]) * QK_SCALE, w1 = __expf(bmend - bm[k0 + 32 + sr] + ip[k0 + 32 + sr]) * QK_SCALE;
        kk0 = scale8(kk0, w0); kk1 = scale8(kk1, w1);
        __syncthreads();
        *(bf16x8*)(V_lds + vst0) = v0; *(bf16x8*)(V_lds + vst1) = v1; *(bf16x8*)(K_lds + vst0) = kk0; *(bf16x8*)(K_lds + vst1) = kk1;
        __syncthreads();
#define C1_KS(ks) do { s16x4 kl, kh, al, ah, bl, bh; TRRDB(kl, kbase, (ks) * 4096); TRRDB(kh, kbase, (ks) * 4096 + 2048); \
            TRRDB(al, vbase, (ks) * 4096); TRRDB(ah, vbase, (ks) * 4096 + 2048); TRRDB(bl, vbase, 512 + (ks) * 4096); TRRDB(bh, vbase, 512 + (ks) * 4096 + 2048); \
            asm volatile("s_waitcnt lgkmcnt(0)" ::: "memory"); SBAR(); \
            const bf16x8 kf = FRAG8(kl, kh); acc0 = __builtin_amdgcn_mfma_f32_32x32x16_bf16(kf, FRAG8(al, ah), acc0, 0, 0, 0); acc1 = __builtin_amdgcn_mfma_f32_32x32x16_bf16(kf, FRAG8(bl, bh), acc1, 0, 0, 0); \
            if (vg == 0) accn = __builtin_amdgcn_mfma_f32_32x32x16_bf16(kf, ones, accn, 0, 0, 0); } while (0)
        C1_KS(0); C1_KS(1); C1_KS(2); C1_KS(3);
#undef C1_KS
    }
    float* Dp = DC + ((size_t)(h * NCH + c) * HD + db * 32) * HD + vg * 64 + r32;
#pragma unroll
    for (int r = 0; r < 16; ++r) { const int drow = crow(r, hi); Dp[(size_t)drow * HD] = acc0[r]; Dp[(size_t)drow * HD + 32] = acc1[r]; }
    if (vg == 0 && r32 == 0) { float* np = NDp + (size_t)(h * NCH + c) * HD + db * 32;
#pragma unroll
        for (int r = 0; r < 16; ++r) np[crow(r, hi)] = accn[r]; }
    __syncthreads();
}
__device__ __forceinline__ void mlstm_c2(const float* BM, const float* DC, const float* NDp, bf16_t* CST, float* NST, int G, int bx) {
    const int EL = HD * HD + HD;
    for (int e = bx * NTHREADS_C + (int)threadIdx.x; e < NH * EL; e += G * NTHREADS_C) {
        const int h = e / EL, i = e % EL; const float* bm = BM + (size_t)h * T; float C = 0.f, bprev = 0.f;
        float dv[8];
        for (int c0 = 0; c0 < NCH - 1; c0 += 8) {
#pragma unroll
            for (int j = 0; j < 8; ++j) { const int c = c0 + j; dv[j] = (c < NCH - 1) ? (i < HD * HD ? DC[(size_t)(h * NCH + c) * HD * HD + i] : NDp[(size_t)(h * NCH + c) * HD + (i - HD * HD)]) : 0.f; }
#pragma unroll
            for (int j = 0; j < 8; ++j) { const int c = c0 + j; if (c < NCH - 1) { const float bend = bm[c * MCH + MCH - 1]; C = __expf(bend - bprev) * C + dv[j]; bprev = bend;
                if (i < HD * HD) CST[(size_t)(h * NCH + c) * HD * HD + i] = (bf16_t)f2bf(C); else NST[(size_t)(h * NCH + c) * HD + (i - HD * HD)] = C; } }
        }
    }
}
__device__ __forceinline__ void mlstm_c3_unit(char* lds, const bf16_t* P7, const float* BM, const float* IP, const bf16_t* CST, const float* NST, const float* ogain, bf16_t* Y, int h, int c) {
    const int tid = threadIdx.x, wid = __builtin_amdgcn_readfirstlane(tid >> 6), lane = tid & 63, r32 = lane & 31, hi = lane >> 5;
    const int sr = tid >> 4, sc = (tid & 15) * 8, vst0 = v_st(sr, sc), vst1 = v_st(32 + sr, sc), kws = KSWZ(sr, sc * 2);
    const unsigned stoff = (unsigned)(sr * DH + sc) * 2u, qoff = (unsigned)(r32 * DH + hi * 8) * 2u;
    char* V_lds = lds; char* K_lds = lds + 2 * SHM_V;
    float* ws = (float*)(lds + OFF_WS) + wid * 64; float* li_l = ws, * al_l = ws + 32;
    float* colb = (float*)(lds + OFF_BIAS); float* nprev = colb + 256;
    const int vb0 = (int)(uintptr_t)V_lds + v_rd_base(lane);
    const bf16_t* Qh = P7 + (size_t)(24 + h) * T * DH; const bf16_t* Kh = P7 + (size_t)(32 + h) * T * DH; const bf16_t* Vh = P7 + (size_t)(40 + h) * T * DH; const bf16_t* Mh = P7 + (size_t)(48 + h) * T * DH;
    const float* bm = BM + (size_t)h * T; const float* ip = IP + (size_t)h * T;
    const int t0 = c * MCH; const float bmref = c ? bm[t0 - 1] : 0.f;
    bf16x8 qr[8];
    { const bf16_t* qb_ = Qh + (size_t)(t0 + wid * QBLK) * DH;
#pragma unroll
      for (int d0 = 0; d0 < 8; ++d0) qr[d0] = *(const bf16x8*)((const char*)qb_ + qoff + d0 * 32); }
    const float rowb = (bm[t0 + wid * QBLK + r32] - bmref) * LOG2E;
    if (tid < 256) colb[tid] = (bmref - bm[t0 + tid] + ip[t0 + tid]) * LOG2E;
    else if (tid < 384 && c) nprev[tid - 256] = NST[(size_t)(h * NCH + c - 1) * HD + (tid - 256)];
    f32x16 o[4] = {}; float den = 0.f;
    if (c) {
        const bf16_t* Cp = CST + (size_t)(h * NCH + c - 1) * HD * HD;
        for (int hf = 0; hf < 2; ++hf) {
            const bf16_t* cb_ = Cp + (size_t)(hf * 64) * DH;
            const bf16x8 v0 = *(const bf16x8*)((const char*)cb_ + stoff), v1 = *(const bf16x8*)((const char*)cb_ + stoff + 32 * DH * 2);
            __syncthreads();
            *(bf16x8*)(V_lds + vst0) = v0; *(bf16x8*)(V_lds + vst1) = v1;
            __syncthreads();
            if (hf == 0) pv_tile<0>(o, vb0, qr[0], qr[1], qr[2], qr[3]); else pv_tile<0>(o, vb0, qr[4], qr[5], qr[6], qr[7]);
        }
        float dn = 0.f;
#pragma unroll
        for (int d0 = 0; d0 < 8; ++d0) { const u32x4 u = *reinterpret_cast<const u32x4*>(&qr[d0]); const float* np_ = nprev + d0 * 16 + hi * 8;
#pragma unroll
            for (int j = 0; j < 4; ++j) dn += __uint_as_float(u[j] << 16) * np_[2 * j] + __uint_as_float(u[j] & 0xffff0000u) * np_[2 * j + 1]; }
        { auto rr = __builtin_amdgcn_permlane32_swap(__float_as_uint(dn), __float_as_uint(dn), false, false); dn = __uint_as_float(rr[0]) + __uint_as_float(rr[1]); }
        const float rs = __builtin_amdgcn_exp2f(rowb); den = rs * dn;
        if (hi == 0) al_l[r32] = rs; asm volatile("s_waitcnt lgkmcnt(0)" ::: "memory");
        for (int d_ = 0; d_ < 4; ++d_) for (int r = 0; r < 16; ++r) o[d_][r] *= al_l[crow(r, hi)];
    }
    const int qrel = wid * QBLK + r32;
    for (int j = 0; j < 4; ++j) {
        const int k0 = t0 + j * KVBLK; const bf16_t* vb_ = Vh + (size_t)k0 * DH; const bf16_t* kb_ = Kh + (size_t)k0 * DH;
        const bf16x8 v0 = *(const bf16x8*)((const char*)vb_ + stoff), v1 = *(const bf16x8*)((const char*)vb_ + stoff + 32 * DH * 2);
        const bf16x8 kk0 = *(const bf16x8*)((const char*)kb_ + stoff), kk1 = *(const bf16x8*)((const char*)kb_ + stoff + 32 * DH * 2);
        __syncthreads();
        *(bf16x8*)(V_lds + vst0) = v0; *(bf16x8*)(V_lds + vst1) = v1; *(bf16x8*)(K_lds + kws) = kk0; *(bf16x8*)(K_lds + kws + 32 * 256) = kk1;
        __syncthreads();
        if (j * KVBLK <= wid * QBLK + QBLK - 1) {
            f32x16 p0, p1; qkt<0>(p0, p1, K_lds, r32, hi, qr);
            const float* bt = colb + j * KVBLK;
#pragma unroll
            for (int g = 0; g < 4; ++g) { const f32x4 b0 = *(const f32x4*)(bt + 8 * g + 4 * hi), b1 = *(const f32x4*)(bt + 32 + 8 * g + 4 * hi);
#pragma unroll
                for (int jj = 0; jj < 4; ++jj) { const int r = 4 * g + jj, kk = j * KVBLK + jj + 8 * g + 4 * hi;
                    const float a0 = p0[r] * QK_SCALE * __builtin_amdgcn_exp2f(rowb + b0[jj]), a1 = p1[r] * QK_SCALE * __builtin_amdgcn_exp2f(rowb + b1[jj]);
                    p0[r] = kk <= qrel ? a0 : 0.f; p1[r] = kk + 32 <= qrel ? a1 : 0.f; } }
            float ps = 0.f; for (int r = 0; r < 16; ++r) ps += p0[r]; for (int r = 0; r < 16; ++r) ps += p1[r];
            { auto rr = __builtin_amdgcn_permlane32_swap(__float_as_uint(ps), __float_as_uint(ps), false, false); ps = __uint_as_float(rr[0]) + __uint_as_float(rr[1]); }
            den += ps;
            bf16x8 pa0, pa1, pa2, pa3;
#define PK4(P, B_, OUT) do { unsigned a0_ = cvtpk(P[B_+0], P[B_+1]), a1_ = cvtpk(P[B_+2], P[B_+3]); unsigned b0_ = cvtpk(P[B_+4], P[B_+5]), b1_ = cvtpk(P[B_+6], P[B_+7]); \
        auto r0_ = __builtin_amdgcn_permlane32_swap(a0_, b0_, false, false); auto r1_ = __builtin_amdgcn_permlane32_swap(a1_, b1_, false, false); \
        u32x4 w_ = {r0_[0], r1_[0], r0_[1], r1_[1]}; OUT = *reinterpret_cast<bf16x8*>(&w_); } while (0)
            PK4(p0, 0, pa0); PK4(p0, 8, pa1); PK4(p1, 0, pa2); PK4(p1, 8, pa3);
#undef PK4
            pv_tile<0>(o, vb0, pa0, pa1, pa2, pa3);
        }
    }
    if (hi == 0) li_l[r32] = 1.0f / fmaxf(fabsf(den), 1.0f); asm volatile("s_waitcnt lgkmcnt(0)" ::: "memory");
    bf16_t* Ow = Y + (size_t)(t0 + wid * QBLK) * D + 1024 + h * DH; const unsigned ooff = (unsigned)(4 * hi * D + r32) * 2u;
    const bf16_t* Mw = Mh + (size_t)(t0 + wid * QBLK) * DH; const unsigned moff = (unsigned)(4 * hi * DH + r32) * 2u;
    float gn[4];
#pragma unroll
    for (int d0 = 0; d0 < 4; ++d0) gn[d0] = ogain[h * DH + d0 * 32 + r32];
#pragma unroll
    for (int r = 0; r < 16; ++r) { const int orow0 = (r & 3) + 8 * (r >> 2); const float rl = li_l[crow(r, hi)];
        float hv[4], ss = 0.f;
#pragma unroll
        for (int d0 = 0; d0 < 4; ++d0) { hv[d0] = o[d0][r] * rl; ss += hv[d0] * hv[d0]; }
#pragma unroll
        for (int m = 1; m < 32; m <<= 1) ss += __shfl_xor(ss, m);
        const float rstd = 1.0f / sqrtf(ss * (1.0f / DH) + RMS_EPS);
#pragma unroll
        for (int d0 = 0; d0 < 4; ++d0) { const float mo = bf2f(*(const bf16_t*)((const char*)(Mw + (size_t)orow0 * DH + d0 * 32) + moff));
            const float v = hv[d0] * rstd * gn[d0] * (1.0f / (1.0f + __expf(-mo))); const float vn = __shfl_xor(v, 1);
            if ((r32 & 1) == 0) *(unsigned*)((char*)(Ow + (size_t)orow0 * D + d0 * 32) + ooff) = cvtpk(v, vn); } }
    __syncthreads();
}
#undef TRRDB
#undef FRAG8
#undef KSWZ
#undef SBAR
}

constexpr int NWAVES = 8, NTHREADS = 512;
constexpr int LDS_STAGE = 0, LDS_TILEE = 131072, LDS_TSTART = LDS_TILEE + 4 * MAXTILES, LDS_CNT = LDS_TSTART + 4 * 64, LDS_ROWOFF = 133120, LDS_ROWW = LDS_ROWOFF + 8 * 1024, LDS_CTL = LDS_ROWW + 8 * 1024, LDS_BYTES = LDS_CTL + 512;
static_assert(LDS_CNT + 4 * 32 <= LDS_ROWOFF && LDS_BYTES <= 160 * 1024 && at::ATT_LDS <= LDS_CTL, "LDS map");
constexpr int MAXU = 8;
enum { PH_INPROJ = 0, PH_OUTPROJ = 1, PH_GU = 2, PH_DOWN = 3, PH_POOLG = 4, PH_ATTN = 5, PH_MC1 = 6, PH_MC2 = 7, PH_MC3 = 8 };
struct MkArgs { const float* in[21]; float* out; unsigned char* ws; int ph_lo, ph_hi, layer, pad; };

__device__ __forceinline__ void moe_setup(LAS unsigned char* lds, const unsigned* cnt, const int* capt, const float* capw, pg::MoeOrder& S, int G, int c, unsigned lda_bytes) {
    LAS int* tileE = (LAS int*)(lds + LDS_TILEE); LAS int* tstart = (LAS int*)(lds + LDS_TSTART); LAS int* cntL = (LAS int*)(lds + LDS_CNT);
    LAS unsigned* rowoff = (LAS unsigned*)(lds + LDS_ROWOFF); LAS float* roww = (LAS float*)(lds + LDS_ROWW);
    const int tid = threadIdx.x;
    if (tid == 0) { int acc = 0; for (int e = 0; e < NEXP; ++e) { const int ce = (int)cnt[e], ntl = (ce + 255) >> 8; cntL[e] = ce; tstart[e] = acc; for (int j = 0; j < ntl; ++j) tileE[acc + j] = e; acc += ntl; } tstart[NEXP] = acc; }
    __syncthreads();
    S.nwg = tstart[NEXP] * 8; S.G = G; S.c = c; S.tileE = tileE;
    for (int s0 = 0; s0 < MAXU; s0 += 2) { const int s = s0 + (tid >> 8), r = tid & 255; pg::Unit u;
        if (S.next(s, u)) { const int e = u.pn >> 3, rank = (u.pm - tstart[e]) * 256 + r; const bool valid = rank < cntL[e];
            rowoff[s * 256 + r] = valid ? (unsigned)capt[(size_t)e * CAP + rank] * lda_bytes : 0u; roww[s * 256 + r] = valid ? capw[(size_t)e * CAP + rank] : 0.f; } }
    __syncthreads();
}

__global__ void __launch_bounds__(NTHREADS, 2) mk_fwd(MkArgs a) {
    extern __shared__ __attribute__((aligned(16))) unsigned char lds_raw[];
    LAS unsigned char* lds = (LAS unsigned char*)lds_raw;
    unsigned char* ws = a.ws; const int G = gridDim.x, bx = blockIdx.x;
    const int lo = a.ph_lo, hi = a.ph_hi;
#define IN(k) (lo <= (k) && (k) < hi)
    if (IN(PH_INPROJ)) {
        pg::Gemm g{(const bf16_t*)(ws + WS_HN), (const bf16_t*)(ws + WS_WINP), D, D, D}; pg::StaticOrder S; S.init(T, NPROJ, G, bx);
        pg::EpiP7 E{(bf16_t*)(ws + WS_P7)};
        pg::gemm_phase<pg::EpiP7, pg::StaticOrder, false>(lds + LDS_STAGE, g, S, E, nullptr, nullptr);
    }
    if (IN(PH_OUTPROJ)) {
        pg::Gemm g{(const bf16_t*)(ws + WS_Y), (const bf16_t*)(ws + WS_WOUT), D, D, D}; pg::StaticOrder S; S.init(T, D, G, bx);
        pg::EpiRes E{a.in[0], a.out, D, nullptr, nullptr};
        pg::gemm_phase<pg::EpiRes, pg::StaticOrder, false>(lds + LDS_STAGE, g, S, E, nullptr, nullptr);
    }
    if (IN(PH_GU)) {
        const int l = a.layer; const unsigned* cnt = (const unsigned*)(ws + WS_CTL) + CW_CNT + 64 * l;
        pg::MoeOrder S; moe_setup(lds, cnt, (const int*)(ws + WS_CAPT), (const float*)(ws + WS_CAPW), S, G, bx, (unsigned)(D * 2));
        pg::Gemm g{(const bf16_t*)(ws + WS_HN), (const bf16_t*)(ws + WS_WGU) + (size_t)l * NEXP * 2048 * D, D, D, D};
        pg::EpiSilu E{(bf16_t*)(ws + WS_H)};
        pg::gemm_phase<pg::EpiSilu, pg::MoeOrder, true>(lds + LDS_STAGE, g, S, E, (const LAS unsigned*)(lds + LDS_ROWOFF), (const LAS float*)(lds + LDS_ROWW));
    }
    if (IN(PH_DOWN)) {
        const int l = a.layer; const unsigned* cnt = (const unsigned*)(ws + WS_CTL) + CW_CNT + 64 * l;
        pg::MoeOrder S; moe_setup(lds, cnt, (const int*)(ws + WS_CAPT), (const float*)(ws + WS_CAPW), S, G, bx, 0u);
        pg::Gemm g{(const bf16_t*)(ws + WS_H), (const bf16_t*)(ws + WS_WD) + (size_t)l * NEXP * D * DEXP, DEXP, DEXP, DEXP};
        pg::EpiDown E{(bf16_t*)(ws + WS_YS)};
        pg::gemm_phase<pg::EpiDown, pg::MoeOrder, false>(lds + LDS_STAGE, g, S, E, nullptr, (const LAS float*)(lds + LDS_ROWW));
    }
    if (IN(PH_POOLG)) {
        pg::Gemm g{(const bf16_t*)(ws + WS_POOLED), (const bf16_t*)(ws + WS_WPOOL), D, 512, 512}; pg::StaticOrder S; S.init(T, D, G, bx, 2);
        pg::EpiRes E{a.out, a.out, D, a.in[12], a.in[13]};
        pg::gemm_phase<pg::EpiRes, pg::StaticOrder, false>(lds + LDS_STAGE, g, S, E, nullptr, nullptr);
    }
    if (IN(PH_ATTN)) {
        at::attn_phase((char*)lds_raw, (const bf16_t*)(ws + WS_P7), (const float*)(ws + WS_CF), (bf16_t*)(ws + WS_Y), G, bx);
    }
    if (IN(PH_MC1)) {
        for (int u = bx; u < NH * at::NCH; u += G) at::mlstm_c1_unit((char*)lds_raw, (const bf16_t*)(ws + WS_P7), (const float*)(ws + WS_BM), (const float*)(ws + WS_IP), (float*)(ws + WS_DC), (float*)(ws + WS_ND), u / at::NCH, u % at::NCH);
    }
    if (IN(PH_MC2)) at::mlstm_c2((const float*)(ws + WS_BM), (const float*)(ws + WS_DC), (const float*)(ws + WS_ND), (bf16_t*)(ws + WS_CST), (float*)(ws + WS_NST), G, bx);
    if (IN(PH_MC3)) {
        for (int u = bx; u < NH * at::NCH; u += G) at::mlstm_c3_unit((char*)lds_raw, (const bf16_t*)(ws + WS_P7), (const float*)(ws + WS_BM), (const float*)(ws + WS_IP), (const bf16_t*)(ws + WS_CST), (const float*)(ws + WS_NST), a.in[9], (bf16_t*)(ws + WS_Y), u / at::NCH, u % at::NCH);
    }
#undef IN
}

extern "C" void kernel_launch(void* const* d_in, const int* in_sizes, int n_in, void* d_out, int out_size, void* d_ws, size_t ws_size, hipStream_t stream) {
    if (n_in != 21 || ws_size < WS_END || out_size != T * D) { fprintf(stderr, "kernel_launch: unexpected shapes (n_in %d, ws %zu need %zu, out %d)\n", n_in, ws_size, (size_t)WS_END, out_size); return; }
    const float* x = (const float*)d_in[0]; const float* norm_mix = (const float*)d_in[1]; const float* norm_ffn = (const float*)d_in[2];
    const float* w_in = (const float*)d_in[3]; const float* fox_fb = (const float*)d_in[4]; const float* gq = (const float*)d_in[5]; const float* gk = (const float*)d_in[6];
    const float* m_ib = (const float*)d_in[7]; const float* m_fb = (const float*)d_in[8]; const float* m_og = (const float*)d_in[9]; const float* w_out = (const float*)d_in[10];
    const float* pool_w = (const float*)d_in[11]; const float* pool_b = (const float*)d_in[12]; const float* pool_scale = (const float*)d_in[13];
    const float* rgw = (const float*)d_in[14]; const float* rgb = (const float*)d_in[15]; const float* rew = (const float*)d_in[16]; const float* reb = (const float*)d_in[17];
    const float* w_gate = (const float*)d_in[18]; const float* w_up = (const float*)d_in[19]; const float* w_down = (const float*)d_in[20];
    unsigned char* ws = (unsigned char*)d_ws; float* out = (float*)d_out;
    hipMemsetAsync(ws + WS_CTL, 0, CTL_BYTES, stream);
    unsigned* ctl = (unsigned*)(ws + WS_CTL);
    bf16_t* HN = (bf16_t*)(ws + WS_HN); bf16_t* P7 = (bf16_t*)(ws + WS_P7); bf16_t* Y = (bf16_t*)(ws + WS_Y); bf16_t* H = (bf16_t*)(ws + WS_H); bf16_t* YS = (bf16_t*)(ws + WS_YS); bf16_t* POOLED = (bf16_t*)(ws + WS_POOLED);
    float* GATES = (float*)(ws + WS_GATES); float* RPROJ = (float*)(ws + WS_RPROJ); float* CF = (float*)(ws + WS_CF); float* BM = (float*)(ws + WS_BM); float* IP = (float*)(ws + WS_IP);
    int* ASGE = (int*)(ws + WS_ASGE); int* ASGR = (int*)(ws + WS_ASGR); float* ASGW = (float*)(ws + WS_ASGW); int* CAPT = (int*)(ws + WS_CAPT); float* CAPW = (float*)(ws + WS_CAPW);

    static int grid = 0;
    if (grid == 0) { int dev = 0, cus = 0; if (hipGetDevice(&dev) != hipSuccess || hipDeviceGetAttribute(&cus, hipDeviceAttributeMultiprocessorCount, dev) != hipSuccess || cus < 160) { fprintf(stderr, "kernel_launch: device query failed or too few CUs (%d)\n", cus); grid = -1; return; }
        if (hipFuncSetAttribute((const void*)mk_fwd, hipFuncAttributeMaxDynamicSharedMemorySize, LDS_BYTES) != hipSuccess) { fprintf(stderr, "kernel_launch: hipFuncSetAttribute failed\n"); grid = -1; return; }
        grid = cus; }
    if (grid < 0) return;
    MkArgs ma{}; for (int i = 0; i < 21; ++i) ma.in[i] = (const float*)d_in[i]; ma.out = out; ma.ws = ws;
#define MK(ph, lyr) do { ma.ph_lo = (ph); ma.ph_hi = (ph) + 1; ma.layer = (lyr); hipLaunchKernelGGL(mk_fwd, dim3(grid), dim3(NTHREADS), LDS_BYTES, stream, ma); } while (0)
    PrepArgs pa{}; pa.w_in = w_in; pa.w_out = w_out; pa.pool_w = pool_w; pa.w_gate = w_gate; pa.w_up = w_up; pa.w_down = w_down; pa.rgw = rgw; pa.rew = rew; pa.ws = ws;
    k_prep<<<2048, 256, 0, stream>>>(pa);
    k_norm_proj<NGATE><<<T / 4, 256, 0, stream>>>(x, norm_mix, (const float*)(ws + WS_WG), HN, GATES);
    MK(PH_INPROJ, 0);
    k_qknorm<<<16 * T / 4, 256, 0, stream>>>(P7, gq, gk);
    k_gates_scan<<<16, 1024, 0, stream>>>(GATES, fox_fb, m_ib, m_fb, CF, BM, IP);
    MK(PH_ATTN, 0);
    MK(PH_MC1, 0); MK(PH_MC2, 0); MK(PH_MC3, 0);
    MK(PH_OUTPROJ, 0);
    for (int l = 0; l < 2; ++l) {
        if (l == 1) {
            float* RSTD = GATES;
            k_rstd<<<T / 4, 256, 0, stream>>>(out, RSTD);
            k_pool<<<T * (D / 4) / 256, 256, 0, stream>>>(out, RSTD, norm_mix + D, POOLED);
            MK(PH_POOLG, 1);
        }
        unsigned* cnt = ctl + CW_CNT + 64 * l;
        k_norm_proj<NROUTE><<<T / 4, 256, 0, stream>>>(out, norm_ffn + (size_t)l * D, (const float*)(ws + WS_WR) + (size_t)l * NROUTE * D, HN, RPROJ);
        k_router<<<T / 256, 256, 0, stream>>>(RPROJ, rgb + l * NGRP, reb + l * NEXP, cnt, ASGE, ASGR, ASGW, CAPT, CAPW);
        MK(PH_GU, l);
        MK(PH_DOWN, l);
        k_combine<<<T / 4, 256, 0, stream>>>(out, YS, cnt, ASGE, ASGR);
    }
}
```

```cpp
#include <hip/hip_runtime.h>
#include <cstdio>
#include <cstdint>

#ifndef MK_CUTS
#define MK_CUTS 0
#endif
constexpr int T = 16384, D = 2048, HD = 128, NH = 8;
constexpr int INC = 7192;
constexpr int NPROJ = 7168;
constexpr int NGATE = 24;
constexpr int NEXP = 32, EPG = 8, NGRP = 4, DEXP = 1024, NROUTE = 36;
constexpr int CAP = 16384;
constexpr int HALF_ROWS = 128; constexpr int MAXTILES = 160, MAXROWS = MAXTILES * 256;
constexpr float RMS_EPS = 1e-6f, SOFTCAP = 15.0f, QK_SCALE = 0.08838834764831845f;

typedef unsigned short bf16_t;
typedef float f32x4 __attribute__((ext_vector_type(4)));
typedef unsigned u32x4 __attribute__((ext_vector_type(4)));
typedef unsigned u32x2 __attribute__((ext_vector_type(2)));

constexpr size_t al256(size_t x) { return (x + 255) & ~(size_t)255; }
constexpr size_t WS_CTL = 0, CTL_BYTES = 1u << 20;
constexpr size_t WS_WG = WS_CTL + CTL_BYTES;
constexpr size_t WS_WR = WS_WG + al256((size_t)NGATE * D * 4);
constexpr size_t WS_WINP = WS_WR + al256((size_t)2 * NROUTE * D * 4);
constexpr int NP16 = 4096, NP8 = 3072;
constexpr size_t WS_WINP8 = WS_WINP + (size_t)NP16 * D * 2;
constexpr size_t WS_WOUT = WS_WINP + al256((size_t)NPROJ * D * 2);
constexpr size_t WS_WPOOL = WS_WOUT + al256((size_t)D * D * 2);
constexpr size_t WS_WGU = WS_WPOOL + al256((size_t)4 * 512 * 512 * 2);
constexpr size_t WS_WD = WS_WGU + al256((size_t)2 * NEXP * 2048 * D * 2);
constexpr size_t WS_HN = WS_WD + al256((size_t)2 * NEXP * D * DEXP * 2);
constexpr size_t WS_GATES = WS_HN + al256((size_t)T * D * 2);
constexpr size_t WS_RPROJ = WS_GATES + al256((size_t)T * NGATE * 4);
constexpr size_t WS_P7 = WS_RPROJ + al256((size_t)T * NROUTE * 4);
constexpr size_t WS_CF = WS_P7 + al256((size_t)56 * T * HD * 2);
constexpr size_t WS_BM = WS_CF + al256((size_t)NH * T * 4);
constexpr size_t WS_IP = WS_BM + al256((size_t)NH * T * 4);
constexpr size_t WS_Y = WS_IP + al256((size_t)NH * T * 4);
constexpr size_t WS_ASGE = WS_Y + al256((size_t)T * D * 2);
constexpr size_t WS_ASGR = WS_ASGE + al256((size_t)T * 2 * 4);
constexpr size_t WS_ASGW = WS_ASGR + al256((size_t)T * 2 * 4);
constexpr size_t WS_CAPT = WS_ASGW + al256((size_t)T * 2 * 4);
constexpr size_t WS_CAPW = WS_CAPT + al256((size_t)NEXP * CAP * 4);
constexpr size_t WS_H = WS_CAPW + al256((size_t)NEXP * CAP * 4);
constexpr size_t WS_YS = WS_H + al256((size_t)MAXROWS * DEXP * 2);
constexpr size_t WS_POOLED = WS_YS + al256((size_t)MAXROWS * D * 2);
constexpr size_t WS_DC = WS_POOLED + al256((size_t)T * D * 2);
constexpr size_t WS_ND = WS_DC + al256((size_t)NH * 64 * HD * HD * 4);
constexpr size_t WS_CST = WS_ND + al256((size_t)NH * 64 * HD * 4);
constexpr size_t WS_NST = WS_CST + al256((size_t)NH * 64 * HD * HD * 2);
constexpr size_t WS_AQORD = WS_NST + al256((size_t)NH * 64 * HD * 4);
constexpr size_t WS_HN8 = WS_AQORD + 4096;
constexpr size_t WS_RSTD0 = WS_HN8 + (size_t)T * D;
constexpr size_t WS_RSTD = WS_RSTD0 + (size_t)T * 4;
constexpr size_t WS_AQORD2 = WS_RSTD + (size_t)T * 4;
constexpr size_t WS_AQCOMB = WS_AQORD2 + al256(4 * (2 + 2 * 2048));
constexpr size_t WS_END = WS_AQCOMB + 4096;
constexpr size_t WS_XB = WS_P7;
constexpr int AQ_MAXSUB = 2048, AQ_CHK = 56;
constexpr size_t WS_PO = WS_H;
constexpr size_t WS_PM = WS_PO + (size_t)AQ_MAXSUB * 256 * HD * 4;
constexpr size_t WS_PL = WS_PM + (size_t)AQ_MAXSUB * 256 * 4;
static_assert(WS_PL + (size_t)AQ_MAXSUB * 256 * 4 <= WS_DC, "attention partials must fit in the H | YS | POOLED overlay");
static_assert(WS_END <= 2147483648ull, "d_ws map exceeds the guaranteed 2 GiB");
constexpr int CW_AQ = 12288;
constexpr int CW_C3Q = 12288 + 64;
constexpr int CW_CNT = 8192, CNT_STRIDE = 64, CNT_LSTRIDE = 2048;

__device__ __forceinline__ float bf2f(bf16_t v) { return __uint_as_float(((unsigned)v) << 16); }
__device__ __forceinline__ unsigned f2bf(float f) { unsigned u = __float_as_uint(f); return (u + 0x7fffu + ((u >> 16) & 1u)) >> 16; }
__device__ __forceinline__ unsigned pk2(float lo, float hi) { return f2bf(lo) | (f2bf(hi) << 16); }
#define DPP_ADD(v, ctrl) ((v) + __builtin_bit_cast(float, __builtin_amdgcn_update_dpp(0, __builtin_bit_cast(int, (v)), (ctrl), 0xF, 0xF, false)))
__device__ __forceinline__ float wave_sum(float v) {
    v = DPP_ADD(v, 0xB1); v = DPP_ADD(v, 0x4E); v = DPP_ADD(v, 0x141); v = DPP_ADD(v, 0x140);
    const int b = __builtin_bit_cast(int, v);
    const float s0 = __builtin_bit_cast(float, __builtin_amdgcn_readlane(b, 0)), s1 = __builtin_bit_cast(float, __builtin_amdgcn_readlane(b, 16));
    const float s2 = __builtin_bit_cast(float, __builtin_amdgcn_readlane(b, 32)), s3 = __builtin_bit_cast(float, __builtin_amdgcn_readlane(b, 48));
    return (s0 + s1) + (s2 + s3);
}
__device__ __forceinline__ unsigned pk4_fp8(float a, float b, float c, float d) { int w = 0; w = __builtin_amdgcn_cvt_pk_fp8_f32(a, b, w, false); w = __builtin_amdgcn_cvt_pk_fp8_f32(c, d, w, true); return (unsigned)w; }
constexpr float W8_SCALE = 32.0f, W8_INV = 1.0f / 32.0f;
__device__ __forceinline__ float log_sigmoid(float x) { return fminf(x, 0.f) - log1pf(expf(-fabsf(x))); }
__device__ __forceinline__ float soft_cap(float x) { return SOFTCAP * tanhf(x * (1.0f / SOFTCAP)); }
__device__ __forceinline__ float sigmoidf(float x) { return 1.0f / (1.0f + expf(-x)); }

struct PrepArgs { const float *w_in, *w_out, *pool_w, *w_gate, *w_up, *w_down, *rgw, *rew; unsigned char* ws; };
constexpr int IT_INP = (D / 64) * (NPROJ / 32);
constexpr int IT_OUT = (D / 64) * (D / 32);
constexpr int IT_POOL = 4 * (512 / 64) * (512 / 32);
constexpr int IT_SMALL = IT_INP + IT_OUT + IT_POOL;
constexpr int IT_G = (D / 128) * (DEXP / 32);
constexpr int IT_DN = (DEXP / 128) * (D / 32);
constexpr int IT_EXP = 2 * NEXP * (2 * IT_G + IT_DN);
constexpr int IT_TOTAL = IT_SMALL;
struct ItemD { const float* src; bf16_t* dst; int ldn, ldk, f8; };
__device__ __forceinline__ ItemD prep_decode(const PrepArgs& a, int it) {
    unsigned char* ws = a.ws; ItemD d;
    if (it < IT_INP) {
        const int nblk = NPROJ / 32, kb = it / nblk, nb = it % nblk, n0 = nb * 32, blk = n0 >> 10;
        const int src_off[7] = {0, 1024, 2048, 3080, 4104, 5128, 6168};
        const int dpos[7] = {0, 1, 0, 2, 3, 1, 2}; const int is8[7] = {0, 0, 1, 0, 0, 1, 1};
        int so = 0, dp = 0, f8 = 0;
#pragma unroll
        for (int j = 0; j < 7; ++j) { so = (blk == j) ? src_off[j] : so; dp = (blk == j) ? dpos[j] : dp; f8 = (blk == j) ? is8[j] : f8; }
        d.src = a.w_in + (size_t)(kb * 64) * INC + so + (n0 & 1023); d.ldn = INC; d.f8 = f8; d.ldk = D;
        d.dst = f8 ? (bf16_t*)((unsigned char*)(ws + WS_WINP8) + (size_t)(dp * 1024 + (n0 & 1023)) * D + kb * 64) : (bf16_t*)(ws + WS_WINP) + (size_t)(dp * 1024 + (n0 & 1023)) * D + kb * 64; return d; }
    it -= IT_INP;
    if (it < IT_OUT) { const int nblk = D / 32, kb = it / nblk, nb = it % nblk; d.src = a.w_out + (size_t)(kb * 64) * D + nb * 32; d.ldn = D; d.dst = (bf16_t*)(ws + WS_WOUT) + (size_t)(nb * 32) * D + kb * 64; d.ldk = D; d.f8 = 0; return d; }
    it -= IT_OUT;
    if (it < IT_POOL) { const int g = it / 128, r = it % 128, kb = r / 16, nb = r % 16;
        d.src = a.pool_w + (size_t)g * 512 * 512 + (size_t)(kb * 64) * 512 + nb * 32; d.ldn = 512; d.dst = (bf16_t*)(ws + WS_WPOOL) + (size_t)g * 512 * 512 + (size_t)(nb * 32) * 512 + kb * 64; d.ldk = 512; d.f8 = 0; return d; }
    return d;
}
__device__ __forceinline__ ItemD prep_decode8(const PrepArgs& a, int it) {
    unsigned char* ws = a.ws; ItemD d; d.f8 = 1;
    const int per = 2 * IT_G + IT_DN, le = it / per; int r = it % per;
    if (r < 2 * IT_G) { const int g = r / IT_G; r %= IT_G; const int nblk = DEXP / 32, kb = r / nblk, nb = r % nblk, n0 = nb * 32;
        const float* W = (g ? a.w_up : a.w_gate) + (size_t)le * D * DEXP;
        d.src = W + (size_t)(kb * 128) * DEXP + n0; d.ldn = DEXP; d.dst = (bf16_t*)((unsigned char*)(ws + WS_WGU) + (size_t)le * 2048 * D + (size_t)(256 * (n0 >> 7) + 128 * g + (n0 & 127)) * D + kb * 128); d.ldk = D; return d; }
    r -= 2 * IT_G;
    { const int nblk = D / 32, kb = r / nblk, nb = r % nblk;
        d.src = a.w_down + (size_t)le * DEXP * D + (size_t)(kb * 128) * D + nb * 32; d.ldn = D; d.dst = (bf16_t*)((unsigned char*)(ws + WS_WD) + (size_t)le * D * DEXP + (size_t)(nb * 32) * DEXP + kb * 128); d.ldk = DEXP; return d; }
}
__device__ __forceinline__ void item_load(const ItemD& d, float (&r)[32], int lane) {
#pragma unroll
    for (int i = 0; i < 32; ++i) r[i] = __builtin_nontemporal_load(d.src + (size_t)(2 * i + (lane >> 5)) * d.ldn + (lane & 31));
}
__device__ __forceinline__ void item_store(const ItemD& d, const float (&r)[32], __attribute__((address_space(3))) float* scr, int lane) {
#pragma unroll
    for (int i = 0; i < 32; ++i) scr[(2 * i + (lane >> 5)) * 33 + (lane & 31)] = r[i];
    asm volatile("s_waitcnt lgkmcnt(0)" ::: "memory");
    if (d.f8) {
        const int n = lane >> 1, kh = lane & 1; const __attribute__((address_space(3))) float* sp = scr + (kh * 32) * 33 + n; u32x4 o0, o1;
#define P4(j) pk4_fp8(sp[(j) * 33] * W8_SCALE, sp[((j) + 1) * 33] * W8_SCALE, sp[((j) + 2) * 33] * W8_SCALE, sp[((j) + 3) * 33] * W8_SCALE)
        o0.x = P4(0); o0.y = P4(4); o0.z = P4(8); o0.w = P4(12); o1.x = P4(16); o1.y = P4(20); o1.z = P4(24); o1.w = P4(28);
#undef P4
        unsigned char* dp = (unsigned char*)d.dst + (size_t)n * d.ldk + kh * 32; *(u32x4*)dp = o0; *(u32x4*)(dp + 16) = o1;
    } else {
    const int c = lane & 7;
#pragma unroll
    for (int j = 0; j < 4; ++j) { const int n = (lane >> 3) + 8 * j; const __attribute__((address_space(3))) float* s = scr + (8 * c) * 33 + n;
        u32x4 o; o.x = pk2(s[0 * 33], s[1 * 33]); o.y = pk2(s[2 * 33], s[3 * 33]); o.z = pk2(s[4 * 33], s[5 * 33]); o.w = pk2(s[6 * 33], s[7 * 33]);
        *(u32x4*)(d.dst + (size_t)n * d.ldk + 8 * c) = o; }
    }
    asm volatile("s_waitcnt lgkmcnt(0)" ::: "memory");
}
__device__ __forceinline__ void item_load8(const ItemD& d, f32x4 (&r)[16], int lane) {
#pragma unroll
    for (int i = 0; i < 16; ++i) r[i] = __builtin_nontemporal_load((const f32x4*)(d.src + (size_t)(8 * i + (lane >> 3)) * d.ldn + (lane & 7) * 4));
}
__device__ __forceinline__ void item_store8(const ItemD& d, const f32x4 (&r)[16], __attribute__((address_space(3))) float* scr, int lane) {
#pragma unroll
    for (int i = 0; i < 16; ++i) { __attribute__((address_space(3))) float* p = scr + (8 * i + (lane >> 3)) * 33 + (lane & 7) * 4; p[0] = r[i].x; p[1] = r[i].y; p[2] = r[i].z; p[3] = r[i].w; }
    asm volatile("s_waitcnt lgkmcnt(0)" ::: "memory");
    const int n = lane >> 1, kh = lane & 1; const __attribute__((address_space(3))) float* sp = scr + (kh * 64) * 33 + n;
    unsigned char* dp = (unsigned char*)d.dst + (size_t)n * d.ldk + kh * 64;
#define P4(j) pk4_fp8(sp[(j) * 33] * W8_SCALE, sp[((j) + 1) * 33] * W8_SCALE, sp[((j) + 2) * 33] * W8_SCALE, sp[((j) + 3) * 33] * W8_SCALE)
#pragma unroll
    for (int q = 0; q < 4; ++q) { u32x4 o; o.x = P4(16 * q); o.y = P4(16 * q + 4); o.z = P4(16 * q + 8); o.w = P4(16 * q + 12); *(u32x4*)(dp + 16 * q) = o; }
#undef P4
    asm volatile("s_waitcnt lgkmcnt(0)" ::: "memory");
}
__device__ __forceinline__ void prep_loop8(const PrepArgs& a, int gw, int ngw, __attribute__((address_space(3))) float* scr, int lane) {
    int it = gw; if (it >= IT_EXP) return;
    ItemD d = prep_decode8(a, it); f32x4 r[16]; item_load8(d, r, lane);
#pragma unroll 1
    for (;;) { const int itn = it + ngw; const bool more = itn < IT_EXP;
        ItemD dn = d; f32x4 rn[16];
        if (more) { dn = prep_decode8(a, itn); item_load8(dn, rn, lane); }
        item_store8(d, r, scr, lane);
        if (!more) break;
#pragma unroll
        for (int i = 0; i < 16; ++i) r[i] = rn[i];
        d = dn; it = itn; }
}
__device__ __forceinline__ void prep_loop(const PrepArgs& a, int gw, int ngw, __attribute__((address_space(3))) float* scr, int lane) {
    int it = gw; if (it >= IT_TOTAL) return;
    __attribute__((address_space(3))) float* scr2 = scr + 64 * 33;
    ItemD d0 = prep_decode(a, it), d1 = d0; bool h1 = it + ngw < IT_TOTAL; if (h1) d1 = prep_decode(a, it + ngw);
    float r0[32], r1[32]; item_load(d0, r0, lane); if (h1) item_load(d1, r1, lane);
#pragma unroll 1
    for (;;) { const int itn = it + 2 * ngw; const bool m0 = itn < IT_TOTAL, m1 = itn + ngw < IT_TOTAL;
        ItemD dn0 = d0, dn1 = d1; float rn0[32], rn1[32];
        if (m0) { dn0 = prep_decode(a, itn); item_load(dn0, rn0, lane); }
        if (m1) { dn1 = prep_decode(a, itn + ngw); item_load(dn1, rn1, lane); }
        item_store(d0, r0, scr, lane); if (h1) item_store(d1, r1, scr2, lane);
        if (!m0) break;
#pragma unroll
        for (int i = 0; i < 32; ++i) { r0[i] = rn0[i]; r1[i] = rn1[i]; }
        d0 = dn0; d1 = dn1; h1 = m1; it = itn; }
}

constexpr int BI_PER_E = 192, BI_TOTAL = 2 * NEXP * BI_PER_E;
struct BItem { const float* src; unsigned char* dst; int ldn, ldk, gu; };
__device__ __forceinline__ BItem bi_decode(const PrepArgs& a, int b) {
    BItem d; const int le = b / BI_PER_E, r = b % BI_PER_E;
    if (r < 128) { const int g = r >> 6, r2 = r & 63, kb = r2 >> 2, nb = r2 & 3;
        d.src = (g ? a.w_up : a.w_gate) + (size_t)le * D * DEXP + (size_t)(kb * 128) * DEXP + nb * 256; d.ldn = DEXP;
        d.dst = a.ws + WS_WGU + (size_t)le * 2048 * D + (size_t)(512 * nb + 128 * g) * D + kb * 128; d.ldk = D; d.gu = 1; }
    else { const int r3 = r - 128, kb = r3 >> 3, nb = r3 & 7;
        d.src = a.w_down + (size_t)le * DEXP * D + (size_t)(kb * 128) * D + nb * 256; d.ldn = D;
        d.dst = a.ws + WS_WD + (size_t)le * D * DEXP + (size_t)(nb * 256) * DEXP + kb * 128; d.ldk = DEXP; d.gu = 0; }
    return d;
}
__device__ __forceinline__ void prep_block8(const PrepArgs& a, __attribute__((address_space(3))) unsigned char* lds, int bx, int G, int b_end = BI_TOTAL) {
    typedef __attribute__((address_space(3))) float lfloat; typedef __attribute__((address_space(3))) f32x4 lf32x4;
    constexpr int PT = 260;
    int tid = threadIdx.x; asm volatile("" : "+v"(tid));
    const int lane = tid & 63, wave = __builtin_amdgcn_readfirstlane(tid >> 6);
    lfloat* tile = (lfloat*)lds;
    int b = bx; if (b >= b_end) return;
    BItem d = bi_decode(a, b); f32x4 r[16];
#define BI_LOAD(dd, rr) do { _Pragma("unroll") for (int i = 0; i < 16; ++i) rr[i] = __builtin_nontemporal_load((const f32x4*)((dd).src + (size_t)(i * 8 + wave) * (dd).ldn) + lane); } while (0)
    BI_LOAD(d, r);
#pragma unroll 1
    for (;;) { const int bn = b + G; const bool more = bn < b_end;
#pragma unroll
        for (int i = 0; i < 16; ++i) *(lf32x4*)(tile + (i * 8 + wave) * PT + lane * 4) = r[i];
        __syncthreads();
        BItem dn = d; if (more) { dn = bi_decode(a, bn); BI_LOAD(dn, r); }
        { const int nl = tid >> 1, kh = tid & 1; const lfloat* sp = tile + (kh * 64) * PT + nl; u32x4 o[4];
#define P4(j) pk4_fp8(sp[(j) * PT] * W8_SCALE, sp[((j) + 1) * PT] * W8_SCALE, sp[((j) + 2) * PT] * W8_SCALE, sp[((j) + 3) * PT] * W8_SCALE)
#pragma unroll
          for (int q = 0; q < 4; ++q) { o[q].x = P4(16 * q); o[q].y = P4(16 * q + 4); o[q].z = P4(16 * q + 8); o[q].w = P4(16 * q + 12); }
#undef P4
          typedef __attribute__((address_space(3))) u32x4 lu32x4; __attribute__((address_space(3))) unsigned char* S8 = (__attribute__((address_space(3))) unsigned char*)tile;
          __syncthreads();
#pragma unroll
          for (int q = 0; q < 4; ++q) *(lu32x4*)(S8 + nl * 144 + kh * 64 + 16 * q) = o[q];
          __syncthreads();
#pragma unroll
          for (int rr = 0; rr < 4; ++rr) { const int line = (tid >> 3) + 64 * rr, ch = tid & 7; const u32x4 v = *(const lu32x4*)(S8 + line * 144 + ch * 16);
              *(u32x4*)(d.dst + (size_t)(d.gu ? 256 * (line >> 7) + (line & 127) : line) * d.ldk + ch * 16) = v; }
        }
        __syncthreads();
        if (!more) break;
        d = dn; b = bn; }
#undef BI_LOAD
}
constexpr int NTHREADS_NP = 512;
template <int NC>
__device__ __forceinline__ float norm_proj_row(const float* __restrict__ xrow, const float* __restrict__ g, const float* __restrict__ Wc, bf16_t* __restrict__ hnrow, int lane) {
    const f32x4* xr = (const f32x4*)xrow + lane; const f32x4* gr = (const f32x4*)g + lane;
    f32x4 v[8]; float s = 0.f;
#pragma unroll
    for (int j = 0; j < 8; ++j) { v[j] = xr[64 * j]; s += (v[j].x * v[j].x + v[j].y * v[j].y) + (v[j].z * v[j].z + v[j].w * v[j].w); }
    const float rstd = 1.0f / sqrtf(wave_sum(s) * (1.0f / D) + RMS_EPS);
    u32x2* o8 = (u32x2*)hnrow + lane;
#pragma unroll
    for (int j = 0; j < 8; ++j) { const f32x4 gg = gr[64 * j]; v[j] = v[j] * rstd * gg; u32x2 w; w.x = pk2(v[j].x, v[j].y); w.y = pk2(v[j].z, v[j].w); o8[64 * j] = w; }
    float mine = 0.f;
    for (int c = 0; c < NC; ++c) { const f32x4* wr = (const f32x4*)(Wc + (size_t)c * D) + lane; float a = 0.f;
#pragma unroll
        for (int j = 0; j < 8; ++j) { const f32x4 w = wr[64 * j]; a += (v[j].x * w.x + v[j].y * w.y) + (v[j].z * w.z + v[j].w * w.w); }
        a = wave_sum(a); mine = (lane == c) ? a : mine; }
    return mine;
}
__device__ __forceinline__ void route_token(float mine, int slot2, const float* gb, const float* eb, __attribute__((address_space(3))) unsigned* lcnt, __attribute__((address_space(3))) unsigned* lasg, int lane) {
    float gl[4]; int gs = 0;
#pragma unroll
    for (int i = 0; i < 4; ++i) gl[i] = __shfl(mine, i) + gb[i];
#pragma unroll
    for (int i = 1; i < 4; ++i) if (gl[i] > gl[gs]) gs = i;
    float se = 0.f;
#pragma unroll
    for (int i = 0; i < 4; ++i) se += expf(gl[i] - gl[gs]);
    const float gw = 1.0f / se;
    float el[8];
#pragma unroll
    for (int i = 0; i < 8; ++i) el[i] = __shfl(mine, 4 + gs * 8 + i) + eb[gs * 8 + i];
    int i0 = 0;
#pragma unroll
    for (int i = 1; i < 8; ++i) if (el[i] > el[i0]) i0 = i;
    int i1 = -1; float e1v = 0.f;
#pragma unroll
    for (int i = 0; i < 8; ++i) if (i != i0 && (i1 < 0 || el[i] > e1v)) { i1 = i; e1v = el[i]; }
    float e0v = el[0];
#pragma unroll
    for (int i = 1; i < 8; ++i) e0v = (i == i0) ? el[i] : e0v;
    const float e1 = expf(e1v - e0v); const float w0 = gw / (1.0f + e1), w1 = gw * e1 / (1.0f + e1);
    if (lane < 2) { const int ex = gs * 8 + (lane ? i1 : i0); const float ww = lane ? w1 : w0;
        const unsigned lr = __hip_atomic_fetch_add(lcnt + ex, 1u, __ATOMIC_RELAXED, __HIP_MEMORY_SCOPE_WORKGROUP);
        lasg[(slot2 + lane) * 3 + 0] = (unsigned)ex; lasg[(slot2 + lane) * 3 + 1] = lr; lasg[(slot2 + lane) * 3 + 2] = __float_as_uint(ww); }
}
struct NormProjArgs { const float* x; const bf16_t* xb; const float* g; const float* Wc; bf16_t* hn; unsigned char* hn8; float* rstd; float* gates; float* cf; float* bm; float* ip; const float* fox_fb; const float* m_ib; const float* m_fb; const float* gb; const float* eb; unsigned* cnt; int* asg_e; int* asg_r; int* capt; float* capw; };
template <int NC, int MODE>
__device__ __forceinline__ void norm_proj_block(__attribute__((address_space(3))) unsigned char* lds, const NormProjArgs& P, int rb) {
    typedef __attribute__((address_space(3))) float lfloat; typedef __attribute__((address_space(3))) f32x4 lf32x4;
    int tid = threadIdx.x; asm volatile("" : "+v"(tid));
    const int lane = tid & 63, wave = __builtin_amdgcn_readfirstlane(tid >> 6);
    const int r0 = rb * 64 + wave * 8; const unsigned loff = (unsigned)lane * 16u;
    if (MODE == 1 && tid < NEXP) ((__attribute__((address_space(3))) unsigned*)(lds + 147456))[tid] = 0u;
    float rs[8];
    { f32x4 gf[8];
#pragma unroll
      for (int j = 0; j < 8; ++j) gf[j] = *(const f32x4*)((const char*)P.g + loff + j * 1024);
      f32x4 vn[8];
#pragma unroll
      for (int j = 0; j < 8; ++j) vn[j] = *(const f32x4*)((const char*)(P.x + (size_t)r0 * D) + loff + j * 1024);
#pragma unroll 1
      for (int i = 0; i < 8; ++i) { f32x4 v[8]; float s = 0.f;
#pragma unroll
        for (int j = 0; j < 8; ++j) { v[j] = vn[j]; s += (v[j].x * v[j].x + v[j].y * v[j].y) + (v[j].z * v[j].z + v[j].w * v[j].w); }
        { const int inx = i < 7 ? i + 1 : i;
#pragma unroll
            for (int j = 0; j < 8; ++j) vn[j] = *(const f32x4*)((const char*)(P.x + (size_t)(r0 + inx) * D) + loff + j * 1024); }
        const float rstd = 1.0f / sqrtf(wave_sum(s) * (1.0f / D) + RMS_EPS);
        if (MODE == 1) { unsigned char* o1 = (unsigned char*)P.hn + (size_t)(r0 + i) * D;
#pragma unroll
            for (int j = 0; j < 8; ++j) { const f32x4 y = v[j] * rstd * gf[j]; *(unsigned*)(o1 + (loff >> 2) + j * 256) = pk4_fp8(y.x, y.y, y.z, y.w); } }
        else { char* o8 = (char*)(P.hn + (size_t)(r0 + i) * D);
#pragma unroll
        for (int j = 0; j < 8; ++j) { const f32x4 y = v[j] * rstd * gf[j]; u32x2 w; w.x = pk2(y.x, y.y); w.y = pk2(y.z, y.w); *(u32x2*)(o8 + (loff >> 1) + j * 512) = w; } }
#pragma unroll
        for (int q = 0; q < 8; ++q) rs[q] = (q == i) ? rstd : rs[q]; } }
    typedef float f32x2 __attribute__((ext_vector_type(2)));
    constexpr int NJ = (NC + 15) / 16;
    float acc[8][NJ];
#pragma unroll
    for (int q = 0; q < 8; ++q)
#pragma unroll
        for (int j = 0; j < NJ; ++j) acc[q][j] = 0.f;
    lfloat* Wl = (lfloat*)lds;
#pragma unroll 1
    for (int ch = 0; ch < 2; ++ch) {
        __syncthreads();
#pragma unroll 6
        for (int i = tid; i < NC * 256; i += NTHREADS_NP) { const int c = i >> 8, k4 = i & 255; *(lf32x4*)(Wl + c * 1024 + k4 * 4) = *(const f32x4*)(P.Wc + (size_t)c * D + ch * 1024 + k4 * 4); }
        __syncthreads();
#pragma unroll
        for (int grp = 0; grp < 2; ++grp) { f32x4 v[4][4];
#pragma unroll
            for (int j = 0; j < 4; ++j) { const f32x4 gg = *(const f32x4*)((const char*)(P.g + ch * 1024) + loff + j * 1024);
#pragma unroll
                for (int r = 0; r < 4; ++r) v[r][j] = *(const f32x4*)((const char*)(P.x + (size_t)(r0 + grp * 4 + r) * D + ch * 1024) + loff + j * 1024) * gg * rs[grp * 4 + r]; }
#pragma unroll
            for (int cj = 0; cj < NJ; ++cj) {
#pragma unroll 2
                for (int cc = 0; cc < 16; ++cc) { const int c = cj * 16 + cc; if (c < NC) { f32x4 w[4];
#pragma unroll
                    for (int j = 0; j < 4; ++j) w[j] = *((const lf32x4*)(Wl + c * 1024) + j * 64 + lane);
#pragma unroll
                    for (int r = 0; r < 4; ++r) { f32x2 a2 = {0.f, 0.f};
#pragma unroll
                        for (int j = 0; j < 4; ++j) { a2 += (f32x2){v[r][j].x, v[r][j].y} * (f32x2){w[j].x, w[j].y}; a2 += (f32x2){v[r][j].z, v[r][j].w} * (f32x2){w[j].z, w[j].w}; }
                        float a = a2.x + a2.y;
                        a = DPP_ADD(a, 0xB1); a = DPP_ADD(a, 0x4E); a = DPP_ADD(a, 0x141); a = DPP_ADD(a, 0x140);
                        acc[grp * 4 + r][cj] += ((lane & 15) == cc) ? a : 0.f; } } }
            }
        }
    }
    __syncthreads();
    lfloat* Lg = (lfloat*)lds + (size_t)wave * 8 * 48;
#pragma unroll
    for (int q = 0; q < 8; ++q)
#pragma unroll
        for (int j = 0; j < NJ; ++j) { float t = acc[q][j]; t += __shfl_xor(t, 16); t += __shfl_xor(t, 32); if (lane < 16) Lg[q * 48 + j * 16 + lane] = t; }
    asm volatile("s_waitcnt lgkmcnt(0)" ::: "memory");
    typedef __attribute__((address_space(3))) unsigned luint;
    luint* lcnt = (luint*)(lds + 147456); luint* lbase = lcnt + 32; luint* lasg = lcnt + 64;
    if (MODE == 0) {
#pragma unroll
        for (int i = lane; i < 8 * NC; i += 64) P.gates[(size_t)r0 * NC + i] = Lg[(i / NC) * 48 + (i % NC)];
    } else if (lane < 8) {
        const lfloat* lg = Lg + lane * 48;
        float gl[4]; int gs = 0;
#pragma unroll
        for (int i = 0; i < 4; ++i) gl[i] = lg[i] + P.gb[i];
        float gmax = gl[0];
#pragma unroll
        for (int i = 1; i < 4; ++i) if (gl[i] > gmax) { gmax = gl[i]; gs = i; }
        float se = 0.f;
#pragma unroll
        for (int i = 0; i < 4; ++i) se += expf(gl[i] - gmax);
        const float gw = 1.0f / se;
        float e0v = -3.0e38f, e1v = -3.0e38f; int i0 = 0, i1 = 0;
#pragma unroll
        for (int i = 0; i < 8; ++i) { const float e = lg[4 + gs * 8 + i] + P.eb[gs * 8 + i];
            if (e > e0v) { e1v = e0v; i1 = i0; e0v = e; i0 = i; } else if (e > e1v) { e1v = e; i1 = i; } }
        const float e1 = expf(e1v - e0v); const float wv[2] = {gw / (1.0f + e1), gw * e1 / (1.0f + e1)}; const int ev[2] = {gs * 8 + i0, gs * 8 + i1};
#pragma unroll
        for (int k = 0; k < 2; ++k) { const unsigned lr = __hip_atomic_fetch_add(lcnt + ev[k], 1u, __ATOMIC_RELAXED, __HIP_MEMORY_SCOPE_WORKGROUP); const int sl = ((wave * 8 + lane) * 2 + k) * 3;
            lasg[sl] = (unsigned)ev[k]; lasg[sl + 1] = lr; lasg[sl + 2] = __float_as_uint(wv[k]); }
    }
    if (MODE == 1) {
        __syncthreads();
        if (tid < NEXP) { const unsigned n = lcnt[tid]; lbase[tid] = n ? atomicAdd(P.cnt + tid * CNT_STRIDE, n) : 0u; }
        __syncthreads();
        if (tid < 128) { const int ex = (int)lasg[tid * 3], r = (int)(lbase[ex] + lasg[tid * 3 + 1]); const int row = rb * 64 + (tid >> 1);
            P.asg_e[row * 2 + (tid & 1)] = ex; P.asg_r[row * 2 + (tid & 1)] = r; P.capt[(size_t)ex * CAP + r] = row; P.capw[(size_t)ex * CAP + r] = __uint_as_float(lasg[tid * 3 + 2]); }
        __syncthreads();
        if (tid < NEXP) lcnt[tid] = 0u;
    }
    __syncthreads();
}
__device__ __forceinline__ void split3_bf16(float w, unsigned& h, unsigned& m, unsigned& l) { h = f2bf(w); const float r1 = w - __uint_as_float(h << 16); m = f2bf(r1); const float r2 = r1 - __uint_as_float(m << 16); l = f2bf(r2); }
template <int NC, int MODE>
__device__ __forceinline__ void norm_proj_block2(__attribute__((address_space(3))) unsigned char* lds, const NormProjArgs& P, int rb) {
    typedef __attribute__((address_space(3))) float lfloat; typedef __attribute__((address_space(3))) f32x4 lf32x4;
    constexpr int NCB = (NC + 15) / 16, PX = 260, KC = 256, NCHK = D / KC;
    int tid = threadIdx.x; asm volatile("" : "+v"(tid));
    const int lane = tid & 63, wave = __builtin_amdgcn_readfirstlane(tid >> 6);
    typedef short nb16x8 __attribute__((ext_vector_type(8))); typedef __attribute__((address_space(3))) nb16x8 lnb16x8; typedef __attribute__((address_space(3))) u32x2 lu32x2;
    constexpr int PB = 528;
    __attribute__((address_space(3))) unsigned char* Xb = lds; __attribute__((address_space(3))) unsigned char* Wh = lds + 64 * PB; __attribute__((address_space(3))) unsigned char* Wm = Wh + 48 * PB; __attribute__((address_space(3))) unsigned char* Wl = Wm + 48 * PB;
    lfloat* Xs = (lfloat*)lds; lfloat* Ws = Xs + 64 * PX; lfloat* Rs = MODE == 1 ? (lfloat*)(Wl + 48 * PB) : Ws + 48 * PX;
    typedef __attribute__((address_space(3))) unsigned luint;
    luint* lcnt = (luint*)(lds + 147456); luint* lbase = lcnt + 32; luint* lasg = lcnt + 64;
    if (MODE == 1 && tid < NEXP) lcnt[tid] = 0u;
    if (MODE == 1) { for (int i = tid; i < 3 * (48 - NC) * (PB / 4); i += NTHREADS_NP) { const int a_ = i / ((48 - NC) * (PB / 4)), o_ = i % ((48 - NC) * (PB / 4)); ((luint*)(Wh + a_ * 48 * PB + NC * PB))[o_] = 0u; } }
    else for (int i = tid; i < (48 - NC) * PX; i += NTHREADS_NP) Ws[NC * PX + i] = 0.f;
    const float* xrow = P.x + (size_t)(rb * 64 + wave * 8) * D + lane * 4;
    const bf16_t* xbrow = P.xb + (size_t)(rb * 64 + wave * 8) * D + lane * 4;
    f32x4 xrA[8], wrA[5], xrB[8], gA, gB; u32x2 xqA[8], xqB[8]; float ssq[8];
#pragma unroll
    for (int j = 0; j < 8; ++j) ssq[j] = 0.f;
#define NP2_FETCH(xr, xq, gx, ch_) do { gx = *(const f32x4*)(P.g + (ch_) * KC + lane * 4); _Pragma("unroll") for (int j = 0; j < 8; ++j) { if (MODE == 1) xq[j] = *(const u32x2*)(xbrow + (size_t)j * D + (ch_) * KC); else xr[j] = *(const f32x4*)(xrow + (size_t)j * D + (ch_) * KC); } } while (0)
#define NP2_FETCHW(wr, ch_) do { _Pragma("unroll") for (int j = 0; j < 5; ++j) if (j * NTHREADS_NP < NC * 64) { int i_ = tid + j * NTHREADS_NP; i_ = i_ < NC * 64 ? i_ : NC * 64 - 1;     \
            wr[j] = *(const f32x4*)(P.Wc + (size_t)(i_ >> 6) * D + (ch_) * KC + lane * 4); } } while (0)
#define NP2_PUT(xr, xq, wr, gx, ch_) do { _Pragma("unroll") for (int j = 0; j < 8; ++j) { const f32x4 xv_ = MODE == 1 ? (f32x4){__uint_as_float(xq[j].x << 16), __uint_as_float(xq[j].x & 0xffff0000u), __uint_as_float(xq[j].y << 16), __uint_as_float(xq[j].y & 0xffff0000u)} : xr[j]; \
            if (MODE == 1) *(lu32x2*)(Xb + (wave * 8 + j) * PB + lane * 8) = xq[j]; else *(lf32x4*)(Xs + (wave * 8 + j) * PX + lane * 4) = xv_; ssq[j] += (xv_.x * xv_.x + xv_.y * xv_.y) + (xv_.z * xv_.z + xv_.w * xv_.w); \
            const f32x4 y_ = xv_ * gx; const size_t e_ = (size_t)(rb * 64 + wave * 8 + j) * D + (ch_) * KC + lane * 4;     \
            if (MODE == 1) *(unsigned*)((unsigned char*)P.hn + e_) = pk4_fp8(y_.x, y_.y, y_.z, y_.w); else { u32x2 w_; w_.x = pk2(y_.x, y_.y); w_.y = pk2(y_.z, y_.w); *(u32x2*)(P.hn + e_) = w_; *(unsigned*)(P.hn8 + e_) = pk4_fp8(y_.x, y_.y, y_.z, y_.w); } } \
        _Pragma("unroll") for (int j = 0; j < 5; ++j) if (j * NTHREADS_NP < NC * 64) { const int i_ = tid + j * NTHREADS_NP; if (i_ < NC * 64) { const f32x4 wg_ = wr[j] * gx;     \
            if (MODE == 1) { unsigned h0, m0, l0, h1, m1, l1, h2, m2, l2, h3, m3, l3; split3_bf16(wg_.x, h0, m0, l0); split3_bf16(wg_.y, h1, m1, l1); split3_bf16(wg_.z, h2, m2, l2); split3_bf16(wg_.w, h3, m3, l3); \
                const int o_ = (i_ >> 6) * PB + lane * 8; *(lu32x2*)(Wh + o_) = (u32x2){h0 | (h1 << 16), h2 | (h3 << 16)}; *(lu32x2*)(Wm + o_) = (u32x2){m0 | (m1 << 16), m2 | (m3 << 16)}; *(lu32x2*)(Wl + o_) = (u32x2){l0 | (l1 << 16), l2 | (l3 << 16)}; } \
            else *(lf32x4*)(Ws + (i_ >> 6) * PX + lane * 4) = wg_; } } } while (0)
#define NP2_MMA() do { if (MODE == 1) { _Pragma("unroll") for (int ks = 0; ks < 4; ++ks) { const nb16x8 a_ = *(const lnb16x8*)(abase8 + ks * 64); \
            _Pragma("unroll") for (int cb = 0; cb < NCB; ++cb) { const nb16x8 bl_ = *(const lnb16x8*)(Wl + bbase8 + cb * 16 * PB + ks * 64), bm_ = *(const lnb16x8*)(Wm + bbase8 + cb * 16 * PB + ks * 64), bh_ = *(const lnb16x8*)(Wh + bbase8 + cb * 16 * PB + ks * 64); \
                acc[cb] = __builtin_amdgcn_mfma_f32_16x16x32_bf16(a_, bl_, acc[cb], 0, 0, 0); acc[cb] = __builtin_amdgcn_mfma_f32_16x16x32_bf16(a_, bm_, acc[cb], 0, 0, 0); acc[cb] = __builtin_amdgcn_mfma_f32_16x16x32_bf16(a_, bh_, acc[cb], 0, 0, 0); } } } \
        else _Pragma("unroll") for (int g8 = 0; g8 < 8; ++g8) { const f32x4 av = *(const lf32x4*)(abase + g8 * 16); f32x4 bv[NCB]; \
            _Pragma("unroll") for (int cb = 0; cb < NCB; ++cb) bv[cb] = *(const lf32x4*)(bbase + cb * 16 * PX + g8 * 16); \
            _Pragma("unroll") for (int e = 0; e < 4; ++e) _Pragma("unroll") for (int cb = 0; cb < NCB; ++cb) acc[cb] = __builtin_amdgcn_mfma_f32_16x16x4f32(av[e], bv[cb][e], acc[cb], 0, 0, 0); } } while (0)
    const int rbk = wave & 3, kh = wave >> 2;
    const lfloat* abase = Xs + (rbk * 16 + (lane & 15)) * PX + kh * 128 + (lane >> 4) * 4;
    const lfloat* bbase = Ws + (lane & 15) * PX + kh * 128 + (lane >> 4) * 4;
    const __attribute__((address_space(3))) unsigned char* abase8 = Xb + (rbk * 16 + (lane & 15)) * PB + (kh * 128 + (lane >> 4) * 8) * 2; const int bbase8 = (lane & 15) * PB + (kh * 128 + (lane >> 4) * 8) * 2;
    f32x4 acc[NCB];
#pragma unroll
    for (int cb = 0; cb < NCB; ++cb) acc[cb] = (f32x4){0.f, 0.f, 0.f, 0.f};
    NP2_FETCH(xrA, xqA, gA, 0); NP2_FETCH(xrB, xqB, gB, 1); NP2_FETCHW(wrA, 0);
    __syncthreads();
#pragma unroll 1
    for (int ch = 0; ch < NCHK; ch += 2) {
        NP2_PUT(xrA, xqA, wrA, gA, ch);
        __syncthreads();
        if (ch + 2 < NCHK) NP2_FETCH(xrA, xqA, gA, ch + 2);
        NP2_FETCHW(wrA, ch + 1);
        NP2_MMA();
        __syncthreads();
        NP2_PUT(xrB, xqB, wrA, gB, ch + 1);
        __syncthreads();
        if (ch + 3 < NCHK) NP2_FETCH(xrB, xqB, gB, ch + 3);
        { const int cw = ch + 2 < NCHK ? ch + 2 : ch + 1; NP2_FETCHW(wrA, cw); }
        NP2_MMA();
        __syncthreads();
    }
#undef NP2_FETCH
#undef NP2_FETCHW
#undef NP2_PUT
#undef NP2_MMA
#pragma unroll
    for (int j = 0; j < 8; ++j) { const float t = wave_sum(ssq[j]); if (lane == 0) { const float r_ = 1.0f / sqrtf(t * (1.0f / D) + RMS_EPS); Rs[wave * 8 + j] = r_; P.rstd[rb * 64 + wave * 8 + j] = r_; } }
    lfloat* Pk = Xs;
#pragma unroll
    for (int cb = 0; cb < NCB; ++cb)
#pragma unroll
        for (int r = 0; r < 4; ++r) Pk[(kh * 64 + rbk * 16 + 4 * (lane >> 4) + r) * 48 + cb * 16 + (lane & 15)] = acc[cb][r];
    __syncthreads();
    lfloat* Lg = Xs + 2 * 64 * 48;
    for (int i = tid; i < 64 * 48; i += NTHREADS_NP) Lg[i] = (Pk[i] + Pk[64 * 48 + i]) * Rs[i / 48];
    __syncthreads();
    const int r0 = rb * 64 + wave * 8;
    const lfloat* Lw = Lg + wave * 8 * 48;
    if (MODE == 0) {
        { const int col = tid & 7, row = tid >> 3; P.ip[(size_t)col * T + rb * 64 + row] = soft_cap(Lg[row * 48 + 8 + col] + P.m_ib[col]); }
        if (wave == 0) { const int cc = lane & 15, q = lane >> 4, h = cc & 7; const bool ml = cc >= 8; const int col = ml ? 16 + h : h;
            const float fb = ml ? P.m_fb[h] : P.fox_fb[h];
            float v[16]; float s = 0.f;
#pragma unroll
            for (int i = 0; i < 16; ++i) { const float z = Lg[(q * 16 + i) * 48 + col] + fb; const float lf = ml ? log_sigmoid(soft_cap(z)) : log_sigmoid(z); s += lf; v[i] = s; }
            const float t0 = __shfl(s, cc), t1 = __shfl(s, cc + 16), t2 = __shfl(s, cc + 32), t3 = __shfl(s, cc + 48);
            const float base = (q > 0 ? t0 : 0.f) + (q > 1 ? t1 : 0.f) + (q > 2 ? t2 : 0.f);
            float* out = (ml ? P.bm : P.cf) + (size_t)h * T + rb * 64 + q * 16;
#pragma unroll
            for (int i = 0; i < 16; i += 4) *(f32x4*)(out + i) = (f32x4){base + v[i], base + v[i + 1], base + v[i + 2], base + v[i + 3]};
            if (q == 0) P.gates[cc * (T / 64) + rb] = (t0 + t1) + (t2 + t3); }
    } else if (lane < 8) {
        const lfloat* lg = Lw + lane * 48;
        float gl[4]; int gs = 0;
#pragma unroll
        for (int i = 0; i < 4; ++i) gl[i] = lg[i] + P.gb[i];
        float gmax = gl[0];
#pragma unroll
        for (int i = 1; i < 4; ++i) if (gl[i] > gmax) { gmax = gl[i]; gs = i; }
        float se = 0.f;
#pragma unroll
        for (int i = 0; i < 4; ++i) se += expf(gl[i] - gmax);
        const float gw = 1.0f / se;
        float e0v = -3.0e38f, e1v = -3.0e38f; int i0 = 0, i1 = 0;
#pragma unroll
        for (int i = 0; i < 8; ++i) { const float e = lg[4 + gs * 8 + i] + P.eb[gs * 8 + i];
            if (e > e0v) { e1v = e0v; i1 = i0; e0v = e; i0 = i; } else if (e > e1v) { e1v = e; i1 = i; } }
        const float e1 = expf(e1v - e0v); const float wv[2] = {gw / (1.0f + e1), gw * e1 / (1.0f + e1)}; const int ev[2] = {gs * 8 + i0, gs * 8 + i1};
#pragma unroll
        for (int k = 0; k < 2; ++k) { const unsigned lr = __hip_atomic_fetch_add(lcnt + ev[k], 1u, __ATOMIC_RELAXED, __HIP_MEMORY_SCOPE_WORKGROUP); const int sl = ((wave * 8 + lane) * 2 + k) * 3;
            lasg[sl] = (unsigned)ev[k]; lasg[sl + 1] = lr; lasg[sl + 2] = __float_as_uint(wv[k]); }
    }
    if (MODE == 1) {
        __syncthreads();
        if (tid < NEXP) { const unsigned n = lcnt[tid]; lbase[tid] = n ? atomicAdd(P.cnt + tid * CNT_STRIDE, n) : 0u; }
        __syncthreads();
        if (tid < 128) { const int ex = (int)lasg[tid * 3], r = (int)(lbase[ex] + lasg[tid * 3 + 1]); const int row = rb * 64 + (tid >> 1);
            P.asg_e[row * 2 + (tid & 1)] = ex; P.asg_r[row * 2 + (tid & 1)] = r; P.capt[(size_t)ex * CAP + r] = row; P.capw[(size_t)ex * CAP + r] = __uint_as_float(lasg[tid * 3 + 2]); }
    }
    __syncthreads();
}
__device__ __forceinline__ void qknorm_rows8(bf16_t* rows, const float* g, int lane) {
    unsigned w[8];
#pragma unroll
    for (int i = 0; i < 8; ++i) w[i] = *((const unsigned*)(rows + (size_t)i * HD) + lane);
    const float g0 = g[2 * lane], g1 = g[2 * lane + 1];
#pragma unroll
    for (int i = 0; i < 8; ++i) { const float a = __uint_as_float(w[i] << 16), b = __uint_as_float(w[i] & 0xffff0000u);
        const float rstd = 1.0f / sqrtf(wave_sum(a * a + b * b) * (1.0f / HD) + RMS_EPS);
        w[i] = pk2(a * rstd * g0, b * rstd * g1); }
#pragma unroll
    for (int i = 0; i < 8; ++i) *((unsigned*)(rows + (size_t)i * HD) + lane) = w[i];
}
__device__ __forceinline__ void gates_scan_seq(int seq, const float* gates, const float* fox_fb, const float* m_ib, const float* m_fb, float* CF, float* BM, float* IP, __attribute__((address_space(3))) float* part) {
    const int h = seq & 7, tid = threadIdx.x; const bool ml = seq >= 8;
    float v[32], ipv[32]; float s = 0.f;
#pragma unroll
    for (int j = 0; j < 32; ++j) { const int t = tid * 32 + j; v[j] = gates[(size_t)t * NGATE + (ml ? 16 : 0) + h]; ipv[j] = ml ? gates[(size_t)t * NGATE + 8 + h] : 0.f; }
    const float fb = ml ? m_fb[h] : fox_fb[h], ib = ml ? m_ib[h] : 0.f;
#pragma unroll
    for (int j = 0; j < 32; ++j) { const float lf = ml ? log_sigmoid(soft_cap(v[j] + fb)) : log_sigmoid(v[j] + fb); s += lf; v[j] = s; }
    if (ml) {
#pragma unroll
        for (int j = 0; j < 32; j += 4) *(f32x4*)(IP + (size_t)h * T + tid * 32 + j) = (f32x4){soft_cap(ipv[j] + ib), soft_cap(ipv[j + 1] + ib), soft_cap(ipv[j + 2] + ib), soft_cap(ipv[j + 3] + ib)}; }
    part[tid] = s; __syncthreads();
    for (int o = 1; o < 512; o <<= 1) { const float a = tid >= o ? part[tid - o] : 0.f; __syncthreads(); part[tid] += a; __syncthreads(); }
    const float base = tid ? part[tid - 1] : 0.f; float* out = (ml ? BM : CF) + (size_t)h * T + tid * 32;
#pragma unroll
    for (int j = 0; j < 32; j += 4) *(f32x4*)(out + j) = (f32x4){base + v[j], base + v[j + 1], base + v[j + 2], base + v[j + 3]};
    __syncthreads();
}
__device__ __forceinline__ void gates_fixup(const float* bt, float* CF, float* BM, int rb, __attribute__((address_space(3))) float* pre) {
    const int tid = threadIdx.x, lane = tid & 63, wave = tid >> 6;
#pragma unroll
    for (int k = 0; k < 2; ++k) { const int seq = 2 * wave + k; float a = 0.f;
#pragma unroll
        for (int j = 0; j < 4; ++j) { const int idx = lane + 64 * j; const float b = bt[seq * (T / 64) + idx]; a += idx < rb ? b : 0.f; }
        a = wave_sum(a); if (lane == 0) pre[seq] = a; }
    __syncthreads();
    { const int seq = tid >> 5, r2 = (tid & 31) * 2; float* p = (seq < 8 ? CF + (size_t)seq * T : BM + (size_t)(seq - 8) * T) + rb * 64 + r2;
      typedef float f2_t __attribute__((ext_vector_type(2))); f2_t v = *(f2_t*)p; const float b = pre[seq]; v.x += b; v.y += b; *(f2_t*)p = v; }
    __syncthreads();
}
template <bool NORM>
__device__ __forceinline__ void combine_rows8(bf16_t* xb, float* xout, const unsigned char* YS, const int* asg_e, const int* asg_r, const __attribute__((address_space(3))) int* tstart, float* rstd_out, int rbase, int lane) {
    int myrow = 0;
    if (lane < 16) { const int e = asg_e[rbase * 2 + lane], r = asg_r[rbase * 2 + lane]; myrow = tstart[e] * 256 + r; }
    const unsigned loff = (unsigned)lane * 16u;
    u32x2 vn[8]; unsigned an[8], bn[8];
#define CMB_LOAD(i_) do { const int ra_ = __builtin_amdgcn_readlane(myrow, 2 * (i_)), rb_ = __builtin_amdgcn_readlane(myrow, 2 * (i_) + 1); \
        const char* xp_ = (const char*)(xb + (size_t)(rbase + (i_)) * D); const char* ap_ = (const char*)(YS + (size_t)ra_ * D); const char* bp_ = (const char*)(YS + (size_t)rb_ * D); \
        _Pragma("unroll") for (int j = 0; j < 8; ++j) { vn[j] = *(const u32x2*)(xp_ + (loff >> 1) + j * 512); an[j] = *(const unsigned*)(ap_ + (loff >> 2) + j * 256); bn[j] = *(const unsigned*)(bp_ + (loff >> 2) + j * 256); } } while (0)
    CMB_LOAD(0);
#pragma unroll
    for (int i = 0; i < 8; ++i) { f32x4 v[8]; float s = 0.f;
#pragma unroll
        for (int j = 0; j < 8; ++j) { f32x4 xx = (f32x4){__uint_as_float(vn[j].x << 16), __uint_as_float(vn[j].x & 0xffff0000u), __uint_as_float(vn[j].y << 16), __uint_as_float(vn[j].y & 0xffff0000u)}; typedef float f2_t __attribute__((ext_vector_type(2)));
            const f2_t a0 = __builtin_amdgcn_cvt_pk_f32_fp8((int)an[j], false), a1 = __builtin_amdgcn_cvt_pk_f32_fp8((int)an[j], true), b0 = __builtin_amdgcn_cvt_pk_f32_fp8((int)bn[j], false), b1 = __builtin_amdgcn_cvt_pk_f32_fp8((int)bn[j], true);
            xx.x += a0.x + b0.x; xx.y += a0.y + b0.y; xx.z += a1.x + b1.x; xx.w += a1.y + b1.y;
            v[j] = xx; s += (xx.x * xx.x + xx.y * xx.y) + (xx.z * xx.z + xx.w * xx.w); }
        if (i < 7) CMB_LOAD(i + 1);
        if (NORM) { char* xo = (char*)(xb + (size_t)(rbase + i) * D);
#pragma unroll
            for (int j = 0; j < 8; ++j) { u32x2 w; w.x = pk2(v[j].x, v[j].y); w.y = pk2(v[j].z, v[j].w); *(u32x2*)(xo + (loff >> 1) + j * 512) = w; }
            const float rstd = 1.0f / sqrtf(wave_sum(s) * (1.0f / D) + RMS_EPS); if (lane == 0) rstd_out[rbase + i] = rstd; }
        else { char* xo = (char*)(xout + (size_t)(rbase + i) * D);
#pragma unroll
            for (int j = 0; j < 8; ++j) *(f32x4*)(xo + loff + j * 1024) = v[j]; } }
#undef CMB_LOAD
}
__device__ __forceinline__ void pool_chunk(const bf16_t* xb, const float* rstd, const float* g, bf16_t* pooled, int t0, __attribute__((address_space(3))) float* rl) {
    const int c = (int)threadIdx.x * 4, w = 2 << (c >> 9);
    if (threadIdx.x < 80) { const int t = t0 - 16 + (int)threadIdx.x; rl[threadIdx.x] = t >= 0 ? rstd[t] : 0.f; }
    const f32x4 g4 = *(const f32x4*)(g + c);
    __syncthreads();
    f32x4 S = {0.f, 0.f, 0.f, 0.f};
#define CV4(q_) ((f32x4){__uint_as_float((q_).x << 16), __uint_as_float((q_).x & 0xffff0000u), __uint_as_float((q_).y << 16), __uint_as_float((q_).y & 0xffff0000u)})
    { u32x2 pre[16];
#pragma unroll
      for (int u = 0; u < 16; ++u) { const int t = t0 - 16 + u; pre[u] = (t >= 0 && u >= 16 - w) ? *(const u32x2*)(xb + (size_t)t * D + c) : (u32x2){0u, 0u}; }
#pragma unroll
      for (int u = 0; u < 16; ++u) S += CV4(pre[u]) * (g4 * rl[u]); }
#pragma unroll 1
    for (int tb = t0; tb < t0 + 64; tb += 8) { u32x2 sv[8], ov[8];
#pragma unroll
        for (int u = 0; u < 8; ++u) { const int t = tb + u; sv[u] = *(const u32x2*)(xb + (size_t)t * D + c); ov[u] = (t - w >= 0) ? *(const u32x2*)(xb + (size_t)(t - w) * D + c) : (u32x2){0u, 0u}; }
        u32x2 out[8];
#pragma unroll
        for (int u = 0; u < 8; ++u) { const int t = tb + u; const f32x4 self = CV4(sv[u]) * (g4 * rl[t - t0 + 16]); S += self; S -= CV4(ov[u]) * (g4 * rl[t - w - t0 + 16]);
            const float inv = 1.0f / (float)(t + 1 < w ? t + 1 : w); const f32x4 p = S * inv - self; out[u].x = pk2(p.x, p.y); out[u].y = pk2(p.z, p.w); }
#pragma unroll
        for (int u = 0; u < 8; ++u) *(u32x2*)(pooled + (size_t)(tb + u) * D + c) = out[u]; }
#undef CV4
    __syncthreads();
}

namespace pg {
#define LAS __attribute__((address_space(3)))
typedef short bf16x8 __attribute__((ext_vector_type(8)));
constexpr int BM = 256, BK = 64, HALF = 128, HTB = HALF * BK * 2, STAGE_BYTES = 8 * HTB, NXCD = 8, WGM = 8;
__host__ __device__ __forceinline__ int lds_byte(int r, int c) { const int st = (r >> 4) * 2 + (c >> 5), rr = r & 15, cc = c & 31, ob = rr * 64 + cc * 2; return st * 1024 + (ob ^ (((ob >> 9) & 1) << 5)); }
__host__ __device__ __forceinline__ void stage_rc(int b, int& R, int& C) { const int st = b / 1024, sb = b % 1024, swz = sb ^ (((sb >> 9) & 1) << 5); R = (st >> 1) * 16 + swz / 64; C = (st & 1) * 32 + (swz % 64) / 2; }
__host__ __device__ __forceinline__ int perm32(int rho) { const int n = rho >> 4, i = rho & 15; return 8 * (i >> 2) + 4 * n + (i & 3); }
__device__ __forceinline__ unsigned cvt_pk_bf16(float lo, float hi) { unsigned r; asm volatile("v_cvt_pk_bf16_f32 %0, %1, %2" : "=v"(r) : "v"(lo), "v"(hi)); return r; }

struct Unit { int pm, pn, ak, half; };
struct Gemm { const bf16_t* A; const bf16_t* Bt; int lda, ldb, K; };
__device__ __forceinline__ int xcd_remap(int L, int nwg) { const int q = nwg / NXCD, r = nwg % NXCD, xcd = L % NXCD, off = L / NXCD; return (xcd < r ? xcd * (q + 1) : r * (q + 1) + (xcd - r) * q) + off; }
struct StaticOrder { static constexpr bool HAS_HALF = false;
    int nM, nN, nwg, G, c, akdiv;
    __device__ void init(int M, int N, int G_, int c_, int akdiv_ = 0) { nM = M / BM; nN = N / BM; nwg = nM * nN; G = G_; c = c_; akdiv = akdiv_; }
    __device__ __forceinline__ bool next(int i, Unit& u) const {
        const int L = i * G + c; if (L >= nwg) return false;
        const int wgid = xcd_remap(L, nwg);
        const int nig = WGM * nN, gid = wgid / nig, fm = gid * WGM, gsz = (nM - fm) < WGM ? (nM - fm) : WGM;
        u.pm = fm + ((wgid % nig) % gsz); u.pn = (wgid % nig) / gsz; u.ak = akdiv ? (u.pn / akdiv) * 512 : 0; u.half = 0; return true;
    }
};
struct MoeOrder {
    static constexpr bool HAS_HALF = true; int nwg, G, c; const LAS int* tileE; const LAS int* tileS;
    __device__ __forceinline__ bool next(int i, Unit& u) const {
        const int L = i * G + c; if (L >= nwg) return false;
        const int rem = nwg - i * G, w = rem < G ? rem : G; const int k = (G & 7) ? L : i * G + (c & 7) * (w >> 3) + (c >> 3);
        const int sl = tileS[k >> 3]; u.pm = sl & 0x7fff; u.half = sl >> 15; u.pn = tileE[u.pm] * 8 + (k & 7); u.ak = 0; return true;
    }
};
template <int SET> struct EpiP7 {
    static constexpr bool PERM = true; bf16_t* P7; const float* gq; const float* gk; LAS float* tab; const float* rstd;
    __device__ __forceinline__ void operator()(const f32x4 (&acc)[2][2][4][2], const Unit& u, int, int wr, int wc, int fr, int fq, const LAS float*) const {
        const int gp = SET ? (u.pn < 4 ? 8 + u.pn : 16 + u.pn) : (u.pn < 8 ? u.pn : u.pn + 4);
        const bool qk = (SET == 0) && u.pn < 8;
        float rr[2][4];
#pragma unroll
        for (int ai = 0; ai < 2; ++ai)
#pragma unroll
            for (int m = 0; m < 4; ++m) rr[ai][m] = rstd[u.pm * BM + ai * HALF + wr * 64 + m * 16 + fr] * (SET ? W8_INV : 1.0f);
        f32x4 g0 = {1.f, 1.f, 1.f, 1.f}, g1 = g0;
        if (qk) {
#pragma unroll
            for (int ai = 0; ai < 2; ++ai)
#pragma unroll
                for (int m = 0; m < 4; ++m)
#pragma unroll
                    for (int bj = 0; bj < 2; ++bj) { const f32x4 v0 = acc[ai][bj][m][0] * rr[ai][m], v1 = acc[ai][bj][m][1] * rr[ai][m];
                        float ss = (v0[0] * v0[0] + v0[1] * v0[1]) + (v0[2] * v0[2] + v0[3] * v0[3]) + (v1[0] * v1[0] + v1[1] * v1[1]) + (v1[2] * v1[2] + v1[3] * v1[3]);
                        ss += __shfl_xor(ss, 16); ss += __shfl_xor(ss, 32);
                        if (fq == 0) tab[((ai * HALF + wr * 64 + m * 16 + fr) * 2 + bj) * 4 + wc] = ss; }
            asm volatile("s_waitcnt lgkmcnt(0)" ::: "memory"); __builtin_amdgcn_s_barrier(); asm volatile("" ::: "memory");
            const float* g = (gp < 4 ? gq : gk) + wc * 32 + 8 * fq; g0 = *(const f32x4*)g; g1 = *(const f32x4*)(g + 4);
            if (gp < 4) { g0 = g0 * (1.4426950408889634f * QK_SCALE); g1 = g1 * (1.4426950408889634f * QK_SCALE); }
        }
#pragma unroll
        for (int ai = 0; ai < 2; ++ai)
#pragma unroll
            for (int m = 0; m < 4; ++m) { const int row = u.pm * BM + ai * HALF + wr * 64 + m * 16 + fr;
#pragma unroll
                for (int bj = 0; bj < 2; ++bj) { f32x4 v0 = acc[ai][bj][m][0] * rr[ai][m], v1 = acc[ai][bj][m][1] * rr[ai][m];
                    if (qk) { const f32x4 p = *(const LAS f32x4*)(tab + ((ai * HALF + wr * 64 + m * 16 + fr) * 2 + bj) * 4);
                        const float r = 1.0f / sqrtf(((p[0] + p[1]) + (p[2] + p[3])) * (1.0f / HD) + RMS_EPS); v0 = v0 * r * g0; v1 = v1 * r * g1; }
                    u32x4 w; w.x = cvt_pk_bf16(v0[0], v0[1]); w.y = cvt_pk_bf16(v0[2], v0[3]); w.z = cvt_pk_bf16(v1[0], v1[1]); w.w = cvt_pk_bf16(v1[2], v1[3]);
                    *(u32x4*)(P7 + ((size_t)(2 * gp + bj) * T + row) * HD + wc * 32 + 8 * fq) = w; } }
    }
};
template <bool RB16, bool OB16> struct EpiRes {
    static constexpr bool PERM = false; const void* res; void* out; int ldc; const float* bias; const float* scale;
    __device__ __forceinline__ void operator()(const f32x4 (&acc)[2][2][4][2], const Unit& u, int, int wr, int wc, int fr, int fq, const LAS float*) const {
        const int col0 = u.pn * BM + wc * 32 + 4 * fq;
        f32x4 bv[2][2], sv[2][2];
#pragma unroll
        for (int bj = 0; bj < 2; ++bj)
#pragma unroll
            for (int n = 0; n < 2; ++n) { bv[bj][n] = bias ? *(const f32x4*)(bias + col0 + bj * HALF + n * 16) : (f32x4){0.f, 0.f, 0.f, 0.f}; sv[bj][n] = scale ? *(const f32x4*)(scale + col0 + bj * HALF + n * 16) : (f32x4){1.f, 1.f, 1.f, 1.f}; }
#pragma unroll
        for (int ai = 0; ai < 2; ++ai) { f32x4 rv[4][2][2]; u32x2 rq[4][2][2];
#pragma unroll
            for (int m = 0; m < 4; ++m) { const size_t off = (size_t)(u.pm * BM + ai * HALF + wr * 64 + m * 16 + fr) * ldc + col0;
#pragma unroll
                for (int bj = 0; bj < 2; ++bj)
#pragma unroll
                    for (int n = 0; n < 2; ++n) { if constexpr (RB16) rq[m][bj][n] = *(const u32x2*)((const bf16_t*)res + off + bj * HALF + n * 16); else rv[m][bj][n] = *(const f32x4*)((const float*)res + off + bj * HALF + n * 16); } }
#pragma unroll
            for (int m = 0; m < 4; ++m) { const size_t off = (size_t)(u.pm * BM + ai * HALF + wr * 64 + m * 16 + fr) * ldc + col0;
#pragma unroll
                for (int bj = 0; bj < 2; ++bj)
#pragma unroll
                    for (int n = 0; n < 2; ++n) { f32x4 r_;
                        if constexpr (RB16) { const u32x2 q_ = rq[m][bj][n]; r_ = (f32x4){__uint_as_float(q_.x << 16), __uint_as_float(q_.x & 0xffff0000u), __uint_as_float(q_.y << 16), __uint_as_float(q_.y & 0xffff0000u)}; } else r_ = rv[m][bj][n];
                        const f32x4 o_ = r_ + (acc[ai][bj][m][n] + bv[bj][n]) * sv[bj][n];
                        if constexpr (OB16) { u32x2 w_; w_.x = cvt_pk_bf16(o_.x, o_.y); w_.y = cvt_pk_bf16(o_.z, o_.w); *(u32x2*)((bf16_t*)out + off + bj * HALF + n * 16) = w_; }
                        else *(f32x4*)((float*)out + off + bj * HALF + n * 16) = o_; } } }
    }
};
struct EpiSilu {
    static constexpr bool PERM = true; unsigned char* Hb;
    __device__ __forceinline__ void operator()(const f32x4 (&acc)[2][2][4][2], const Unit& u, int ui, int wr, int wc, int fr, int fq, const LAS float* roww) const {
        const int col0 = (u.pn & 7) * HALF + wc * 32 + 8 * fq;
#pragma unroll
        for (int ai = 0; ai < 2; ++ai) if (!(ai == 1 && u.half))
#pragma unroll
            for (int m = 0; m < 4; ++m) { const int rl = ai * HALF + wr * 64 + m * 16 + fr; const size_t row = (size_t)u.pm * BM + rl; float h[8];
                const float W8_INV_R = W8_INV * roww[ui * 256 + rl];
#pragma unroll
                for (int n = 0; n < 2; ++n)
#pragma unroll
                    for (int j = 0; j < 4; ++j) { const float a = acc[ai][0][m][n][j] * W8_INV_R, up = acc[ai][1][m][n][j] * W8_INV_R; h[n * 4 + j] = __builtin_amdgcn_fmed3f(a * __builtin_amdgcn_rcpf(1.0f + __expf(-a)) * up, -448.0f, 448.0f); }
                u32x2 w; w.x = pk4_fp8(h[0], h[1], h[2], h[3]); w.y = pk4_fp8(h[4], h[5], h[6], h[7]);
                *(u32x2*)(Hb + row * DEXP + col0) = w; }
    }
};
struct EpiDown {
    static constexpr bool PERM = true; unsigned char* YSb;
    __device__ __forceinline__ void operator()(const f32x4 (&acc)[2][2][4][2], const Unit& u, int ui, int wr, int wc, int fr, int fq, const LAS float* roww) const {
        const int col0 = (u.pn & 7) * BM + wc * 32 + 8 * fq;
#pragma unroll
        for (int ai = 0; ai < 2; ++ai) if (!(ai == 1 && u.half))
#pragma unroll
            for (int m = 0; m < 4; ++m) { const int r = ai * HALF + wr * 64 + m * 16 + fr; const float w8 = roww[ui * 256 + r] * W8_INV; unsigned char* rowp = YSb + ((size_t)u.pm * BM + r) * D + col0;
#pragma unroll
                for (int bj = 0; bj < 2; ++bj) { const f32x4 v0 = acc[ai][bj][m][0] * w8, v1 = acc[ai][bj][m][1] * w8;
                    u32x2 w; w.x = pk4_fp8(v0[0], v0[1], v0[2], v0[3]); w.y = pk4_fp8(v1[0], v1[1], v1[2], v1[3]);
                    *(u32x2*)(rowp + bj * HALF) = w; } }
    }
};

template <class Epi, class Sched, bool GATHER, bool FP8 = false>
__device__ __forceinline__ void gemm_phase(LAS unsigned char* lds, const Gemm g, const Sched& S, const Epi& E, const LAS unsigned* rowoff, const LAS float* roww) {
    const int tid = threadIdx.x, wid = __builtin_amdgcn_readfirstlane(tid >> 6), lane = tid & 63, wr = wid >> 2, wc = wid & 3, fr = lane & 15, fq = lane >> 4;
    const int K = g.K; int nt = K / BK; asm volatile("" : "+s"(nt));
    unsigned voffA[2], voffB[2]; int Rst[2]; unsigned Cst2[2];
#pragma unroll
    for (int i = 0; i < 2; ++i) { int R, C; stage_rc(tid * 16 + i * 8192, R, C); const int Rb = Epi::PERM ? ((R & ~31) + perm32(R & 31)) : R;
        voffA[i] = (unsigned)(R * g.lda + C) * 2u; voffB[i] = (unsigned)(Rb * g.ldb + C) * 2u; Rst[i] = R; Cst2[i] = (unsigned)C * 2u; }
    const size_t kstep = (size_t)(BK * 2);
    const size_t hstepA = (size_t)HALF * g.lda * 2, hstepB = (size_t)HALF * g.ldb * 2, tstepA = 2 * hstepA, tstepB = 2 * hstepB;
    const unsigned ldsw = (unsigned)wid * 1024u;
    const int aoff = lds_byte(wr * 64 + fr, fq * 8), boff = lds_byte(wc * 32 + fr, fq * 8);
#define PG_SA(b, h) (((b) * 2 + (h)) * HTB)
#define PG_SB(b, h) ((4 + (b) * 2 + (h)) * HTB)
#define PG_STAGE_B(bufoff, gbase) do { _Pragma("unroll") for (int _i = 0; _i < 2; ++_i) \
        __builtin_amdgcn_global_load_lds((const unsigned*)((const char*)(gbase) + voffB[_i]), (LAS unsigned*)(lds + (bufoff) + ldsw + _i * 8192), 16, 0, 0); } while (0)
#define PG_STAGE_A(bufoff, gbase, h, OFS) do { _Pragma("unroll") for (int _i = 0; _i < 2; ++_i) \
        __builtin_amdgcn_global_load_lds((const unsigned*)((const char*)(gbase) + (OFS)[h][_i]), (LAS unsigned*)(lds + (bufoff) + ldsw + _i * 8192), 16, 0, 0); } while (0)
#define PG_LDA(dst, b, h) do { _Pragma("unroll") for (int m = 0; m < 4; ++m) { if constexpr (FP8) { dst##8[m].lo = *(const LAS i4_t*)(lds + PG_SA(b, h) + aoff + m * 2048); dst##8[m].hi = *(const LAS i4_t*)(lds + PG_SA(b, h) + aoff + m * 2048 + 1024); } \
        else { _Pragma("unroll") for (int k = 0; k < 2; ++k) dst[m][k] = *(const LAS bf16x8*)(lds + PG_SA(b, h) + aoff + m * 2048 + k * 1024); } } } while (0)
#define PG_LDB(dst, b, h) do { _Pragma("unroll") for (int n = 0; n < 2; ++n) { if constexpr (FP8) { dst##8[n].lo = *(const LAS i4_t*)(lds + PG_SB(b, h) + boff + n * 2048); dst##8[n].hi = *(const LAS i4_t*)(lds + PG_SB(b, h) + boff + n * 2048 + 1024); } \
        else { _Pragma("unroll") for (int k = 0; k < 2; ++k) dst[n][k] = *(const LAS bf16x8*)(lds + PG_SB(b, h) + boff + n * 2048 + k * 1024); } } } while (0)
#define PG_MMA(ai, bj, At, Bt) do { __builtin_amdgcn_s_setprio(1); _Pragma("unroll") for (int m = 0; m < 4; ++m) _Pragma("unroll") for (int n = 0; n < 2; ++n) { \
        if constexpr (FP8) acc[ai][bj][m][n] = __builtin_amdgcn_mfma_scale_f32_16x16x128_f8f6f4(Bt##8[n], At##8[m], acc[ai][bj][m][n], 0, 0, 0, 0x7F7F7F7F, 0, 0x7F7F7F7F); \
        else { _Pragma("unroll") for (int k = 0; k < 2; ++k) acc[ai][bj][m][n] = __builtin_amdgcn_mfma_f32_16x16x32_bf16(Bt[n][k], At[m][k], acc[ai][bj][m][n], 0, 0, 0); } } __builtin_amdgcn_s_setprio(0); } while (0)
#define PG_WAIT_V(n) asm volatile("s_waitcnt vmcnt(" #n ")" ::: "memory")
#define PG_WAIT_L(n) asm volatile("s_waitcnt lgkmcnt(" #n ")" ::: "memory")
#define PG_BAR __builtin_amdgcn_s_barrier()
#define PG_SCHED __builtin_amdgcn_sched_barrier(0)
#define PG_LOAD_OFS(o, slot) do { _Pragma("unroll") for (int _h = 0; _h < 2; ++_h) _Pragma("unroll") for (int _i = 0; _i < 2; ++_i) \
        o[_h][_i] = GATHER ? (rowoff[(slot) * 256 + _h * HALF + Rst[_i]] + Cst2[_i]) : (voffA[_i] + (unsigned)(_h * hstepA)); } while (0)
#define PG_ABASE(u) (GATHER ? (const char*)g.A + (size_t)(u).ak * 2 : (const char*)g.A + (size_t)(u).pm * tstepA + (size_t)(u).ak * 2)
    Unit cur, nxt; int ui = 0;
    if (!S.next(0, cur)) return;
    f32x4 acc[2][2][4][2];
#pragma unroll
    for (int a = 0; a < 2; ++a)
#pragma unroll
        for (int b = 0; b < 2; ++b)
#pragma unroll
            for (int m = 0; m < 4; ++m)
#pragma unroll
                for (int n = 0; n < 2; ++n) acc[a][b][m][n] = (f32x4){0.f, 0.f, 0.f, 0.f};
    typedef int i8_t __attribute__((ext_vector_type(8))); typedef int i4_t __attribute__((ext_vector_type(4)));
    bf16x8 At[4][2], B0[2][2], B1[2][2]; i8_t At8[4], B08[2], B18[2];
    unsigned ofsC[2][2];
    PG_LOAD_OFS(ofsC, 0);
    const char* cA = PG_ABASE(cur); const char* cB = (const char*)g.Bt + (size_t)cur.pn * tstepB;
    PG_STAGE_B(PG_SB(0, 0), cB); PG_STAGE_B(PG_SB(0, 1), cB + hstepB); PG_STAGE_A(PG_SA(0, 0), cA, 0, ofsC); PG_STAGE_A(PG_SA(0, 1), cA, 1, ofsC);
    if (wr == 1) PG_BAR;
    PG_WAIT_V(2); PG_BAR;
    PG_STAGE_B(PG_SB(1, 0), cB + kstep); PG_STAGE_A(PG_SA(1, 0), cA + kstep, 0, ofsC); PG_STAGE_B(PG_SB(1, 1), cB + hstepB + kstep);
    PG_WAIT_V(6); PG_BAR;
    for (;;) {
        const bool has_next = S.next(ui + 1, nxt);
        const bool hf = cur.half != 0;
        const char* nA = has_next ? PG_ABASE(nxt) : cA; const char* nB = has_next ? (const char*)g.Bt + (size_t)nxt.pn * tstepB : cB;
#define PG_KLOOP(HF_) \
        for (int t = 0; t < nt; t += 2) { \
            const bool last = (t == nt - 2); \
            asm volatile("" : "+v"(voffB[0]), "+v"(voffB[1]), "+v"(ofsC[0][0]), "+v"(ofsC[0][1]), "+v"(ofsC[1][0]), "+v"(ofsC[1][1])); \
            const char* a1 = cA + (size_t)(t + 1) * kstep; \
            const char* a2 = last ? nA : cA + (size_t)(t + 2) * kstep; const char* b2 = last ? nB : cB + (size_t)(t + 2) * kstep; \
            const char* a3 = a2 + kstep; const char* b3 = b2 + kstep; \
            PG_LDB(B0, 0, 0); PG_LDB(B1, 0, 1); PG_SCHED; PG_LDA(At, 0, 0); if (!(HF_)) PG_STAGE_A(PG_SA(1, 1), a1, 1, ofsC); \
            if (GATHER && last) PG_LOAD_OFS(ofsC, (has_next ? ui + 1 : ui)); \
            if (HF_) PG_WAIT_V(6); else PG_WAIT_V(8); PG_WAIT_L(0); PG_BAR; PG_MMA(0, 0, At, B0); PG_MMA(0, 1, At, B1); PG_BAR; PG_SCHED; \
            if (!(HF_)) PG_LDA(At, 0, 1); PG_STAGE_B(PG_SB(0, 0), b2); PG_STAGE_B(PG_SB(0, 1), b2 + hstepB); PG_STAGE_A(PG_SA(0, 0), a2, 0, ofsC); \
            if (HF_) PG_WAIT_V(6); else PG_WAIT_V(8); PG_WAIT_L(0); PG_BAR; if (!(HF_)) { PG_MMA(1, 0, At, B0); PG_MMA(1, 1, At, B1); } PG_BAR; PG_SCHED; \
            PG_LDB(B0, 1, 0); PG_LDB(B1, 1, 1); PG_SCHED; PG_LDA(At, 1, 0); if (!(HF_)) PG_STAGE_A(PG_SA(0, 1), a2, 1, ofsC); \
            if (HF_) PG_WAIT_V(6); else PG_WAIT_V(8); PG_WAIT_L(0); PG_BAR; PG_MMA(0, 0, At, B0); PG_MMA(0, 1, At, B1); PG_BAR; PG_SCHED; \
            if (!(HF_)) PG_LDA(At, 1, 1); PG_STAGE_B(PG_SB(1, 0), b3); PG_STAGE_B(PG_SB(1, 1), b3 + hstepB); PG_STAGE_A(PG_SA(1, 0), a3, 0, ofsC); \
            if (HF_) PG_WAIT_V(6); else PG_WAIT_V(8); PG_WAIT_L(0); PG_BAR; if (!(HF_)) { PG_MMA(1, 0, At, B0); PG_MMA(1, 1, At, B1); } PG_BAR; PG_SCHED; \
        }
        if (Sched::HAS_HALF && hf) {
#pragma unroll 1
            PG_KLOOP(1)
        } else {
#pragma unroll 1
            PG_KLOOP(0)
        }
#undef PG_KLOOP
        if (wr == 0) PG_BAR;
        { int t_ = (int)threadIdx.x; asm volatile("" : "+v"(t_)); const int fr_ = t_ & 15, fq_ = (t_ >> 4) & 3;
          E(acc, cur, ui, wr, wc, fr_, fq_, roww); }
        if (!has_next) break;
#pragma unroll
        for (int a = 0; a < 2; ++a)
#pragma unroll
            for (int b = 0; b < 2; ++b)
#pragma unroll
                for (int m = 0; m < 4; ++m)
#pragma unroll
                    for (int n = 0; n < 2; ++n) acc[a][b][m][n] = (f32x4){0.f, 0.f, 0.f, 0.f};
        cur = nxt; cA = nA; cB = nB; ++ui;
        if (wr == 1) PG_BAR;
    }
    PG_WAIT_V(0);
    PG_BAR;
#undef PG_SA
#undef PG_SB
#undef PG_STAGE_A
#undef PG_STAGE_B
#undef PG_LDA
#undef PG_LDB
#undef PG_MMA
#undef PG_WAIT_V
#undef PG_WAIT_L
#undef PG_BAR
#undef PG_SCHED
#undef PG_LOAD_OFS
#undef PG_ABASE
}
}

struct MkArgsFwd { const float* in[21]; float* out; unsigned char* ws; int ph_lo, ph_hi, pad0, pad1; };
namespace at {
constexpr int NTHREADS_C = 512;
typedef short bf16x8 __attribute__((ext_vector_type(8)));
typedef short s16x4 __attribute__((ext_vector_type(4)));
typedef float f32x16 __attribute__((ext_vector_type(16)));
typedef float f32x2v __attribute__((ext_vector_type(2)));
constexpr int NW = 8, QBLK = 32, KVBLK = 64, QB = NW * QBLK, DH = 128;
constexpr int SHM_V = KVBLK * DH * 2, SHM_K = KVBLK * DH * 2;
constexpr int OFF_WS = 2 * SHM_V + 2 * SHM_K, OFF_BIAS = OFF_WS + NW * 64 * 4, BIAS_BYTES = 65536, ATT_LDS = OFF_BIAS + BIAS_BYTES;
constexpr float LOG2E = 1.4426950408889634f, C2 = LOG2E * QK_SCALE, THR2 = 8.f * LOG2E;
#define KSWZ(row, colB) ((row) * 256 + ((colB) ^ (((row) & 7) << 4)))
#define SBAR() __builtin_amdgcn_sched_barrier(0)
__device__ __forceinline__ int v_st(int k, int c) { const int kk = (k & ~0xC) | ((k & 4) << 1) | ((k & 8) >> 1); return ((kk >> 3) * 4 + (c >> 5)) * 512 + ((kk & 7) * 32 + (c & 31)) * 2; }
__device__ __forceinline__ int v_rd_base(int lane) { return ((lane & 3) << 3) | (((lane >> 2) & 3) << 6) | (((lane >> 4) & 1) << 5) | (((lane >> 5) & 1) << 8); }
constexpr int v_rd_off(int d0, int ks, int half) { return d0 * 512 + ks * 4096 + half * 2048; }
__device__ __forceinline__ int crow(int r, int hi) { return (r & 3) + 8 * (r >> 2) + 4 * hi; }
__device__ __forceinline__ unsigned cvtpk(float lo, float hi) { unsigned r; asm volatile("v_cvt_pk_bf16_f32 %0, %1, %2" : "=v"(r) : "v"(lo), "v"(hi)); return r; }
__device__ __forceinline__ bf16x8 load8(const bf16_t* p) { return *reinterpret_cast<const bf16x8*>(p); }
__device__ __forceinline__ void mask_tile(f32x16& p0, f32x16& p1, int dq) {
    const float NEG = -__builtin_inff();
#pragma unroll
    for (int r = 0; r < 16; ++r) { const int c = (r & 3) + 8 * (r >> 2); if (dq - c < 0) p0[r] = NEG; if (dq - c - 32 < 0) p1[r] = NEG; }
}
__device__ __forceinline__ void bias_scale(f32x16& p0, f32x16& p1, const LAS float* bt, int hi) {
#pragma unroll
    for (int g = 0; g < 4; ++g) { const f32x4 b0 = *(const LAS f32x4*)(bt + 8 * g + 4 * hi);
#pragma unroll
        for (int j = 0; j < 4; ++j) p0[4 * g + j] = fmaf(p0[4 * g + j], C2, b0[j]); }
#pragma unroll
    for (int g = 0; g < 4; ++g) { const f32x4 b1 = *(const LAS f32x4*)(bt + 32 + 8 * g + 4 * hi);
#pragma unroll
        for (int j = 0; j < 4; ++j) p1[4 * g + j] = fmaf(p1[4 * g + j], C2, b1[j]); }
}
__device__ __forceinline__ void partialSM(f32x16& p0, f32x16& p1, float& m_reg, float& mn, float& alpha) {
    float pmax = p0[0]; for (int r = 1; r < 16; ++r) pmax = fmaxf(pmax, p0[r]); for (int r = 0; r < 16; ++r) pmax = fmaxf(pmax, p1[r]);
    { auto rr = __builtin_amdgcn_permlane32_swap(__float_as_uint(pmax), __float_as_uint(pmax), false, false); pmax = fmaxf(__uint_as_float(rr[0]), __uint_as_float(rr[1])); }
    if (__builtin_expect(__all((pmax - m_reg) <= THR2), 1)) { mn = m_reg; alpha = 1.f; }
    else { mn = fmaxf(m_reg, pmax); alpha = __builtin_amdgcn_exp2f(m_reg - mn); m_reg = mn; }
    for (int r = 0; r < 16; ++r) p0[r] = p0[r] - mn; for (int r = 0; r < 16; ++r) p1[r] = p1[r] - mn;
    for (int r = 0; r < 16; ++r) p0[r] = __builtin_amdgcn_exp2f(p0[r]);
}
__device__ __forceinline__ void finishSM(f32x16& p0, f32x16& p1, float alpha, float& l_reg, bf16x8& pa0, bf16x8& pa1, bf16x8& pa2, bf16x8& pa3) {
    for (int r = 0; r < 16; ++r) p1[r] = __builtin_amdgcn_exp2f(p1[r]);
    float ps = 0; for (int r = 0; r < 16; ++r) ps += p0[r]; for (int r = 0; r < 16; ++r) ps += p1[r];
    { auto rr = __builtin_amdgcn_permlane32_swap(__float_as_uint(ps), __float_as_uint(ps), false, false); ps = __uint_as_float(rr[0]) + __uint_as_float(rr[1]); }
    l_reg = l_reg * alpha + ps;
#define PK4(P, B_, OUT) do { unsigned a0 = cvtpk(P[B_+0], P[B_+1]), a1 = cvtpk(P[B_+2], P[B_+3]);                          \
        unsigned b0 = cvtpk(P[B_+4], P[B_+5]), b1 = cvtpk(P[B_+6], P[B_+7]);                                             \
        auto r0 = __builtin_amdgcn_permlane32_swap(a0, b0, false, false); auto r1 = __builtin_amdgcn_permlane32_swap(a1, b1, false, false); \
        u32x4 w = {r0[0], r1[0], r0[1], r1[1]}; OUT = *reinterpret_cast<bf16x8*>(&w); } while (0)
    PK4(p0, 0, pa0); PK4(p0, 8, pa1); PK4(p1, 0, pa2); PK4(p1, 8, pa3);
#undef PK4
}
template <int KB>
__device__ __forceinline__ void qkt(f32x16& p0, f32x16& p1, const char* K_lds, int r32, int hi, const bf16x8* qr, const LAS float* bt = nullptr) {
    if (bt) {
#pragma unroll
        for (int g = 0; g < 4; ++g) { const f32x4 b0 = *(const LAS f32x4*)(bt + 8 * g), b1 = *(const LAS f32x4*)(bt + 32 + 8 * g);
#pragma unroll
            for (int j = 0; j < 4; ++j) { p0[4 * g + j] = b0[j]; p1[4 * g + j] = b1[j]; } }
    } else { p0 = f32x16{}; p1 = f32x16{}; }
    const char* kb[4];
#pragma unroll
    for (int dd = 0; dd < 4; ++dd) kb[dd] = K_lds + KB * SHM_K + KSWZ(r32, (dd * 16 + hi * 8) * 2);
#pragma unroll
    for (int d0 = 0; d0 < 8; ++d0) { const char* a = kb[d0 & 3] + (d0 >> 2) * 128;
        bf16x8 b0 = *reinterpret_cast<const bf16x8*>(a);
        bf16x8 b1 = *reinterpret_cast<const bf16x8*>(a + 32 * 256);
        p0 = __builtin_amdgcn_mfma_f32_32x32x16_bf16(b0, qr[d0], p0, 0, 0, 0);
        p1 = __builtin_amdgcn_mfma_f32_32x32x16_bf16(b1, qr[d0], p1, 0, 0, 0); }
}
template <int VB>
__device__ __forceinline__ void pv_tile(f32x16* o, int vb0, bf16x8 pa0, bf16x8 pa1, bf16x8 pa2, bf16x8 pa3) {
#define TRRD(dst, off) asm volatile("ds_read_b64_tr_b16 %0, %1 offset:%2" : "=&v"(dst) : "v"(vb0), "i"(off) : "memory")
#define PV_D0(d0) do { s16x4 l0, l1, l2, l3, h0, h1, h2, h3; constexpr int b_ = VB * SHM_V + v_rd_off(d0, 0, 0); \
        TRRD(l0, b_); TRRD(h0, b_ + 2048); TRRD(l1, b_ + 4096); TRRD(h1, b_ + 6144); TRRD(l2, b_ + 8192); TRRD(h2, b_ + 10240); TRRD(l3, b_ + 12288); TRRD(h3, b_ + 14336); \
        asm volatile("s_waitcnt lgkmcnt(0)" ::: "memory"); SBAR();   \
        o[d0] = __builtin_amdgcn_mfma_f32_32x32x16_bf16(pa0, (bf16x8){l0[0], l0[1], l0[2], l0[3], h0[0], h0[1], h0[2], h0[3]}, o[d0], 0, 0, 0);   \
        o[d0] = __builtin_amdgcn_mfma_f32_32x32x16_bf16(pa1, (bf16x8){l1[0], l1[1], l1[2], l1[3], h1[0], h1[1], h1[2], h1[3]}, o[d0], 0, 0, 0);   \
        o[d0] = __builtin_amdgcn_mfma_f32_32x32x16_bf16(pa2, (bf16x8){l2[0], l2[1], l2[2], l2[3], h2[0], h2[1], h2[2], h2[3]}, o[d0], 0, 0, 0);   \
        o[d0] = __builtin_amdgcn_mfma_f32_32x32x16_bf16(pa3, (bf16x8){l3[0], l3[1], l3[2], l3[3], h3[0], h3[1], h3[2], h3[3]}, o[d0], 0, 0, 0); } while (0)
    PV_D0(0); PV_D0(1); PV_D0(2); PV_D0(3);
#undef PV_D0
#undef TRRD
}
struct BlockRef { int h, qb, jlo, jhi, part; };
struct AttnPtrs { unsigned char* ws; };
#define AP_P7(p) ((const bf16_t*)((p).ws + WS_P7))
#define BR_Q(p, r) (AP_P7(p) + ((size_t)(r).h * T + (size_t)(r).qb * QB) * DH)
#define BR_K(p, r) (AP_P7(p) + (size_t)(8 + (r).h) * T * DH)
#define BR_V(p, r) (AP_P7(p) + (size_t)(16 + (r).h) * T * DH)
#define BR_O(p, r) ((bf16_t*)((p).ws + WS_Y) + (size_t)(r).qb * QB * D + (r).h * DH)
#define BR_CB(p, r) ((const float*)((p).ws + WS_CF) + (size_t)(r).h * T)
struct Seam { bf16x8 qr[8]; bf16x8 st_v0, st_v1, st_k0, st_k1; };
#define LDG8(ubase, voff) (*(const bf16x8*)((const char*)(ubase) + (voff)))
#define VMW() asm volatile("s_waitcnt vmcnt(0)" ::: "memory")
#define VMWN(n) asm volatile("s_waitcnt vmcnt(%0)" :: "i"(n) : "memory")
#define SLOAD_H(Kp, Vp, k0) do { const bf16_t* vb_ = (Vp) + (size_t)(k0) * DH; const bf16_t* kb_ = (Kp) + (size_t)(k0) * DH; \
        S.st_v0 = LDG8(vb_, stoff); S.st_v1 = LDG8(vb_, stoff + 32 * DH * 2); S.st_k0 = LDG8(kb_, stoff); S.st_k1 = LDG8(kb_, stoff + 32 * DH * 2); } while (0)
#define SWRITE_HK(bf) do { *(bf16x8*)(K_lds + (bf) * SHM_K + kws) = S.st_k0; *(bf16x8*)(K_lds + (bf) * SHM_K + kws + 32 * 256) = S.st_k1; } while (0)
#define SWRITE_HV(bf) do { *(bf16x8*)(V_lds + (bf) * SHM_V + vst0) = S.st_v0; *(bf16x8*)(V_lds + (bf) * SHM_V + vst1) = S.st_v1; } while (0)
#define SWRITE_H(bf) do { SWRITE_HV(bf); SWRITE_HK(bf); } while (0)
__device__ __forceinline__ void attn_prime(const AttnPtrs& pp, const BlockRef& cur, char* lds, Seam& S) {
    const int tid = threadIdx.x, wid = __builtin_amdgcn_readfirstlane(tid >> 6), lane = tid & 63, r32 = lane & 31, hi = lane >> 5;
    const int sr = tid >> 4, sc = (tid & 15) * 8, kws = KSWZ(sr, sc * 2); char* K_lds = lds + 2 * SHM_V;
    const unsigned stoff = (unsigned)(sr * DH + sc) * 2u, qoff = (unsigned)(r32 * DH + hi * 8) * 2u;
    const int kb0 = cur.jlo * KVBLK;
    { const bf16_t* qb_ = BR_Q(pp, cur) + (size_t)(wid * QBLK) * DH;
#pragma unroll
      for (int d0 = 0; d0 < 8; ++d0) S.qr[d0] = LDG8(qb_, qoff + d0 * 32); }
    SLOAD_H(BR_K(pp, cur), BR_V(pp, cur), kb0); VMW(); SWRITE_HK(0);
    __syncthreads();
}
__device__ __forceinline__ void attn_block(const AttnPtrs& pp, const BlockRef& cur, const BlockRef& nxt, int ldo, char* lds, Seam& S) {
    const int tid = threadIdx.x, wid = __builtin_amdgcn_readfirstlane(tid >> 6), lane = tid & 63, r32 = lane & 31, hi = lane >> 5;
    const int P0 = cur.qb * QB; const int j_lo = cur.jlo, j_hi = cur.jhi;
    const int NT = j_hi - j_lo;
    const int kbn = nxt.jlo * KVBLK;
    const int qlo = P0 + wid * QBLK, qm = qlo + r32 - 4 * hi;
    char* V_lds = lds; char* K_lds = lds + 2 * SHM_V;
    float* ws = (float*)(lds + OFF_WS) + wid * 64; float* li_l = ws, * al_l = ws + 32;
    float* bias_l = (float*)(lds + OFF_BIAS); const LAS float* btp = (const LAS float*)bias_l + 4 * hi;
    { const float* cb_ = BR_CB(pp, cur); const float cref = cb_[P0]; const int nk = (j_hi - j_lo) * KVBLK; const float* csrc = cb_ + j_lo * KVBLK;
      const LAS float* bl_ = (const LAS float*)bias_l;
      unsigned i0_ = (unsigned)tid * 16u; asm volatile("" : "+v"(i0_));
#pragma unroll 1
      for (unsigned i = i0_; i < (unsigned)nk * 4u; i += 512u * 16u) { const f32x4 c4 = *(const f32x4*)((const char*)csrc + i); *(LAS f32x4*)((LAS char*)bl_ + i) = (cref - c4) * LOG2E; } }
    float m_reg = -1e30f, l_reg = 0; f32x16 o[4] = {};
#define TIDQ() ({ int t_ = (int)threadIdx.x; asm volatile("" : "+v"(t_)); t_; })
#define stoff ((unsigned)TIDQ() * 16u)
#define vst0 ({ const int t_ = TIDQ(); v_st(t_ >> 4, (t_ & 15) * 8); })
#define vst1 (vst0 + 8192)
#define kws ({ const int t_ = TIDQ(); KSWZ(t_ >> 4, (t_ & 15) * 16); })
#define qoff ({ const int t_ = TIDQ(); (unsigned)(((t_ & 31) * DH + ((t_ >> 5) & 1) * 8) * 2); })
    const int vb0 = (int)(uintptr_t)V_lds + v_rd_base(lane);
    const bf16_t* Kh = BR_K(pp, cur); const bf16_t* Vh = BR_V(pp, cur);
#define RESC(a) do { if (__any((a) < 1.f)) { if (hi == 0) al_l[r32] = (a); asm volatile("s_waitcnt lgkmcnt(0)" ::: "memory");              \
                     for (int d_ = 0; d_ < 4; ++d_) for (int r = 0; r < 16; ++r) o[d_][r] *= al_l[crow(r, hi)]; } } while (0)
#define KBASE(t) ((j_lo + (t)) * KVBLK)
#define MASKT(P0_, P1_, t) do { const int kb_ = KBASE(t); if (kb_ + KVBLK - 1 > qlo) mask_tile(P0_, P1_, qm - kb_); } while (0)
#define QKTB(KB_, P0_, P1_) do { qkt<KB_>(P0_, P1_, K_lds, r32, hi, S.qr, btp); btp += KVBLK; asm volatile("" : "+v"(btp)); } while (0)
    constexpr int NQL = 8;
#define SEAM_K0() do { VMWN(NQL); SWRITE_HK(0); SBAR(); } while (0)
    f32x16 pA0, pA1, pB0, pB1; float mnA, mnB, alA, alB; bf16x8 pa0, pa1, pa2, pa3;
    SWRITE_HV(0); SBAR();
    if (NT > 1) SLOAD_H(Kh, Vh, KBASE(1));
    __syncthreads();
    SBAR(); QKTB(0, pA0, pA1);
    MASKT(pA0, pA1, 0); partialSM(pA0, pA1, m_reg, mnA, alA);
    if (NT > 1) { VMW(); SWRITE_H(1); }
    __syncthreads();
#define HALF_STEP(PX0, PX1, mnX, alX, PY0, PY1, alY, t, KB, VB, SB) do {                                                      \
        SBAR(); QKTB(KB, PX0, PX1);                                             \
        finishSM(PY0, PY1, alY, l_reg, pa0, pa1, pa2, pa3); SBAR();                                                           \
        if ((t) + 1 < NT) { SLOAD_H(Kh, Vh, KBASE((t) + 1)); SBAR(); }                                               \
        pv_tile<VB>(o, vb0, pa0, pa1, pa2, pa3); MASKT(PX0, PX1, (t)); partialSM(PX0, PX1, m_reg, mnX, alX);                                        \
        __syncthreads();                                                                                                      \
        if ((t) + 1 < NT) { VMW(); SWRITE_H(SB); }                                                                          \
        RESC(alX); __syncthreads(); } while (0)
    for (int t = 1; t + 1 < NT; t += 2) {
        HALF_STEP(pB0, pB1, mnB, alB, pA0, pA1, alA, t, 1, 0, 0);
        HALF_STEP(pA0, pA1, mnA, alA, pB0, pB1, alB, t + 1, 0, 1, 1);
    }
    const bool even = (NT & 1) == 0;
    if (even) { SBAR(); QKTB(1, pB0, pB1); SBAR(); }
    { SLOAD_H(BR_K(pp, nxt), BR_V(pp, nxt), kbn); SBAR();
      const bf16_t* qb_ = BR_Q(pp, nxt) + (size_t)(wid * QBLK) * DH;
#pragma unroll
        for (int d0 = 0; d0 < 8; ++d0) S.qr[d0] = LDG8(qb_, qoff + d0 * 32); }
    SBAR();
    finishSM(pA0, pA1, alA, l_reg, pa0, pa1, pa2, pa3); SBAR();
    pv_tile<0>(o, vb0, pa0, pa1, pa2, pa3);
    if (even) { MASKT(pB0, pB1, NT - 1); partialSM(pB0, pB1, m_reg, mnB, alB); __syncthreads(); RESC(alB);
        finishSM(pB0, pB1, alB, l_reg, pa0, pa1, pa2, pa3); SBAR(); pv_tile<1>(o, vb0, pa0, pa1, pa2, pa3); }
    SBAR(); SEAM_K0();
    if (cur.part == 0) {
    if (hi == 0) li_l[r32] = l_reg; asm volatile("s_waitcnt lgkmcnt(0)" ::: "memory");
    float rli[16];
#pragma unroll
    for (int r = 0; r < 16; ++r) rli[r] = __builtin_amdgcn_rcpf(li_l[crow(r, hi)]);
    bf16_t* Ow = BR_O(pp, cur) + (size_t)(wid * QBLK) * ldo; const unsigned ooff = (unsigned)(4 * hi * ldo + r32) * 2u;
#pragma unroll
    for (int r = 0; r < 16; ++r) { const int orow0 = (r & 3) + 8 * (r >> 2);
#pragma unroll
        for (int d0 = 0; d0 < 4; ++d0) { const float v = o[d0][r] * rli[r]; const float vn = __shfl_xor(v, 1);
            if ((r32 & 1) == 0) *(unsigned*)((char*)(Ow + (size_t)orow0 * ldo + d0 * 32) + ooff) = cvtpk(v, vn); } }
    } else {
        const size_t sidx = (size_t)(cur.part - 1);
        unsigned poff = (unsigned)(4 * hi * DH + r32) * 4u, mlo = (unsigned)r32 * 4u; asm volatile("" : "+v"(poff), "+v"(mlo));
        float* Pw = (float*)(pp.ws + WS_PO) + (sidx * QB + (size_t)(wid * QBLK)) * DH;
#pragma unroll
        for (int r = 0; r < 16; ++r) { const int orow0 = (r & 3) + 8 * (r >> 2);
#pragma unroll
            for (int d0 = 0; d0 < 4; ++d0) *(float*)((char*)(Pw + (size_t)orow0 * DH + d0 * 32) + poff) = o[d0][r]; }
        if (hi == 0) { *(float*)((char*)((float*)(pp.ws + WS_PM) + sidx * QB + wid * QBLK) + mlo) = m_reg; *(float*)((char*)((float*)(pp.ws + WS_PL) + sidx * QB + wid * QBLK) + mlo) = l_reg; }
    }
    __syncthreads();
#undef TIDQ
#undef stoff
#undef vst0
#undef vst1
#undef kws
#undef qoff
#undef RESC
#undef KBASE
#undef MASKT
#undef QKTB
#undef SEAM_K0
#undef HALF_STEP
}
#undef LDG8
#undef VMW
#undef VMWN
#undef SLOAD_H
#undef SWRITE_HK
#undef SWRITE_HV
#undef SWRITE_H
__device__ __forceinline__ void attn_plan(char* lds, const float* BT, const float* gq, const float* gk, unsigned* ORD, unsigned* ORD2, unsigned* COMB) {
    unsigned* keys = (unsigned*)lds; unsigned* jl = keys + 512; float* pf = (float*)(keys + 2048); float* red = pf + 2048;
    const int tid = threadIdx.x, h = tid >> 6, qb = tid & 63;
    { float m = tid < 128 ? fabsf(gq[tid]) : (tid < 256 ? fabsf(gk[tid - 128]) : 0.f);
#pragma unroll
      for (int o = 32; o > 0; o >>= 1) m = fmaxf(m, __shfl_xor(m, o));
      if (qb == 0) red[h] = m;
      const f32x4 b = *(const f32x4*)(BT + h * (T / 64) + 4 * qb); const float s0 = b.x, s1 = s0 + b.y, s2 = s1 + b.z, s3 = s2 + b.w; float inc = s3;
#pragma unroll
      for (int o = 1; o < 64; o <<= 1) { const float t = __shfl_up(inc, o); inc += qb >= o ? t : 0.f; }
      const float ex = inc - s3; *(f32x4*)(pf + h * 256 + 4 * qb) = (f32x4){ex + s0, ex + s1, ex + s2, ex + s3}; }
    __syncthreads();
    const float mq = fmaxf(red[0], red[1]), mk = fmaxf(red[2], red[3]);
    const float thr = -(104.0f + 2.0f * 11.3137085f * mq * mk * 1.02f);
    const float* cf = pf + h * 256; const float cP = qb ? cf[4 * qb - 1] : 0.f;
    int lo = 0, hi = 4 * qb;
    while (lo < hi) { const int mid = (lo + hi) >> 1; if (cP - cf[mid] >= thr) hi = mid; else lo = mid + 1; }
    jl[tid] = (unsigned)lo; keys[tid] = ((unsigned)(4 * (qb + 1) - lo) << 16) | (unsigned)tid;
    for (int k = 2; k <= 512; k <<= 1)
        for (int j = k >> 1; j > 0; j >>= 1) { __syncthreads(); const int ixj = tid ^ j;
            if (ixj > tid) { const unsigned a = keys[tid], b = keys[ixj]; const bool desc = (tid & k) == 0; if (desc ? (a < b) : (a > b)) { keys[tid] = b; keys[ixj] = a; } } }
    __syncthreads();
    unsigned* pre = jl + 512;
    const unsigned key = keys[tid], idx = key & 0xffffu, cost = key >> 16, nch0 = (cost + AQ_CHK - 1) / AQ_CHK, nch = nch0 < 4u ? nch0 : 4u;
    pre[tid] = nch; __syncthreads();
    for (int o = 1; o < 512; o <<= 1) { const unsigned a = tid >= o ? pre[tid - o] : 0u; __syncthreads(); pre[tid] += a; __syncthreads(); }
    const unsigned base = pre[tid] - nch, total = pre[511];
    { const unsigned hh = idx >> 6, qq = idx & 63u, j0 = jl[idx], jh = 4u * (qq + 1u), len = (cost + nch - 1) / nch;
      for (unsigned k = 0; k < nch; ++k) { const unsigned ja = j0 + k * len, jb = (ja + len < jh) ? ja + len : jh, sidx = base + k;
          ORD2[1 + 2 * sidx] = hh | (qq << 8) | (ja << 16); ORD2[2 + 2 * sidx] = jb | ((nch > 1 ? sidx + 1u : 0u) << 12); }
      COMB[tid] = base | (nch << 16) | (hh << 20) | (qq << 24); }
    if (tid == 0) ORD2[0] = total;
    (void)ORD;
    __syncthreads();
}
constexpr int OFF_Q = 140000;
__device__ __forceinline__ void aq_decode(const unsigned* ORD2, unsigned n, BlockRef& b) {
    const unsigned w0 = ORD2[1 + 2 * n], w1 = ORD2[2 + 2 * n];
    b.h = (int)(w0 & 0xffu); b.qb = (int)((w0 >> 8) & 0xffu); b.jlo = (int)(w0 >> 16); b.jhi = (int)(w1 & 0xfffu); b.part = (int)(w1 >> 12);
}
constexpr int AQ_CONV_PER = 16, AQ_NCONV = BI_TOTAL / AQ_CONV_PER;
static_assert(BI_TOTAL % AQ_CONV_PER == 0, "copy work-items");
__device__ __forceinline__ void attn_phase(char* lds, unsigned char* ws, const unsigned* ORD2, unsigned* qctr, __attribute__((address_space(3))) unsigned char* ldsl) {
    unsigned* qw = (unsigned*)(lds + OFF_Q);
    const int tid = threadIdx.x;
    int par = 0;
#define AQ_FETCH() ({ if (tid == 0) { qw[par] = atomicAdd(qctr, 1u); qw[2] = ORD2[0]; } __syncthreads(); const unsigned v_ = qw[par]; par ^= 1; v_; })
    unsigned n = AQ_FETCH();
    const unsigned nsub = qw[2], nq = nsub + AQ_NCONV;
#define AQ_CNUM(p) ((unsigned)(((unsigned long long)(p) * (unsigned)AQ_NCONV) / nq))
#define AQ_ISCONV(p) (AQ_CNUM((p) + 1u) > AQ_CNUM(p))
    AttnPtrs pp; pp.ws = ws;
    while (n < nq) {
        if (AQ_ISCONV(n)) {
            const int c = (int)AQ_CNUM(n);
            { const auto A = (const __attribute__((address_space(4))) MkArgsFwd*)__builtin_amdgcn_kernarg_segment_ptr();
              PrepArgs pa; pa.w_in = nullptr; pa.w_out = nullptr; pa.pool_w = nullptr; pa.rgw = nullptr; pa.rew = nullptr; pa.w_gate = A->in[18]; pa.w_up = A->in[19]; pa.w_down = A->in[20]; pa.ws = ws;
              prep_block8(pa, ldsl, c * AQ_CONV_PER, 1, (c + 1) * AQ_CONV_PER); }
            n = AQ_FETCH();
            continue;
        }
        BlockRef cur; aq_decode(ORD2, n - AQ_CNUM(n), cur);
        Seam S;
        attn_prime(pp, cur, lds, S);
        for (;;) {
            n = AQ_FETCH();
            const bool chain = n < nq && !AQ_ISCONV(n);
            BlockRef nxt = cur; if (chain) aq_decode(ORD2, n - AQ_CNUM(n), nxt);
            attn_block(pp, cur, nxt, D, lds, S);
            if (!chain) break;
            cur = nxt;
        }
    }
#undef AQ_FETCH
#undef AQ_CNUM
#undef AQ_ISCONV
}
__device__ __forceinline__ void attn_combine(const unsigned* COMB, const float* PO, const float* PM, const float* PL, bf16_t* Y, int gw, int ngw, int lane) {
#pragma unroll 1
    for (int u = gw; u < 512 * 32; u += ngw) {
        const unsigned cw = COMB[u >> 5]; const unsigned nch = (cw >> 16) & 0xfu; if (nch <= 1u) continue;
        const unsigned base = cw & 0xffffu, hh = (cw >> 20) & 0xfu, qq = cw >> 24;
#pragma unroll 1
        for (int rr = 0; rr < 8; ++rr) { const int row = (u & 31) * 8 + rr;
            float m[4], l[4]; f32x2v ov[4]; float M = -3.0e38f;
#pragma unroll
            for (unsigned k = 0; k < 4; ++k) { const bool on = k < nch; const size_t si = (size_t)(base + (on ? k : 0u)) * QB + row;
                m[k] = on ? PM[si] : -3.0e38f; l[k] = on ? PL[si] : 0.f; ov[k] = *(const f32x2v*)(PO + si * DH + 2 * lane); M = fmaxf(M, m[k]); }
            float L = 0.f; f32x2v O = {0.f, 0.f};
#pragma unroll
            for (unsigned k = 0; k < 4; ++k) { const float f = (k < nch) ? __builtin_amdgcn_exp2f(m[k] - M) : 0.f; L += l[k] * f; O += ov[k] * f; }
            const float r = 1.0f / L;
            *(unsigned*)(Y + ((size_t)qq * QB + row) * D + hh * DH + 2 * lane) = cvtpk(O.x * r, O.y * r); }
    }
}
constexpr int MCH = 256, NCH = T / MCH;
#define TRRDB(dst, base, off) asm volatile("ds_read_b64_tr_b16 %0, %1 offset:%2" : "=&v"(dst) : "v"(base), "i"(off) : "memory")
#define FRAG8(l, h) (bf16x8){l[0], l[1], l[2], l[3], h[0], h[1], h[2], h[3]}
__device__ __forceinline__ bf16x8 scale8(bf16x8 v, float w) {
    u32x4 u = *reinterpret_cast<u32x4*>(&v); u32x4 o;
#pragma unroll
    for (int j = 0; j < 4; ++j) o[j] = cvtpk(__uint_as_float(u[j] << 16) * w, __uint_as_float(u[j] & 0xffff0000u) * w);
    return *reinterpret_cast<bf16x8*>(&o);
}
__device__ __forceinline__ void mlstm_c1_unit(char* lds, const bf16_t* P7, const float* BM, const float* IP, float* DC, float* NDp, int h, int c) {
    const int tid = threadIdx.x, wid = __builtin_amdgcn_readfirstlane(tid >> 6), lane = tid & 63, r32 = lane & 31, hi = lane >> 5;
    const int sr = tid >> 4, sc = (tid & 15) * 8, vst0 = v_st(sr, sc), vst1 = vst0 + 8192;
    const unsigned stoff = (unsigned)(sr * DH + sc) * 2u;
    char* V_lds = lds; char* K_lds = lds + 2 * SHM_V;
    const bf16_t* Kh = P7 + (size_t)(32 + h) * T * DH; const bf16_t* Vh = P7 + (size_t)(40 + h) * T * DH;
    const float* bm = BM + (size_t)h * T; const float* ip = IP + (size_t)h * T;
    const int t0 = c * MCH; const float bmend = bm[t0 + MCH - 1];
    const int db = wid & 3, vg = wid >> 2;
    const int kbase = (int)(uintptr_t)K_lds + v_rd_base(lane) + db * 512, vbase = (int)(uintptr_t)V_lds + v_rd_base(lane) + vg * 1024;
    f32x16 acc0 = {}, acc1 = {}, accn = {};
    const bf16x8 ones = (bf16x8){0x3F80, 0x3F80, 0x3F80, 0x3F80, 0x3F80, 0x3F80, 0x3F80, 0x3F80};
    bf16x8 nv0, nv1, nk0, nk1; float nb0, ni0, nb1, ni1;
#define C1_LOAD(j_) do { const int k0_ = t0 + (j_) * KVBLK; const char* vb_ = (const char*)(Vh + (size_t)k0_ * DH); const char* kb_ = (const char*)(Kh + (size_t)k0_ * DH); \
        nv0 = *(const bf16x8*)(vb_ + stoff); nv1 = *(const bf16x8*)(vb_ + stoff + 32 * DH * 2); nk0 = *(const bf16x8*)(kb_ + stoff); nk1 = *(const bf16x8*)(kb_ + stoff + 32 * DH * 2); \
        nb0 = bm[k0_ + sr]; ni0 = ip[k0_ + sr]; nb1 = bm[k0_ + 32 + sr]; ni1 = ip[k0_ + 32 + sr]; } while (0)
    C1_LOAD(0);
    for (int j = 0; j < 4; ++j) {
        const bf16x8 v0 = nv0, v1 = nv1;
        const float w0 = __expf(bmend - nb0 + ni0) * QK_SCALE, w1 = __expf(bmend - nb1 + ni1) * QK_SCALE;
        const bf16x8 kk0 = scale8(nk0, w0), kk1 = scale8(nk1, w1);
        __syncthreads();
        *(bf16x8*)(V_lds + vst0) = v0; *(bf16x8*)(V_lds + vst1) = v1; *(bf16x8*)(K_lds + vst0) = kk0; *(bf16x8*)(K_lds + vst1) = kk1;
        __syncthreads();
        { const int jn = j < 3 ? j + 1 : 3; C1_LOAD(jn); }
#define C1_KS(ks) do { s16x4 kl, kh, al, ah, bl, bh; TRRDB(kl, kbase, (ks) * 4096); TRRDB(kh, kbase, (ks) * 4096 + 2048); \
            TRRDB(al, vbase, (ks) * 4096); TRRDB(ah, vbase, (ks) * 4096 + 2048); TRRDB(bl, vbase, 512 + (ks) * 4096); TRRDB(bh, vbase, 512 + (ks) * 4096 + 2048); \
            asm volatile("s_waitcnt lgkmcnt(0)" ::: "memory"); SBAR(); \
            const bf16x8 kf = FRAG8(kl, kh); acc0 = __builtin_amdgcn_mfma_f32_32x32x16_bf16(kf, FRAG8(al, ah), acc0, 0, 0, 0); acc1 = __builtin_amdgcn_mfma_f32_32x32x16_bf16(kf, FRAG8(bl, bh), acc1, 0, 0, 0); \
            if (vg == 0) accn = __builtin_amdgcn_mfma_f32_32x32x16_bf16(kf, ones, accn, 0, 0, 0); } while (0)
        C1_KS(0); C1_KS(1); C1_KS(2); C1_KS(3);
#undef C1_KS
    }
#undef C1_LOAD
    float* Dp = DC + ((size_t)(h * NCH + c) * HD + db * 32) * HD + vg * 64 + r32;
#pragma unroll
    for (int r = 0; r < 16; ++r) { const int drow = crow(r, hi); Dp[(size_t)drow * HD] = acc0[r]; Dp[(size_t)drow * HD + 32] = acc1[r]; }
    if (vg == 0 && r32 == 0) { float* np = NDp + (size_t)(h * NCH + c) * HD + db * 32;
#pragma unroll
        for (int r = 0; r < 16; ++r) np[crow(r, hi)] = accn[r]; }
    __syncthreads();
}
__device__ __forceinline__ void mlstm_c2(char* lds, const float* BM, const float* DC, const float* NDp, bf16_t* CST, float* NST, int G, int bx) {
    float* aL = (float*)lds;
    { const int h = threadIdx.x >> 6, c = threadIdx.x & 63; const float* bm = BM + (size_t)h * T; aL[threadIdx.x] = __expf(bm[c * MCH + MCH - 1] - (c ? bm[c * MCH - 1] : 0.f)); }
    __syncthreads();
    for (int eb = bx; eb < NH * HD * HD / NTHREADS_C; eb += G) {
        int tid = threadIdx.x; asm volatile("" : "+v"(tid));
        const int e = eb * NTHREADS_C + tid, h = e >> 14, i = e & 16383, n = eb * 4 + (tid & 3), jn = n & 127;
        const float* dp = DC + (size_t)h * NCH * HD * HD + i; const float* np = NDp + (size_t)h * NCH * HD + jn;
        bf16_t* cs = CST + (size_t)h * NCH * HD * HD + i; float* ns = NST + (size_t)h * NCH * HD + jn;
        float C = 0.f, N = 0.f; float dv[16], nv[16], dn[16], nn[16];
#define C2_LOAD(dd, nd, c0_) do { _Pragma("unroll") for (int j = 0; j < 16; ++j) { const int c_ = ((c0_) + j) < NCH - 1 ? ((c0_) + j) : NCH - 2; dd[j] = dp[(size_t)c_ * HD * HD]; nd[j] = np[(size_t)c_ * HD]; } } while (0)
        C2_LOAD(dv, nv, 0);
#pragma unroll
        for (int c0 = 0; c0 < NCH; c0 += 16) {
            if (c0 + 16 < NCH) C2_LOAD(dn, nn, c0 + 16);
#pragma unroll
            for (int j = 0; j < 16; ++j) { const int c = c0 + j; if (c < NCH - 1) { const float a = aL[h * 64 + c]; C = a * C + dv[j]; N = a * N + nv[j];
                cs[(size_t)c * HD * HD] = (bf16_t)f2bf(C); if (tid < 4) ns[(size_t)c * HD] = N; } }
#pragma unroll
            for (int j = 0; j < 16; ++j) { dv[j] = dn[j]; nv[j] = nn[j]; }
        }
#undef C2_LOAD
    }
    __syncthreads();
}
__device__ __forceinline__ void mlstm_c3_unit(char* lds, const bf16_t* P7, const float* BM, const float* IP, const bf16_t* CST, const float* NST, const float* ogain, bf16_t* Y, int h, int c) {
    const int tid = threadIdx.x, wid = __builtin_amdgcn_readfirstlane(tid >> 6), lane = tid & 63, r32 = lane & 31, hi = lane >> 5;
    const int sr = tid >> 4, sc = (tid & 15) * 8, vst0 = v_st(sr, sc), vst1 = vst0 + 8192, kws = KSWZ(sr, sc * 2);
    const unsigned stoff = (unsigned)(sr * DH + sc) * 2u, qoff = (unsigned)(r32 * DH + hi * 8) * 2u;
    char* V_lds = lds; char* K_lds = lds + 2 * SHM_V;
    float* ws = (float*)(lds + OFF_WS) + wid * 64; float* li_l = ws, * al_l = ws + 32;
    float* colb = (float*)(lds + OFF_BIAS); float* nprev = colb + 256;
    const int vb0 = (int)(uintptr_t)V_lds + v_rd_base(lane);
    const bf16_t* Qh = P7 + (size_t)(24 + h) * T * DH; const bf16_t* Kh = P7 + (size_t)(32 + h) * T * DH; const bf16_t* Vh = P7 + (size_t)(40 + h) * T * DH; const bf16_t* Mh = P7 + (size_t)(48 + h) * T * DH;
    const float* bm = BM + (size_t)h * T; const float* ip = IP + (size_t)h * T;
    const int t0 = c * MCH; const float bmref = c ? bm[t0 - 1] : 0.f;
    bf16x8 qr[8];
    { const bf16_t* qb_ = Qh + (size_t)(t0 + wid * QBLK) * DH;
#pragma unroll
      for (int d0 = 0; d0 < 8; ++d0) qr[d0] = *(const bf16x8*)((const char*)qb_ + qoff + d0 * 32); }
    const float rowb = (bm[t0 + wid * QBLK + r32] - bmref) * LOG2E;
    if (tid < 256) colb[tid] = (bmref - bm[t0 + tid] + ip[t0 + tid]) * LOG2E;
    else if (tid < 384 && c) nprev[tid - 256] = NST[(size_t)(h * NCH + c - 1) * HD + (tid - 256)];
    f32x16 o[4] = {}; float den = 0.f;
    bf16x8 nv0, nv1, nk0, nk1;
#define C3_LOADKV(j_) do { const int k0_ = t0 + (j_) * KVBLK; const char* vb_ = (const char*)(Vh + (size_t)k0_ * DH); const char* kb_ = (const char*)(Kh + (size_t)k0_ * DH); \
        nv0 = *(const bf16x8*)(vb_ + stoff); nv1 = *(const bf16x8*)(vb_ + stoff + 32 * DH * 2); nk0 = *(const bf16x8*)(kb_ + stoff); nk1 = *(const bf16x8*)(kb_ + stoff + 32 * DH * 2); } while (0)
    if (c) {
        const char* Cp = (const char*)(CST + (size_t)(h * NCH + c - 1) * HD * HD);
        nv0 = *(const bf16x8*)(Cp + stoff); nv1 = *(const bf16x8*)(Cp + stoff + 32 * DH * 2);
#pragma unroll
        for (int hf = 0; hf < 2; ++hf) {
            const bf16x8 v0 = nv0, v1 = nv1;
            __syncthreads();
            *(bf16x8*)(V_lds + vst0) = v0; *(bf16x8*)(V_lds + vst1) = v1;
            __syncthreads();
            if (hf == 0) { nv0 = *(const bf16x8*)(Cp + 64 * DH * 2 + stoff); nv1 = *(const bf16x8*)(Cp + 64 * DH * 2 + stoff + 32 * DH * 2); } else C3_LOADKV(0);
            if (hf == 0) pv_tile<0>(o, vb0, qr[0], qr[1], qr[2], qr[3]); else pv_tile<0>(o, vb0, qr[4], qr[5], qr[6], qr[7]);
        }
        float dn = 0.f;
#pragma unroll
        for (int d0 = 0; d0 < 8; ++d0) { const u32x4 u = *reinterpret_cast<const u32x4*>(&qr[d0]); const float* np_ = nprev + d0 * 16 + hi * 8;
#pragma unroll
            for (int j = 0; j < 4; ++j) dn += __uint_as_float(u[j] << 16) * np_[2 * j] + __uint_as_float(u[j] & 0xffff0000u) * np_[2 * j + 1]; }
        { auto rr = __builtin_amdgcn_permlane32_swap(__float_as_uint(dn), __float_as_uint(dn), false, false); dn = __uint_as_float(rr[0]) + __uint_as_float(rr[1]); }
        const float rs = __builtin_amdgcn_exp2f(rowb); den = rs * dn;
        if (hi == 0) al_l[r32] = rs; asm volatile("s_waitcnt lgkmcnt(0)" ::: "memory");
        for (int d_ = 0; d_ < 4; ++d_) for (int r = 0; r < 16; ++r) o[d_][r] *= al_l[crow(r, hi)];
    } else C3_LOADKV(0);
    const int qrel = wid * QBLK + r32;
    for (int j = 0; j < 4; ++j) {
        const bf16x8 v0 = nv0, v1 = nv1, kk0 = nk0, kk1 = nk1;
        __syncthreads();
        *(bf16x8*)(V_lds + vst0) = v0; *(bf16x8*)(V_lds + vst1) = v1; *(bf16x8*)(K_lds + kws) = kk0; *(bf16x8*)(K_lds + kws + 32 * 256) = kk1;
        __syncthreads();
        { const int jn = j < 3 ? j + 1 : 3; C3_LOADKV(jn); }
        if (j * KVBLK <= wid * QBLK + QBLK - 1) {
            f32x16 p0, p1; qkt<0>(p0, p1, K_lds, r32, hi, qr);
            const float* bt = colb + j * KVBLK;
#pragma unroll
            for (int g = 0; g < 4; ++g) { const f32x4 b0 = *(const f32x4*)(bt + 8 * g + 4 * hi), b1 = *(const f32x4*)(bt + 32 + 8 * g + 4 * hi);
#pragma unroll
                for (int jj = 0; jj < 4; ++jj) { const int r = 4 * g + jj, kk = j * KVBLK + jj + 8 * g + 4 * hi;
                    const float a0 = p0[r] * QK_SCALE * __builtin_amdgcn_exp2f(rowb + b0[jj]), a1 = p1[r] * QK_SCALE * __builtin_amdgcn_exp2f(rowb + b1[jj]);
                    p0[r] = kk <= qrel ? a0 : 0.f; p1[r] = kk + 32 <= qrel ? a1 : 0.f; } }
            float ps = 0.f; for (int r = 0; r < 16; ++r) ps += p0[r]; for (int r = 0; r < 16; ++r) ps += p1[r];
            { auto rr = __builtin_amdgcn_permlane32_swap(__float_as_uint(ps), __float_as_uint(ps), false, false); ps = __uint_as_float(rr[0]) + __uint_as_float(rr[1]); }
            den += ps;
            bf16x8 pa0, pa1, pa2, pa3;
#define PK4(P, B_, OUT) do { unsigned a0_ = cvtpk(P[B_+0], P[B_+1]), a1_ = cvtpk(P[B_+2], P[B_+3]); unsigned b0_ = cvtpk(P[B_+4], P[B_+5]), b1_ = cvtpk(P[B_+6], P[B_+7]); \
        auto r0_ = __builtin_amdgcn_permlane32_swap(a0_, b0_, false, false); auto r1_ = __builtin_amdgcn_permlane32_swap(a1_, b1_, false, false); \
        u32x4 w_ = {r0_[0], r1_[0], r0_[1], r1_[1]}; OUT = *reinterpret_cast<bf16x8*>(&w_); } while (0)
            PK4(p0, 0, pa0); PK4(p0, 8, pa1); PK4(p1, 0, pa2); PK4(p1, 8, pa3);
#undef PK4
            pv_tile<0>(o, vb0, pa0, pa1, pa2, pa3);
        }
    }
#undef C3_LOADKV
    if (hi == 0) li_l[r32] = 1.0f / fmaxf(fabsf(den), 1.0f); asm volatile("s_waitcnt lgkmcnt(0)" ::: "memory");
    bf16_t* Ow = Y + (size_t)(t0 + wid * QBLK) * D + 1024 + h * DH; const unsigned ooff = (unsigned)(4 * hi * D + r32) * 2u;
    const bf16_t* Mw = Mh + (size_t)(t0 + wid * QBLK) * DH; const unsigned moff = (unsigned)(4 * hi * DH + r32) * 2u;
    float gn[4];
#pragma unroll
    for (int d0 = 0; d0 < 4; ++d0) gn[d0] = ogain[h * DH + d0 * 32 + r32];
    bf16_t mov[16][4];
#pragma unroll
    for (int r = 0; r < 16; ++r) { const int orow0 = (r & 3) + 8 * (r >> 2);
#pragma unroll
        for (int d0 = 0; d0 < 4; ++d0) mov[r][d0] = *(const bf16_t*)((const char*)(Mw + (size_t)orow0 * DH + d0 * 32) + moff); }
#pragma unroll
    for (int r = 0; r < 16; ++r) { const int orow0 = (r & 3) + 8 * (r >> 2); const float rl = li_l[crow(r, hi)];
        float hv[4], ss = 0.f;
#pragma unroll
        for (int d0 = 0; d0 < 4; ++d0) { hv[d0] = o[d0][r] * rl; ss += hv[d0] * hv[d0]; }
#pragma unroll
        for (int m = 1; m < 32; m <<= 1) ss += __shfl_xor(ss, m);
        const float rstd = 1.0f / sqrtf(ss * (1.0f / DH) + RMS_EPS);
#pragma unroll
        for (int d0 = 0; d0 < 4; ++d0) { const float mo = bf2f(mov[r][d0]);
            const float v = hv[d0] * rstd * gn[d0] * (1.0f / (1.0f + __expf(-mo))); const float vn = __shfl_xor(v, 1);
            if ((r32 & 1) == 0) *(unsigned*)((char*)(Ow + (size_t)orow0 * D + d0 * 32) + ooff) = cvtpk(v, vn); } }
    __syncthreads();
}
#undef TRRDB
#undef FRAG8
#undef KSWZ
#undef SBAR
}

constexpr int NWAVES = 8, NTHREADS = 512;
constexpr int LDS_STAGE = 0, LDS_TILEE = 131072, LDS_TSTART = LDS_TILEE + 4 * MAXTILES, LDS_CNT = LDS_TSTART + 4 * 64, LDS_TILES = LDS_CNT + 4 * 32, LDS_ROWOFF = 133120, LDS_ROWW = LDS_ROWOFF + 8 * 1024, LDS_CTL = LDS_ROWW + 8 * 1024, LDS_BYTES = LDS_CTL + 512;
static_assert(LDS_TILES + 4 * MAXTILES <= LDS_ROWOFF && LDS_BYTES <= 160 * 1024 && at::ATT_LDS <= LDS_CTL, "LDS map");
constexpr int MAXU = 8;
constexpr int CW_BAR = 4096;

#define XB_TMO      128
#define XB_XCNT(j)  (256  + 64 * (j))
#define XB_XSUB(j)  (1280 + 64 * (j))
#define XB_XGEN(j)  (2304 + 64 * (j))
#define XB_TOP      3328
#define XB_TOPGEN   3392
#define XCD_BAR_WORDS 3456
#define XB_SPIN_CAP (1u << 18)
__device__ __forceinline__ unsigned xb_ld(unsigned* p)              { return __hip_atomic_load(p, __ATOMIC_RELAXED, __HIP_MEMORY_SCOPE_AGENT); }
__device__ __forceinline__ unsigned xb_add(unsigned* p, unsigned v) { return __hip_atomic_fetch_add(p, v, __ATOMIC_RELAXED, __HIP_MEMORY_SCOPE_AGENT); }
__device__ __forceinline__ unsigned xb_xcc_id() { return (unsigned)__builtin_amdgcn_s_getreg((3 << 11) | 20) & 0xFu; }
#define XB_SPIN(cond, bar) do { unsigned _sp = 0; while (cond) { __builtin_amdgcn_s_sleep(1); \
    if ((++_sp & 255u) == 0u) { if (xb_ld(&(bar)[XB_TMO])) break; if (_sp > XB_SPIN_CAP) { atomicAdd(&(bar)[XB_TMO], 1u); break; } } } } while (0)
struct XcdBarrier { unsigned* bar; unsigned x; volatile LAS unsigned* st; };
__device__ __forceinline__ XcdBarrier xcd_barrier_post(unsigned* bar, volatile LAS unsigned* st) {
    XcdBarrier b; b.bar = bar; b.x = xb_xcc_id(); b.st = st;
    if (threadIdx.x == 0) (void)xb_add(&bar[XB_XCNT(b.x)], 1u);
    return b;
}
__device__ __forceinline__ void xcd_barrier_complete(unsigned* bar, unsigned x, unsigned& nloc, unsigned& nx) {
    const unsigned G = gridDim.x * gridDim.y * gridDim.z;
    unsigned sum, cnt, mine, sp = 0u;
    for (;;) {
        sum = 0u; cnt = 0u; mine = 0u;
#pragma unroll
        for (unsigned j = 0; j < 16; ++j) { const unsigned c = xb_ld(&bar[XB_XCNT(j)]); sum += c; cnt += (c > 0u) ? 1u : 0u; mine = (j == x) ? c : mine; }
        if (sum == G) break;
        __builtin_amdgcn_s_sleep(1);
        if ((++sp & 255u) == 0u) { if (xb_ld(&bar[XB_TMO])) break; if (sp > XB_SPIN_CAP) { atomicAdd(&bar[XB_TMO], 1u); break; } }
    }
    nloc = mine > 0u ? mine : 1u; nx = cnt > 0u ? cnt : 1u;
}
__device__ __forceinline__ void xcd_barrier(const XcdBarrier& b) {
    asm volatile("s_waitcnt vmcnt(0)" ::: "memory");
    __syncthreads();
    if (threadIdx.x == 0) {
        unsigned* bar = b.bar;
        __builtin_amdgcn_s_waitcnt(0);
        unsigned nloc = b.st[0], nx = b.st[1];
        if (nloc == 0u) { xcd_barrier_complete(bar, b.x, nloc, nx); b.st[0] = nloc; b.st[1] = nx; }
        const unsigned old = xb_add(&bar[XB_XSUB(b.x)], 1u);
        const unsigned gen = old / nloc;
        if (old + 1u == (gen + 1u) * nloc) {
            __builtin_amdgcn_fence(__ATOMIC_RELEASE, "agent");
            asm volatile("s_waitcnt vmcnt(0)" ::: "memory");
            const unsigned og = xb_add(&bar[XB_TOP], 1u);
            const unsigned tg = og / nx;
            if (og + 1u == (tg + 1u) * nx) xb_add(&bar[XB_TOPGEN], 1u);
            else XB_SPIN(xb_ld(&bar[XB_TOPGEN]) == tg, bar);
            __builtin_amdgcn_fence(__ATOMIC_ACQUIRE, "agent");
            xb_add(&bar[XB_XGEN(b.x)], 1u);
            asm volatile("s_waitcnt vmcnt(0)" ::: "memory");
        } else {
            XB_SPIN(xb_ld(&bar[XB_XGEN(b.x)]) == gen, bar);
            __builtin_amdgcn_fence(__ATOMIC_ACQUIRE, "agent");
            asm volatile("s_waitcnt vmcnt(0)" ::: "memory");
        }
    }
    __syncthreads();
}

enum { PH_PREP = 0, PH_NORM0 = 1, PH_INPROJ = 2, PH_QKN_C1 = 3, PH_MC2 = 4, PH_MIX = 5, PH_ACOMB = 6, PH_OUTPROJ = 7,
       PH_ROUTE0 = 8, PH_GU0 = 9, PH_DOWN0 = 10, PH_COMB0 = 11, PH_POOL = 12, PH_POOLG = 13,
       PH_ROUTE1 = 14, PH_GU1 = 15, PH_DOWN1 = 16, PH_COMB1 = 17, PH_END = 18 };
struct MkArgs { const float* in[21]; float* out; unsigned char* ws; int ph_lo, ph_hi, pad0, pad1; };

__device__ __forceinline__ void moe_tables(LAS unsigned char* lds, const unsigned* cnt) {
    LAS int* tileE = (LAS int*)(lds + LDS_TILEE); LAS int* tstart = (LAS int*)(lds + LDS_TSTART); LAS int* cntL = (LAS int*)(lds + LDS_CNT); LAS int* tileS = (LAS int*)(lds + LDS_TILES);
    if (threadIdx.x < 64) {
        const int e = (int)threadIdx.x, ce = e < NEXP ? (int)cnt[e * CNT_STRIDE] : 0, ntl = (ce + 255) >> 8, hf = ((ce & 255) >= 1 && (ce & 255) <= HALF_ROWS) ? 1 : 0, nfu = ntl - hf;
        int inc = ntl, incf = nfu, inch = hf;
#pragma unroll
        for (int o = 1; o < 32; o <<= 1) { const int t = __shfl_up(inc, o), tf = __shfl_up(incf, o), th = __shfl_up(inch, o); inc += e >= o ? t : 0; incf += e >= o ? tf : 0; inch += e >= o ? th : 0; }
        const int st = inc - ntl, fst = incf - nfu, hst = inch - hf, totf = __shfl(incf, NEXP - 1);
        if (e < NEXP) { cntL[e] = ce; tstart[e] = st; for (int j = 0; j < ntl; ++j) tileE[st + j] = e;
            for (int j = 0; j < nfu; ++j) tileS[fst + j] = st + j;
            if (hf) tileS[totf + hst] = (st + ntl - 1) | 0x8000; }
        if (e == NEXP - 1) tstart[NEXP] = inc; }
    __syncthreads();
}
__device__ __forceinline__ void moe_setup(LAS unsigned char* lds, const unsigned* cnt, const int* capt, const float* capw, pg::MoeOrder& S, int G, int c, unsigned lda_bytes, bool seq_rows, const float* tokscale) {
    moe_tables(lds, cnt);
    LAS int* tileE = (LAS int*)(lds + LDS_TILEE); LAS int* tstart = (LAS int*)(lds + LDS_TSTART); LAS int* cntL = (LAS int*)(lds + LDS_CNT);
    LAS unsigned* rowoff = (LAS unsigned*)(lds + LDS_ROWOFF); LAS float* roww = (LAS float*)(lds + LDS_ROWW);
    const int tid = threadIdx.x, r = tid & 255;
    S.nwg = tstart[NEXP] * 8; S.G = G; S.c = c; S.tileE = tileE; S.tileS = (const LAS int*)(lds + LDS_TILES);
    static_assert(MAXU == 8, "four batched steps of two units");
    int idx[4], pmr[4], tok[4]; bool has[4], val[4]; float w[4];
#pragma unroll
    for (int k = 0; k < 4; ++k) { pg::Unit u; u.pm = 0; u.pn = 0; u.ak = 0; has[k] = S.next(2 * k + (tid >> 8), u);
        const int e = has[k] ? (u.pn >> 3) : 0, rank = (u.pm - tstart[e]) * 256 + r; val[k] = has[k] && rank < cntL[e]; idx[k] = val[k] ? e * CAP + rank : 0; pmr[k] = u.pm * 256 + r; }
#pragma unroll
    for (int k = 0; k < 4; ++k) { tok[k] = capt[idx[k]]; w[k] = capw[idx[k]]; }
#pragma unroll
    for (int k = 0; k < 4; ++k) tok[k] = val[k] ? tok[k] : 0;
    if (tokscale) {
#pragma unroll
        for (int k = 0; k < 4; ++k) w[k] = tokscale[tok[k]]; }
#pragma unroll
    for (int k = 0; k < 4; ++k) if (has[k]) { const int s = 2 * k + (tid >> 8);
        rowoff[s * 256 + r] = seq_rows ? (unsigned)pmr[k] * lda_bytes : (unsigned)tok[k] * lda_bytes; roww[s * 256 + r] = val[k] ? w[k] : 0.f; }
    __syncthreads();
}

typedef const __attribute__((address_space(4))) MkArgs* KArgs;
__device__ __forceinline__ KArgs kargs() { KArgs p = (KArgs)__builtin_amdgcn_kernarg_segment_ptr(); asm volatile("" : "+s"(p)); return p; }
#define WSP(T_, off) ((T_*)(A->ws + (off)))
#define LANE_ ((int)(threadIdx.x & 63))
#define WAVE_ (__builtin_amdgcn_readfirstlane((int)(threadIdx.x >> 6)))
#define GW_ ((int)blockIdx.x * NWAVES + WAVE_)
#define NGW_ ((int)gridDim.x * NWAVES)
#define GRID_BAR() do { KArgs A = kargs(); XcdBarrier b_; b_.bar = WSP(unsigned, WS_CTL) + CW_BAR; b_.x = xb_xcc_id(); b_.st = (volatile LAS unsigned*)(lds + LDS_CTL + 32); xcd_barrier(b_); } while (0)
__global__ void __launch_bounds__(NTHREADS, 2) mk_fwd(MkArgs a_unused) {
    extern __shared__ __attribute__((aligned(16))) unsigned char lds_raw[];
    LAS unsigned char* lds = (LAS unsigned char*)lds_raw;
    if (threadIdx.x < 128) ((LAS unsigned*)(lds + LDS_CTL))[threadIdx.x] = 0u;
    __syncthreads();
    { KArgs A = kargs(); (void)xcd_barrier_post(WSP(unsigned, WS_CTL) + CW_BAR, (volatile LAS unsigned*)(lds + LDS_CTL + 32)); }
#define IN(k) (kargs()->ph_lo <= (k) && (k) < kargs()->ph_hi)
#define SEAM(k) do { if (IN(k) && IN((k) + 1)) GRID_BAR(); } while (0)

    if (IN(PH_PREP)) { KArgs A = kargs();
        PrepArgs pa; pa.w_in = A->in[3]; pa.w_out = A->in[10]; pa.pool_w = A->in[11]; pa.w_gate = A->in[18]; pa.w_up = A->in[19]; pa.w_down = A->in[20]; pa.rgw = A->in[14]; pa.rew = A->in[16]; pa.ws = A->ws;
        float* WG = WSP(float, WS_WG); float* WR = WSP(float, WS_WR);
        const int gt = (int)blockIdx.x * NTHREADS + (int)threadIdx.x, ngt = (int)gridDim.x * NTHREADS;
#pragma unroll 1
        for (int i = gt; i < NGATE * D; i += ngt) { const int c = i / D, k = i % D; const int col = c < 8 ? 3072 + c : 6152 + (c - 8); WG[i] = pa.w_in[(size_t)k * INC + col]; }
#pragma unroll 1
        for (int i = gt; i < 2 * NROUTE * D; i += ngt) { const int l = i / (NROUTE * D), r = i % (NROUTE * D), c = r / D, k = r % D;
            WR[i] = c < 4 ? pa.rgw[((size_t)l * D + k) * NGRP + c] : pa.rew[((size_t)l * D + k) * NEXP + (c - 4)]; }
        LAS float* scr = (LAS float*)(lds + WAVE_ * 16896); const int ngw = NGW_;
        prep_loop(pa, GW_, ngw, scr, LANE_);
    }
    SEAM(PH_PREP);
    if (IN(PH_NORM0)) { KArgs A = kargs();
        NormProjArgs P{}; P.x = A->in[0]; P.g = A->in[1]; P.Wc = WSP(const float, WS_WG); P.hn = WSP(bf16_t, WS_HN); P.hn8 = WSP(unsigned char, WS_HN8); P.rstd = WSP(float, WS_RSTD0); P.gates = WSP(float, WS_GATES); P.cf = WSP(float, WS_CF); P.bm = WSP(float, WS_BM); P.ip = WSP(float, WS_IP); P.fox_fb = A->in[4]; P.m_ib = A->in[7]; P.m_fb = A->in[8];
#pragma unroll 1
        for (int rb = blockIdx.x; rb < T / 64; rb += gridDim.x) norm_proj_block2<NGATE, 0>(lds, P, rb);
    }
    SEAM(PH_NORM0);
    if (IN(PH_INPROJ)) { KArgs A = kargs();
        if (blockIdx.x == gridDim.x - 1) at::attn_plan((char*)lds_raw, WSP(const float, WS_GATES), A->in[5], A->in[6], WSP(unsigned, WS_AQORD), WSP(unsigned, WS_AQORD2), WSP(unsigned, WS_AQCOMB));
#pragma unroll 1
        for (int rb = blockIdx.x; rb < T / 64; rb += gridDim.x) gates_fixup(WSP(const float, WS_GATES), WSP(float, WS_CF), WSP(float, WS_BM), rb, (LAS float*)lds);
        { pg::Gemm g{WSP(const bf16_t, WS_HN), WSP(const bf16_t, WS_WINP), D, D, D}; pg::StaticOrder S; S.init(T, NP16, (int)gridDim.x, (int)blockIdx.x);
          pg::EpiP7<0> E{WSP(bf16_t, WS_P7), A->in[5], A->in[6], (LAS float*)(lds + 131072), WSP(const float, WS_RSTD0)};
          pg::gemm_phase<pg::EpiP7<0>, pg::StaticOrder, false>(lds + LDS_STAGE, g, S, E, nullptr, nullptr); }
        { pg::StaticOrder S; S.init(T, NP8, (int)gridDim.x, (int)blockIdx.x);
          LAS unsigned* rowoff = (LAS unsigned*)(lds + LDS_ROWOFF);
          for (int s0 = 0; s0 < MAXU; s0 += 2) { const int s_ = s0 + ((int)threadIdx.x >> 8), r_ = (int)threadIdx.x & 255; pg::Unit u_; if (S.next(s_, u_)) rowoff[s_ * 256 + r_] = (unsigned)(u_.pm * 256 + r_) * (unsigned)D; }
          __syncthreads();
          pg::Gemm g{WSP(const bf16_t, WS_HN8), WSP(const bf16_t, WS_WINP8), D / 2, D / 2, D / 2};
          pg::EpiP7<1> E{WSP(bf16_t, WS_P7), A->in[5], A->in[6], (LAS float*)(lds + 131072), WSP(const float, WS_RSTD0)};
          pg::gemm_phase<pg::EpiP7<1>, pg::StaticOrder, true, true>(lds + LDS_STAGE, g, S, E, (const LAS unsigned*)(lds + LDS_ROWOFF), nullptr); }
    }
    SEAM(PH_INPROJ);
    if (IN(PH_QKN_C1)) { KArgs A = kargs();
#pragma unroll 1
        for (int u = blockIdx.x; u < NH * at::NCH; u += gridDim.x) at::mlstm_c1_unit((char*)lds_raw, WSP(const bf16_t, WS_P7), WSP(const float, WS_BM), WSP(const float, WS_IP), WSP(float, WS_DC), WSP(float, WS_ND), u / at::NCH, u % at::NCH);
    }
    SEAM(PH_QKN_C1);
    if (IN(PH_MC2)) { KArgs A = kargs(); at::mlstm_c2((char*)lds_raw, WSP(const float, WS_BM), WSP(const float, WS_DC), WSP(const float, WS_ND), WSP(bf16_t, WS_CST), WSP(float, WS_NST), (int)gridDim.x, (int)blockIdx.x); }
    SEAM(PH_MC2);
    if (IN(PH_MIX)) { KArgs A = kargs();
        at::attn_phase((char*)lds_raw, A->ws, WSP(const unsigned, WS_AQORD2), WSP(unsigned, WS_CTL) + CW_AQ, lds);
        { LAS unsigned* bq = (LAS unsigned*)(lds + LDS_CTL + 256);
#pragma unroll 1
          for (;;) { __syncthreads(); if (threadIdx.x == 0) *bq = atomicAdd(WSP(unsigned, WS_CTL) + CW_C3Q, 1u); __syncthreads(); const unsigned u = *bq; if (u >= (unsigned)(NH * at::NCH)) break;
              at::mlstm_c3_unit((char*)lds_raw, WSP(const bf16_t, WS_P7), WSP(const float, WS_BM), WSP(const float, WS_IP), WSP(const bf16_t, WS_CST), WSP(const float, WS_NST), A->in[9], WSP(bf16_t, WS_Y), (int)(u / at::NCH), (int)(u % at::NCH)); } }
    }
    SEAM(PH_MIX);
    if (IN(PH_ACOMB)) { KArgs A = kargs(); at::attn_combine(WSP(const unsigned, WS_AQCOMB), WSP(const float, WS_PO), WSP(const float, WS_PM), WSP(const float, WS_PL), WSP(bf16_t, WS_Y), GW_, NGW_, LANE_); }
    SEAM(PH_ACOMB);
    if (IN(PH_OUTPROJ)) { KArgs A = kargs();
        pg::Gemm g{WSP(const bf16_t, WS_Y), WSP(const bf16_t, WS_WOUT), D, D, D}; pg::StaticOrder S; S.init(T, D, (int)gridDim.x, (int)blockIdx.x);
        pg::EpiRes<false, true> E{A->in[0], WSP(bf16_t, WS_XB), D, nullptr, nullptr};
        pg::gemm_phase<pg::EpiRes<false, true>, pg::StaticOrder, false>(lds + LDS_STAGE, g, S, E, nullptr, nullptr);
    }
    SEAM(PH_OUTPROJ);
    {
        constexpr int l = 0; constexpr int pb = l ? PH_ROUTE1 : PH_ROUTE0;
        if (l == 1) {
            if (IN(PH_POOL)) { KArgs A = kargs();
#pragma unroll 1
                for (int ch = blockIdx.x; ch < T / 64; ch += gridDim.x) pool_chunk(WSP(const bf16_t, WS_XB), WSP(const float, WS_RSTD0), A->in[1] + D, WSP(bf16_t, WS_POOLED), ch * 64, (LAS float*)lds); }
            SEAM(PH_POOL);
            if (IN(PH_POOLG)) { KArgs A = kargs();
                pg::Gemm g{WSP(const bf16_t, WS_POOLED), WSP(const bf16_t, WS_WPOOL), D, 512, 512}; pg::StaticOrder S; S.init(T, D, (int)gridDim.x, (int)blockIdx.x, 2);
                pg::EpiRes<true, true> E{WSP(const bf16_t, WS_XB), WSP(bf16_t, WS_XB), D, A->in[12], A->in[13]};
                pg::gemm_phase<pg::EpiRes<true, true>, pg::StaticOrder, false>(lds + LDS_STAGE, g, S, E, nullptr, nullptr);
            }
            SEAM(PH_POOLG);
        }
        if (IN(pb)) { KArgs A = kargs();
            NormProjArgs P{}; P.xb = WSP(const bf16_t, WS_XB); P.g = A->in[2] + (size_t)l * D; P.Wc = WSP(const float, WS_WR) + (size_t)l * NROUTE * D; P.hn = WSP(bf16_t, WS_HN); P.rstd = WSP(float, WS_RSTD);
            P.gb = A->in[15] + l * NGRP; P.eb = A->in[17] + l * NEXP; P.cnt = WSP(unsigned, WS_CTL) + CW_CNT + CNT_LSTRIDE * l; P.asg_e = WSP(int, WS_ASGE); P.asg_r = WSP(int, WS_ASGR); P.capt = WSP(int, WS_CAPT); P.capw = WSP(float, WS_CAPW);
#pragma unroll 1
            for (int rb = blockIdx.x; rb < T / 64; rb += gridDim.x) norm_proj_block2<NROUTE, 1>(lds, P, rb);
        }
        SEAM(pb);
        if (IN(pb + 1)) { KArgs A = kargs();
            pg::MoeOrder S; moe_setup(lds, WSP(const unsigned, WS_CTL) + CW_CNT + CNT_LSTRIDE * l, WSP(const int, WS_CAPT), WSP(const float, WS_CAPW), S, (int)gridDim.x, (int)blockIdx.x, (unsigned)D, false, WSP(const float, WS_RSTD));
            pg::Gemm g{WSP(const bf16_t, WS_HN), (const bf16_t*)(WSP(const unsigned char, WS_WGU) + (size_t)l * NEXP * 2048 * D), D / 2, D / 2, D / 2};
            pg::EpiSilu E{WSP(unsigned char, WS_H)};
            pg::gemm_phase<pg::EpiSilu, pg::MoeOrder, true, true>(lds + LDS_STAGE, g, S, E, (const LAS unsigned*)(lds + LDS_ROWOFF), (const LAS float*)(lds + LDS_ROWW));
        }
        SEAM(pb + 1);
        if (IN(pb + 2)) { KArgs A = kargs();
            pg::MoeOrder S; moe_setup(lds, WSP(const unsigned, WS_CTL) + CW_CNT + CNT_LSTRIDE * l, WSP(const int, WS_CAPT), WSP(const float, WS_CAPW), S, (int)gridDim.x, (int)blockIdx.x, (unsigned)DEXP, true, nullptr);
            pg::Gemm g{WSP(const bf16_t, WS_H), (const bf16_t*)(WSP(const unsigned char, WS_WD) + (size_t)l * NEXP * D * DEXP), DEXP / 2, DEXP / 2, DEXP / 2};
            pg::EpiDown E{WSP(unsigned char, WS_YS)};
            pg::gemm_phase<pg::EpiDown, pg::MoeOrder, true, true>(lds + LDS_STAGE, g, S, E, (const LAS unsigned*)(lds + LDS_ROWOFF), (const LAS float*)(lds + LDS_ROWW));
        }
        SEAM(pb + 2);
        if (IN(pb + 3)) { KArgs A = kargs();
            moe_tables(lds, WSP(const unsigned, WS_CTL) + CW_CNT + CNT_LSTRIDE * l);
            const LAS int* tstart = (const LAS int*)(lds + LDS_TSTART); const int ngw = NGW_, lane = LANE_;
#pragma unroll 1
            for (int r8 = GW_; r8 < T / 8; r8 += ngw) {
                if (l == 0) combine_rows8<true>(WSP(bf16_t, WS_XB), nullptr, WSP(const unsigned char, WS_YS), WSP(const int, WS_ASGE), WSP(const int, WS_ASGR), tstart, WSP(float, WS_RSTD0), r8 * 8, lane);
                else combine_rows8<false>(WSP(bf16_t, WS_XB), A->out, WSP(const unsigned char, WS_YS), WSP(const int, WS_ASGE), WSP(const int, WS_ASGR), tstart, nullptr, r8 * 8, lane); }
        }
        SEAM(pb + 3);
        }
    {
        constexpr int l = 1; constexpr int pb = l ? PH_ROUTE1 : PH_ROUTE0;
        if (l == 1) {
            if (IN(PH_POOL)) { KArgs A = kargs();
#pragma unroll 1
                for (int ch = blockIdx.x; ch < T / 64; ch += gridDim.x) pool_chunk(WSP(const bf16_t, WS_XB), WSP(const float, WS_RSTD0), A->in[1] + D, WSP(bf16_t, WS_POOLED), ch * 64, (LAS float*)lds); }
            SEAM(PH_POOL);
            if (IN(PH_POOLG)) { KArgs A = kargs();
                pg::Gemm g{WSP(const bf16_t, WS_POOLED), WSP(const bf16_t, WS_WPOOL), D, 512, 512}; pg::StaticOrder S; S.init(T, D, (int)gridDim.x, (int)blockIdx.x, 2);
                pg::EpiRes<true, true> E{WSP(const bf16_t, WS_XB), WSP(bf16_t, WS_XB), D, A->in[12], A->in[13]};
                pg::gemm_phase<pg::EpiRes<true, true>, pg::StaticOrder, false>(lds + LDS_STAGE, g, S, E, nullptr, nullptr);
            }
            SEAM(PH_POOLG);
        }
        if (IN(pb)) { KArgs A = kargs();
            NormProjArgs P{}; P.xb = WSP(const bf16_t, WS_XB); P.g = A->in[2] + (size_t)l * D; P.Wc = WSP(const float, WS_WR) + (size_t)l * NROUTE * D; P.hn = WSP(bf16_t, WS_HN); P.rstd = WSP(float, WS_RSTD);
            P.gb = A->in[15] + l * NGRP; P.eb = A->in[17] + l * NEXP; P.cnt = WSP(unsigned, WS_CTL) + CW_CNT + CNT_LSTRIDE * l; P.asg_e = WSP(int, WS_ASGE); P.asg_r = WSP(int, WS_ASGR); P.capt = WSP(int, WS_CAPT); P.capw = WSP(float, WS_CAPW);
#pragma unroll 1
            for (int rb = blockIdx.x; rb < T / 64; rb += gridDim.x) norm_proj_block2<NROUTE, 1>(lds, P, rb);
        }
        SEAM(pb);
        if (IN(pb + 1)) { KArgs A = kargs();
            pg::MoeOrder S; moe_setup(lds, WSP(const unsigned, WS_CTL) + CW_CNT + CNT_LSTRIDE * l, WSP(const int, WS_CAPT), WSP(const float, WS_CAPW), S, (int)gridDim.x, (int)blockIdx.x, (unsigned)D, false, WSP(const float, WS_RSTD));
            pg::Gemm g{WSP(const bf16_t, WS_HN), (const bf16_t*)(WSP(const unsigned char, WS_WGU) + (size_t)l * NEXP * 2048 * D), D / 2, D / 2, D / 2};
            pg::EpiSilu E{WSP(unsigned char, WS_H)};
            pg::gemm_phase<pg::EpiSilu, pg::MoeOrder, true, true>(lds + LDS_STAGE, g, S, E, (const LAS unsigned*)(lds + LDS_ROWOFF), (const LAS float*)(lds + LDS_ROWW));
        }
        SEAM(pb + 1);
        if (IN(pb + 2)) { KArgs A = kargs();
            pg::MoeOrder S; moe_setup(lds, WSP(const unsigned, WS_CTL) + CW_CNT + CNT_LSTRIDE * l, WSP(const int, WS_CAPT), WSP(const float, WS_CAPW), S, (int)gridDim.x, (int)blockIdx.x, (unsigned)DEXP, true, nullptr);
            pg::Gemm g{WSP(const bf16_t, WS_H), (const bf16_t*)(WSP(const unsigned char, WS_WD) + (size_t)l * NEXP * D * DEXP), DEXP / 2, DEXP / 2, DEXP / 2};
            pg::EpiDown E{WSP(unsigned char, WS_YS)};
            pg::gemm_phase<pg::EpiDown, pg::MoeOrder, true, true>(lds + LDS_STAGE, g, S, E, (const LAS unsigned*)(lds + LDS_ROWOFF), (const LAS float*)(lds + LDS_ROWW));
        }
        SEAM(pb + 2);
        if (IN(pb + 3)) { KArgs A = kargs();
            moe_tables(lds, WSP(const unsigned, WS_CTL) + CW_CNT + CNT_LSTRIDE * l);
            const LAS int* tstart = (const LAS int*)(lds + LDS_TSTART); const int ngw = NGW_, lane = LANE_;
#pragma unroll 1
            for (int r8 = GW_; r8 < T / 8; r8 += ngw) {
                if (l == 0) combine_rows8<true>(WSP(bf16_t, WS_XB), nullptr, WSP(const unsigned char, WS_YS), WSP(const int, WS_ASGE), WSP(const int, WS_ASGR), tstart, WSP(float, WS_RSTD0), r8 * 8, lane);
                else combine_rows8<false>(WSP(bf16_t, WS_XB), A->out, WSP(const unsigned char, WS_YS), WSP(const int, WS_ASGE), WSP(const int, WS_ASGR), tstart, nullptr, r8 * 8, lane); }
        }
        SEAM(pb + 3);
        }
#undef IN
#undef SEAM
}

extern "C" void kernel_launch(void* const* d_in, const int* in_sizes, int n_in, void* d_out, int out_size, void* d_ws, size_t ws_size, hipStream_t stream) {
    static int grid = 0;
    if (grid == 0) {
        if (n_in != 21 || ws_size < WS_END || out_size != T * D || in_sizes[0] != T * D) { fprintf(stderr, "kernel_launch: unexpected shapes (n_in %d, ws %zu need %zu, out %d)\n", n_in, ws_size, (size_t)WS_END, out_size); grid = -1; return; }
        int dev = 0, cus = 0;
        if (hipGetDevice(&dev) != hipSuccess || hipDeviceGetAttribute(&cus, hipDeviceAttributeMultiprocessorCount, dev) != hipSuccess || cus < 160) { fprintf(stderr, "kernel_launch: device query failed or too few CUs (%d)\n", cus); grid = -1; return; }
        if (hipFuncSetAttribute((const void*)mk_fwd, hipFuncAttributeMaxDynamicSharedMemorySize, LDS_BYTES) != hipSuccess) { fprintf(stderr, "kernel_launch: hipFuncSetAttribute failed\n"); grid = -1; return; }
        int per_cu = 0;
        if (hipOccupancyMaxActiveBlocksPerMultiprocessor(&per_cu, (const void*)mk_fwd, NTHREADS, LDS_BYTES) != hipSuccess || per_cu < 1) fprintf(stderr, "kernel_launch: note: occupancy query reports %d workgroups per CU\n", per_cu);
        (void)hipGetLastError();
        grid = cus;
    }
    if (grid < 0) return;
    if (hipMemsetAsync((char*)d_ws + WS_CTL, 0, CTL_BYTES, stream) != hipSuccess) { fprintf(stderr, "kernel_launch: memset failed\n"); return; }
    MkArgs ma{}; for (int i = 0; i < 21; ++i) ma.in[i] = (const float*)d_in[i]; ma.out = (float*)d_out; ma.ws = (unsigned char*)d_ws;
#if MK_CUTS
    for (int p = 0; p < PH_END; ++p) { ma.ph_lo = p; ma.ph_hi = p + 1; hipLaunchKernelGGL(mk_fwd, dim3(grid), dim3(NTHREADS), LDS_BYTES, stream, ma); }
#else
    ma.ph_lo = 0; ma.ph_hi = PH_END;
    hipLaunchKernelGGL(mk_fwd, dim3(grid), dim3(NTHREADS), LDS_BYTES, stream, ma);
#endif
    const hipError_t le = hipPeekAtLastError();
    if (le != hipSuccess) fprintf(stderr, "kernel_launch: launch failed: %s\n", hipGetErrorName(le));
}
```

```cpp
#include <hip/hip_runtime.h>
#include <cstdio>
#include <cstdint>

#ifndef MK_CUTS
#define MK_CUTS 0
#endif
constexpr int T = 16384, D = 2048, HD = 128, NH = 8;
constexpr int INC = 7192;
constexpr int NPROJ = 7168;
constexpr int NGATE = 24;
constexpr int NEXP = 32, EPG = 8, NGRP = 4, DEXP = 1024, NROUTE = 36;
constexpr int CAP = 16384;
constexpr int HALF_ROWS = 128; constexpr int MAXTILES = 160, MAXROWS = MAXTILES * 256;
constexpr float RMS_EPS = 1e-6f, SOFTCAP = 15.0f, QK_SCALE = 0.08838834764831845f;

typedef unsigned short bf16_t;
typedef float f32x4 __attribute__((ext_vector_type(4)));
typedef unsigned u32x4 __attribute__((ext_vector_type(4)));
typedef unsigned u32x2 __attribute__((ext_vector_type(2)));

constexpr size_t al256(size_t x) { return (x + 255) & ~(size_t)255; }
constexpr size_t WS_CTL = 0, CTL_BYTES = 1u << 20;
constexpr size_t WS_WG = WS_CTL + CTL_BYTES;
constexpr size_t WS_WR = WS_WG + al256((size_t)NGATE * D * 4);
constexpr size_t WS_WINP = WS_WR + al256((size_t)2 * NROUTE * D * 4);
constexpr int NP16 = 4096, NP8 = 3072;
constexpr size_t WS_WINP8 = WS_WINP + (size_t)NP16 * D * 2;
constexpr size_t WS_WOUT = WS_WINP + al256((size_t)NPROJ * D * 2);
constexpr size_t WS_WPOOL = WS_WOUT + al256((size_t)D * D * 2);
constexpr size_t WS_WGU = WS_WPOOL + al256((size_t)4 * 512 * 512 * 2);
constexpr size_t WS_WD = WS_WGU + al256((size_t)2 * NEXP * 2048 * D * 2);
constexpr size_t WS_HN = WS_WD + al256((size_t)2 * NEXP * D * DEXP * 2);
constexpr size_t WS_GATES = WS_HN + al256((size_t)T * D * 2);
constexpr size_t WS_RPROJ = WS_GATES + al256((size_t)T * NGATE * 4);
constexpr size_t WS_P7 = WS_RPROJ + al256((size_t)T * NROUTE * 4);
constexpr size_t WS_CF = WS_P7 + al256((size_t)56 * T * HD * 2);
constexpr size_t WS_BM = WS_CF + al256((size_t)NH * T * 4);
constexpr size_t WS_IP = WS_BM + al256((size_t)NH * T * 4);
constexpr size_t WS_Y = WS_IP + al256((size_t)NH * T * 4);
constexpr size_t WS_ASGE = WS_Y + al256((size_t)T * D * 2);
constexpr size_t WS_ASGR = WS_ASGE + al256((size_t)T * 2 * 4);
constexpr size_t WS_ASGW = WS_ASGR + al256((size_t)T * 2 * 4);
constexpr size_t WS_CAPT = WS_ASGW + al256((size_t)T * 2 * 4);
constexpr size_t WS_CAPW = WS_CAPT + al256((size_t)NEXP * CAP * 4);
constexpr size_t WS_H = WS_CAPW + al256((size_t)NEXP * CAP * 4);
constexpr size_t WS_YS = WS_H + al256((size_t)MAXROWS * DEXP * 2);
constexpr size_t WS_POOLED = WS_YS + al256((size_t)MAXROWS * D * 2);
constexpr size_t WS_DC = WS_POOLED + al256((size_t)T * D * 2);
constexpr size_t WS_ND = WS_DC + al256((size_t)NH * 64 * HD * HD * 4);
constexpr size_t WS_CST = WS_ND + al256((size_t)NH * 64 * HD * 4);
constexpr size_t WS_NST = WS_CST + al256((size_t)NH * 64 * HD * HD * 2);
constexpr size_t WS_AQORD = WS_NST + al256((size_t)NH * 64 * HD * 4);
constexpr size_t WS_HN8 = WS_AQORD + 4096;
constexpr size_t WS_RSTD0 = WS_HN8 + (size_t)T * D;
constexpr size_t WS_RSTD = WS_RSTD0 + (size_t)T * 4;
constexpr size_t WS_AQORD2 = WS_RSTD + (size_t)T * 4;
constexpr size_t WS_AQCOMB = WS_AQORD2 + al256(4 * (2 + 2 * 2048));
constexpr size_t WS_END = WS_AQCOMB + 4096;
constexpr size_t WS_XB = WS_P7;
constexpr int AQ_MAXSUB = 2048, AQ_CHK = 56;
constexpr size_t WS_PO = WS_H;
constexpr size_t WS_PM = WS_PO + (size_t)AQ_MAXSUB * 256 * HD * 4;
constexpr size_t WS_PL = WS_PM + (size_t)AQ_MAXSUB * 256 * 4;
static_assert(WS_PL + (size_t)AQ_MAXSUB * 256 * 4 <= WS_DC, "attention partials must fit in the H | YS | POOLED overlay");
static_assert(WS_END <= 2147483648ull, "d_ws map exceeds the guaranteed 2 GiB");
constexpr int CW_AQ = 12288;
constexpr int CW_C3Q = 12288 + 64;
constexpr int CW_CNT = 8192, CNT_STRIDE = 64, CNT_LSTRIDE = 2048;

__device__ __forceinline__ float bf2f(bf16_t v) { return __uint_as_float(((unsigned)v) << 16); }
__device__ __forceinline__ unsigned f2bf(float f) { unsigned u = __float_as_uint(f); return (u + 0x7fffu + ((u >> 16) & 1u)) >> 16; }
__device__ __forceinline__ unsigned pk2(float lo, float hi) { return f2bf(lo) | (f2bf(hi) << 16); }
#define DPP_ADD(v, ctrl) ((v) + __builtin_bit_cast(float, __builtin_amdgcn_update_dpp(0, __builtin_bit_cast(int, (v)), (ctrl), 0xF, 0xF, false)))
__device__ __forceinline__ float wave_sum(float v) {
    v = DPP_ADD(v, 0xB1); v = DPP_ADD(v, 0x4E); v = DPP_ADD(v, 0x141); v = DPP_ADD(v, 0x140);
    const int b = __builtin_bit_cast(int, v);
    const float s0 = __builtin_bit_cast(float, __builtin_amdgcn_readlane(b, 0)), s1 = __builtin_bit_cast(float, __builtin_amdgcn_readlane(b, 16));
    const float s2 = __builtin_bit_cast(float, __builtin_amdgcn_readlane(b, 32)), s3 = __builtin_bit_cast(float, __builtin_amdgcn_readlane(b, 48));
    return (s0 + s1) + (s2 + s3);
}
__device__ __forceinline__ unsigned pk4_fp8(float a, float b, float c, float d) { int w = 0; w = __builtin_amdgcn_cvt_pk_fp8_f32(a, b, w, false); w = __builtin_amdgcn_cvt_pk_fp8_f32(c, d, w, true); return (unsigned)w; }
constexpr float W8_SCALE = 32.0f, W8_INV = 1.0f / 32.0f;
__device__ __forceinline__ float log_sigmoid(float x) { return fminf(x, 0.f) - log1pf(expf(-fabsf(x))); }
__device__ __forceinline__ float soft_cap(float x) { return SOFTCAP * tanhf(x * (1.0f / SOFTCAP)); }
__device__ __forceinline__ float sigmoidf(float x) { return 1.0f / (1.0f + expf(-x)); }

struct PrepArgs { const float *w_in, *w_out, *pool_w, *w_gate, *w_up, *w_down, *rgw, *rew; unsigned char* ws; };
constexpr int IT_INP = (D / 64) * (NPROJ / 32);
constexpr int IT_OUT = (D / 64) * (D / 32);
constexpr int IT_POOL = 4 * (512 / 64) * (512 / 32);
constexpr int IT_SMALL = IT_INP + IT_OUT + IT_POOL;
constexpr int IT_G = (D / 128) * (DEXP / 32);
constexpr int IT_DN = (DEXP / 128) * (D / 32);
constexpr int IT_EXP = 2 * NEXP * (2 * IT_G + IT_DN);
constexpr int IT_TOTAL = IT_SMALL;
struct ItemD { const float* src; bf16_t* dst; int ldn, ldk, f8; };
__device__ __forceinline__ ItemD prep_decode(const PrepArgs& a, int it) {
    unsigned char* ws = a.ws; ItemD d;
    if (it < IT_INP) {
        const int nblk = NPROJ / 32, kb = it / nblk, nb = it % nblk, n0 = nb * 32, blk = n0 >> 10;
        const int src_off[7] = {0, 1024, 2048, 3080, 4104, 5128, 6168};
        const int dpos[7] = {0, 1, 0, 2, 3, 1, 2}; const int is8[7] = {0, 0, 1, 0, 0, 1, 1};
        int so = 0, dp = 0, f8 = 0;
#pragma unroll
        for (int j = 0; j < 7; ++j) { so = (blk == j) ? src_off[j] : so; dp = (blk == j) ? dpos[j] : dp; f8 = (blk == j) ? is8[j] : f8; }
        d.src = a.w_in + (size_t)(kb * 64) * INC + so + (n0 & 1023); d.ldn = INC; d.f8 = f8; d.ldk = D;
        d.dst = f8 ? (bf16_t*)((unsigned char*)(ws + WS_WINP8) + (size_t)(dp * 1024 + (n0 & 1023)) * D + kb * 64) : (bf16_t*)(ws + WS_WINP) + (size_t)(dp * 1024 + (n0 & 1023)) * D + kb * 64; return d; }
    it -= IT_INP;
    if (it < IT_OUT) { const int nblk = D / 32, kb = it / nblk, nb = it % nblk; d.src = a.w_out + (size_t)(kb * 64) * D + nb * 32; d.ldn = D; d.dst = (bf16_t*)(ws + WS_WOUT) + (size_t)(nb * 32) * D + kb * 64; d.ldk = D; d.f8 = 0; return d; }
    it -= IT_OUT;
    if (it < IT_POOL) { const int g = it / 128, r = it % 128, kb = r / 16, nb = r % 16;
        d.src = a.pool_w + (size_t)g * 512 * 512 + (size_t)(kb * 64) * 512 + nb * 32; d.ldn = 512; d.dst = (bf16_t*)(ws + WS_WPOOL) + (size_t)g * 512 * 512 + (size_t)(nb * 32) * 512 + kb * 64; d.ldk = 512; d.f8 = 0; return d; }
    return d;
}
__device__ __forceinline__ ItemD prep_decode8(const PrepArgs& a, int it) {
    unsigned char* ws = a.ws; ItemD d; d.f8 = 1;
    const int per = 2 * IT_G + IT_DN, le = it / per; int r = it % per;
    if (r < 2 * IT_G) { const int g = r / IT_G; r %= IT_G; const int nblk = DEXP / 32, kb = r / nblk, nb = r % nblk, n0 = nb * 32;
        const float* W = (g ? a.w_up : a.w_gate) + (size_t)le * D * DEXP;
        d.src = W + (size_t)(kb * 128) * DEXP + n0; d.ldn = DEXP; d.dst = (bf16_t*)((unsigned char*)(ws + WS_WGU) + (size_t)le * 2048 * D + (size_t)(256 * (n0 >> 7) + 128 * g + (n0 & 127)) * D + kb * 128); d.ldk = D; return d; }
    r -= 2 * IT_G;
    { const int nblk = D / 32, kb = r / nblk, nb = r % nblk;
        d.src = a.w_down + (size_t)le * DEXP * D + (size_t)(kb * 128) * D + nb * 32; d.ldn = D; d.dst = (bf16_t*)((unsigned char*)(ws + WS_WD) + (size_t)le * D * DEXP + (size_t)(nb * 32) * DEXP + kb * 128); d.ldk = DEXP; return d; }
}
__device__ __forceinline__ void item_load(const ItemD& d, float (&r)[32], int lane) {
#pragma unroll
    for (int i = 0; i < 32; ++i) r[i] = __builtin_nontemporal_load(d.src + (size_t)(2 * i + (lane >> 5)) * d.ldn + (lane & 31));
}
__device__ __forceinline__ void item_store(const ItemD& d, const float (&r)[32], __attribute__((address_space(3))) float* scr, int lane) {
#pragma unroll
    for (int i = 0; i < 32; ++i) scr[(2 * i + (lane >> 5)) * 33 + (lane & 31)] = r[i];
    asm volatile("s_waitcnt lgkmcnt(0)" ::: "memory");
    if (d.f8) {
        const int n = lane >> 1, kh = lane & 1; const __attribute__((address_space(3))) float* sp = scr + (kh * 32) * 33 + n; u32x4 o0, o1;
#define P4(j) pk4_fp8(sp[(j) * 33] * W8_SCALE, sp[((j) + 1) * 33] * W8_SCALE, sp[((j) + 2) * 33] * W8_SCALE, sp[((j) + 3) * 33] * W8_SCALE)
        o0.x = P4(0); o0.y = P4(4); o0.z = P4(8); o0.w = P4(12); o1.x = P4(16); o1.y = P4(20); o1.z = P4(24); o1.w = P4(28);
#undef P4
        unsigned char* dp = (unsigned char*)d.dst + (size_t)n * d.ldk + kh * 32; *(u32x4*)dp = o0; *(u32x4*)(dp + 16) = o1;
    } else {
    const int c = lane & 7;
#pragma unroll
    for (int j = 0; j < 4; ++j) { const int n = (lane >> 3) + 8 * j; const __attribute__((address_space(3))) float* s = scr + (8 * c) * 33 + n;
        u32x4 o; o.x = pk2(s[0 * 33], s[1 * 33]); o.y = pk2(s[2 * 33], s[3 * 33]); o.z = pk2(s[4 * 33], s[5 * 33]); o.w = pk2(s[6 * 33], s[7 * 33]);
        *(u32x4*)(d.dst + (size_t)n * d.ldk + 8 * c) = o; }
    }
    asm volatile("s_waitcnt lgkmcnt(0)" ::: "memory");
}
__device__ __forceinline__ void item_load8(const ItemD& d, f32x4 (&r)[16], int lane) {
#pragma unroll
    for (int i = 0; i < 16; ++i) r[i] = __builtin_nontemporal_load((const f32x4*)(d.src + (size_t)(8 * i + (lane >> 3)) * d.ldn + (lane & 7) * 4));
}
__device__ __forceinline__ void item_store8(const ItemD& d, const f32x4 (&r)[16], __attribute__((address_space(3))) float* scr, int lane) {
#pragma unroll
    for (int i = 0; i < 16; ++i) { __attribute__((address_space(3))) float* p = scr + (8 * i + (lane >> 3)) * 33 + (lane & 7) * 4; p[0] = r[i].x; p[1] = r[i].y; p[2] = r[i].z; p[3] = r[i].w; }
    asm volatile("s_waitcnt lgkmcnt(0)" ::: "memory");
    const int n = lane >> 1, kh = lane & 1; const __attribute__((address_space(3))) float* sp = scr + (kh * 64) * 33 + n;
    unsigned char* dp = (unsigned char*)d.dst + (size_t)n * d.ldk + kh * 64;
#define P4(j) pk4_fp8(sp[(j) * 33] * W8_SCALE, sp[((j) + 1) * 33] * W8_SCALE, sp[((j) + 2) * 33] * W8_SCALE, sp[((j) + 3) * 33] * W8_SCALE)
#pragma unroll
    for (int q = 0; q < 4; ++q) { u32x4 o; o.x = P4(16 * q); o.y = P4(16 * q + 4); o.z = P4(16 * q + 8); o.w = P4(16 * q + 12); *(u32x4*)(dp + 16 * q) = o; }
#undef P4
    asm volatile("s_waitcnt lgkmcnt(0)" ::: "memory");
}
__device__ __forceinline__ void prep_loop8(const PrepArgs& a, int gw, int ngw, __attribute__((address_space(3))) float* scr, int lane) {
    int it = gw; if (it >= IT_EXP) return;
    ItemD d = prep_decode8(a, it); f32x4 r[16]; item_load8(d, r, lane);
#pragma unroll 1
    for (;;) { const int itn = it + ngw; const bool more = itn < IT_EXP;
        ItemD dn = d; f32x4 rn[16];
        if (more) { dn = prep_decode8(a, itn); item_load8(dn, rn, lane); }
        item_store8(d, r, scr, lane);
        if (!more) break;
#pragma unroll
        for (int i = 0; i < 16; ++i) r[i] = rn[i];
        d = dn; it = itn; }
}
__device__ __forceinline__ void prep_loop(const PrepArgs& a, int gw, int ngw, __attribute__((address_space(3))) float* scr, int lane) {
    int it = gw; if (it >= IT_TOTAL) return;
    __attribute__((address_space(3))) float* scr2 = scr + 64 * 33;
    ItemD d0 = prep_decode(a, it), d1 = d0; bool h1 = it + ngw < IT_TOTAL; if (h1) d1 = prep_decode(a, it + ngw);
    float r0[32], r1[32]; item_load(d0, r0, lane); if (h1) item_load(d1, r1, lane);
#pragma unroll 1
    for (;;) { const int itn = it + 2 * ngw; const bool m0 = itn < IT_TOTAL, m1 = itn + ngw < IT_TOTAL;
        ItemD dn0 = d0, dn1 = d1; float rn0[32], rn1[32];
        if (m0) { dn0 = prep_decode(a, itn); item_load(dn0, rn0, lane); }
        if (m1) { dn1 = prep_decode(a, itn + ngw); item_load(dn1, rn1, lane); }
        item_store(d0, r0, scr, lane); if (h1) item_store(d1, r1, scr2, lane);
        if (!m0) break;
#pragma unroll
        for (int i = 0; i < 32; ++i) { r0[i] = rn0[i]; r1[i] = rn1[i]; }
        d0 = dn0; d1 = dn1; h1 = m1; it = itn; }
}

constexpr int BI_PER_E = 192, BI_TOTAL = 2 * NEXP * BI_PER_E;
struct BItem { const float* src; unsigned char* dst; int ldn, ldk, gu; };
__device__ __forceinline__ BItem bi_decode(const PrepArgs& a, int b) {
    BItem d; const int le = b / BI_PER_E, r = b % BI_PER_E;
    if (r < 128) { const int g = r >> 6, r2 = r & 63, kb = r2 >> 2, nb = r2 & 3;
        d.src = (g ? a.w_up : a.w_gate) + (size_t)le * D * DEXP + (size_t)(kb * 128) * DEXP + nb * 256; d.ldn = DEXP;
        d.dst = a.ws + WS_WGU + (size_t)le * 2048 * D + (size_t)(512 * nb + 128 * g) * D + kb * 128; d.ldk = D; d.gu = 1; }
    else { const int r3 = r - 128, kb = r3 >> 3, nb = r3 & 7;
        d.src = a.w_down + (size_t)le * DEXP * D + (size_t)(kb * 128) * D + nb * 256; d.ldn = D;
        d.dst = a.ws + WS_WD + (size_t)le * D * DEXP + (size_t)(nb * 256) * DEXP + kb * 128; d.ldk = DEXP; d.gu = 0; }
    return d;
}
__device__ __forceinline__ void prep_block8(const PrepArgs& a, __attribute__((address_space(3))) unsigned char* lds, int bx, int G, int b_end = BI_TOTAL) {
    typedef __attribute__((address_space(3))) float lfloat; typedef __attribute__((address_space(3))) f32x4 lf32x4;
    constexpr int PT = 260;
    int tid = threadIdx.x; asm volatile("" : "+v"(tid));
    const int lane = tid & 63, wave = __builtin_amdgcn_readfirstlane(tid >> 6);
    lfloat* tile = (lfloat*)lds;
    int b = bx; if (b >= b_end) return;
    BItem d = bi_decode(a, b); f32x4 r[16];
#define BI_LOAD(dd, rr) do { _Pragma("unroll") for (int i = 0; i < 16; ++i) rr[i] = __builtin_nontemporal_load((const f32x4*)((dd).src + (size_t)(i * 8 + wave) * (dd).ldn) + lane); } while (0)
    BI_LOAD(d, r);
#pragma unroll 1
    for (;;) { const int bn = b + G; const bool more = bn < b_end;
#pragma unroll
        for (int i = 0; i < 16; ++i) *(lf32x4*)(tile + (i * 8 + wave) * PT + lane * 4) = r[i];
        __syncthreads();
        BItem dn = d; if (more) { dn = bi_decode(a, bn); BI_LOAD(dn, r); }
        { const int nl = tid >> 1, kh = tid & 1; const lfloat* sp = tile + (kh * 64) * PT + nl; u32x4 o[4];
#define P4(j) pk4_fp8(sp[(j) * PT] * W8_SCALE, sp[((j) + 1) * PT] * W8_SCALE, sp[((j) + 2) * PT] * W8_SCALE, sp[((j) + 3) * PT] * W8_SCALE)
#pragma unroll
          for (int q = 0; q < 4; ++q) { o[q].x = P4(16 * q); o[q].y = P4(16 * q + 4); o[q].z = P4(16 * q + 8); o[q].w = P4(16 * q + 12); }
#undef P4
          typedef __attribute__((address_space(3))) u32x4 lu32x4; __attribute__((address_space(3))) unsigned char* S8 = (__attribute__((address_space(3))) unsigned char*)tile;
          __syncthreads();
#pragma unroll
          for (int q = 0; q < 4; ++q) *(lu32x4*)(S8 + nl * 144 + kh * 64 + 16 * q) = o[q];
          __syncthreads();
#pragma unroll
          for (int rr = 0; rr < 4; ++rr) { const int line = (tid >> 3) + 64 * rr, ch = tid & 7; const u32x4 v = *(const lu32x4*)(S8 + line * 144 + ch * 16);
              *(u32x4*)(d.dst + (size_t)(d.gu ? 256 * (line >> 7) + (line & 127) : line) * d.ldk + ch * 16) = v; }
        }
        __syncthreads();
        if (!more) break;
        d = dn; b = bn; }
#undef BI_LOAD
}
constexpr int NTHREADS_NP = 512;
template <int NC>
__device__ __forceinline__ float norm_proj_row(const float* __restrict__ xrow, const float* __restrict__ g, const float* __restrict__ Wc, bf16_t* __restrict__ hnrow, int lane) {
    const f32x4* xr = (const f32x4*)xrow + lane; const f32x4* gr = (const f32x4*)g + lane;
    f32x4 v[8]; float s = 0.f;
#pragma unroll
    for (int j = 0; j < 8; ++j) { v[j] = xr[64 * j]; s += (v[j].x * v[j].x + v[j].y * v[j].y) + (v[j].z * v[j].z + v[j].w * v[j].w); }
    const float rstd = 1.0f / sqrtf(wave_sum(s) * (1.0f / D) + RMS_EPS);
    u32x2* o8 = (u32x2*)hnrow + lane;
#pragma unroll
    for (int j = 0; j < 8; ++j) { const f32x4 gg = gr[64 * j]; v[j] = v[j] * rstd * gg; u32x2 w; w.x = pk2(v[j].x, v[j].y); w.y = pk2(v[j].z, v[j].w); o8[64 * j] = w; }
    float mine = 0.f;
    for (int c = 0; c < NC; ++c) { const f32x4* wr = (const f32x4*)(Wc + (size_t)c * D) + lane; float a = 0.f;
#pragma unroll
        for (int j = 0; j < 8; ++j) { const f32x4 w = wr[64 * j]; a += (v[j].x * w.x + v[j].y * w.y) + (v[j].z * w.z + v[j].w * w.w); }
        a = wave_sum(a); mine = (lane == c) ? a : mine; }
    return mine;
}
__device__ __forceinline__ void route_token(float mine, int slot2, const float* gb, const float* eb, __attribute__((address_space(3))) unsigned* lcnt, __attribute__((address_space(3))) unsigned* lasg, int lane) {
    float gl[4]; int gs = 0;
#pragma unroll
    for (int i = 0; i < 4; ++i) gl[i] = __shfl(mine, i) + gb[i];
#pragma unroll
    for (int i = 1; i < 4; ++i) if (gl[i] > gl[gs]) gs = i;
    float se = 0.f;
#pragma unroll
    for (int i = 0; i < 4; ++i) se += expf(gl[i] - gl[gs]);
    const float gw = 1.0f / se;
    float el[8];
#pragma unroll
    for (int i = 0; i < 8; ++i) el[i] = __shfl(mine, 4 + gs * 8 + i) + eb[gs * 8 + i];
    int i0 = 0;
#pragma unroll
    for (int i = 1; i < 8; ++i) if (el[i] > el[i0]) i0 = i;
    int i1 = -1; float e1v = 0.f;
#pragma unroll
    for (int i = 0; i < 8; ++i) if (i != i0 && (i1 < 0 || el[i] > e1v)) { i1 = i; e1v = el[i]; }
    float e0v = el[0];
#pragma unroll
    for (int i = 1; i < 8; ++i) e0v = (i == i0) ? el[i] : e0v;
    const float e1 = expf(e1v - e0v); const float w0 = gw / (1.0f + e1), w1 = gw * e1 / (1.0f + e1);
    if (lane < 2) { const int ex = gs * 8 + (lane ? i1 : i0); const float ww = lane ? w1 : w0;
        const unsigned lr = __hip_atomic_fetch_add(lcnt + ex, 1u, __ATOMIC_RELAXED, __HIP_MEMORY_SCOPE_WORKGROUP);
        lasg[(slot2 + lane) * 3 + 0] = (unsigned)ex; lasg[(slot2 + lane) * 3 + 1] = lr; lasg[(slot2 + lane) * 3 + 2] = __float_as_uint(ww); }
}
struct NormProjArgs { const float* x; const bf16_t* xb; const float* g; const float* Wc; bf16_t* hn; unsigned char* hn8; float* rstd; float* gates; float* cf; float* bm; float* ip; const float* fox_fb; const float* m_ib; const float* m_fb; const float* gb; const float* eb; unsigned* cnt; int* asg_e; int* asg_r; int* capt; float* capw; };
template <int NC, int MODE>
__device__ __forceinline__ void norm_proj_block(__attribute__((address_space(3))) unsigned char* lds, const NormProjArgs& P, int rb) {
    typedef __attribute__((address_space(3))) float lfloat; typedef __attribute__((address_space(3))) f32x4 lf32x4;
    int tid = threadIdx.x; asm volatile("" : "+v"(tid));
    const int lane = tid & 63, wave = __builtin_amdgcn_readfirstlane(tid >> 6);
    const int r0 = rb * 64 + wave * 8; const unsigned loff = (unsigned)lane * 16u;
    if (MODE == 1 && tid < NEXP) ((__attribute__((address_space(3))) unsigned*)(lds + 147456))[tid] = 0u;
    float rs[8];
    { f32x4 gf[8];
#pragma unroll
      for (int j = 0; j < 8; ++j) gf[j] = *(const f32x4*)((const char*)P.g + loff + j * 1024);
      f32x4 vn[8];
#pragma unroll
      for (int j = 0; j < 8; ++j) vn[j] = *(const f32x4*)((const char*)(P.x + (size_t)r0 * D) + loff + j * 1024);
#pragma unroll 1
      for (int i = 0; i < 8; ++i) { f32x4 v[8]; float s = 0.f;
#pragma unroll
        for (int j = 0; j < 8; ++j) { v[j] = vn[j]; s += (v[j].x * v[j].x + v[j].y * v[j].y) + (v[j].z * v[j].z + v[j].w * v[j].w); }
        { const int inx = i < 7 ? i + 1 : i;
#pragma unroll
            for (int j = 0; j < 8; ++j) vn[j] = *(const f32x4*)((const char*)(P.x + (size_t)(r0 + inx) * D) + loff + j * 1024); }
        const float rstd = 1.0f / sqrtf(wave_sum(s) * (1.0f / D) + RMS_EPS);
        if (MODE == 1) { unsigned char* o1 = (unsigned char*)P.hn + (size_t)(r0 + i) * D;
#pragma unroll
            for (int j = 0; j < 8; ++j) { const f32x4 y = v[j] * rstd * gf[j]; *(unsigned*)(o1 + (loff >> 2) + j * 256) = pk4_fp8(y.x, y.y, y.z, y.w); } }
        else { char* o8 = (char*)(P.hn + (size_t)(r0 + i) * D);
#pragma unroll
        for (int j = 0; j < 8; ++j) { const f32x4 y = v[j] * rstd * gf[j]; u32x2 w; w.x = pk2(y.x, y.y); w.y = pk2(y.z, y.w); *(u32x2*)(o8 + (loff >> 1) + j * 512) = w; } }
#pragma unroll
        for (int q = 0; q < 8; ++q) rs[q] = (q == i) ? rstd : rs[q]; } }
    typedef float f32x2 __attribute__((ext_vector_type(2)));
    constexpr int NJ = (NC + 15) / 16;
    float acc[8][NJ];
#pragma unroll
    for (int q = 0; q < 8; ++q)
#pragma unroll
        for (int j = 0; j < NJ; ++j) acc[q][j] = 0.f;
    lfloat* Wl = (lfloat*)lds;
#pragma unroll 1
    for (int ch = 0; ch < 2; ++ch) {
        __syncthreads();
#pragma unroll 6
        for (int i = tid; i < NC * 256; i += NTHREADS_NP) { const int c = i >> 8, k4 = i & 255; *(lf32x4*)(Wl + c * 1024 + k4 * 4) = *(const f32x4*)(P.Wc + (size_t)c * D + ch * 1024 + k4 * 4); }
        __syncthreads();
#pragma unroll
        for (int grp = 0; grp < 2; ++grp) { f32x4 v[4][4];
#pragma unroll
            for (int j = 0; j < 4; ++j) { const f32x4 gg = *(const f32x4*)((const char*)(P.g + ch * 1024) + loff + j * 1024);
#pragma unroll
                for (int r = 0; r < 4; ++r) v[r][j] = *(const f32x4*)((const char*)(P.x + (size_t)(r0 + grp * 4 + r) * D + ch * 1024) + loff + j * 1024) * gg * rs[grp * 4 + r]; }
#pragma unroll
            for (int cj = 0; cj < NJ; ++cj) {
#pragma unroll 2
                for (int cc = 0; cc < 16; ++cc) { const int c = cj * 16 + cc; if (c < NC) { f32x4 w[4];
#pragma unroll
                    for (int j = 0; j < 4; ++j) w[j] = *((const lf32x4*)(Wl + c * 1024) + j * 64 + lane);
#pragma unroll
                    for (int r = 0; r < 4; ++r) { f32x2 a2 = {0.f, 0.f};
#pragma unroll
                        for (int j = 0; j < 4; ++j) { a2 += (f32x2){v[r][j].x, v[r][j].y} * (f32x2){w[j].x, w[j].y}; a2 += (f32x2){v[r][j].z, v[r][j].w} * (f32x2){w[j].z, w[j].w}; }
                        float a = a2.x + a2.y;
                        a = DPP_ADD(a, 0xB1); a = DPP_ADD(a, 0x4E); a = DPP_ADD(a, 0x141); a = DPP_ADD(a, 0x140);
                        acc[grp * 4 + r][cj] += ((lane & 15) == cc) ? a : 0.f; } } }
            }
        }
    }
    __syncthreads();
    lfloat* Lg = (lfloat*)lds + (size_t)wave * 8 * 48;
#pragma unroll
    for (int q = 0; q < 8; ++q)
#pragma unroll
        for (int j = 0; j < NJ; ++j) { float t = acc[q][j]; t += __shfl_xor(t, 16); t += __shfl_xor(t, 32); if (lane < 16) Lg[q * 48 + j * 16 + lane] = t; }
    asm volatile("s_waitcnt lgkmcnt(0)" ::: "memory");
    typedef __attribute__((address_space(3))) unsigned luint;
    luint* lcnt = (luint*)(lds + 147456); luint* lbase = lcnt + 32; luint* lasg = lcnt + 64;
    if (MODE == 0) {
#pragma unroll
        for (int i = lane; i < 8 * NC; i += 64) P.gates[(size_t)r0 * NC + i] = Lg[(i / NC) * 48 + (i % NC)];
    } else if (lane < 8) {
        const lfloat* lg = Lg + lane * 48;
        float gl[4]; int gs = 0;
#pragma unroll
        for (int i = 0; i < 4; ++i) gl[i] = lg[i] + P.gb[i];
        float gmax = gl[0];
#pragma unroll
        for (int i = 1; i < 4; ++i) if (gl[i] > gmax) { gmax = gl[i]; gs = i; }
        float se = 0.f;
#pragma unroll
        for (int i = 0; i < 4; ++i) se += expf(gl[i] - gmax);
        const float gw = 1.0f / se;
        float e0v = -3.0e38f, e1v = -3.0e38f; int i0 = 0, i1 = 0;
#pragma unroll
        for (int i = 0; i < 8; ++i) { const float e = lg[4 + gs * 8 + i] + P.eb[gs * 8 + i];
            if (e > e0v) { e1v = e0v; i1 = i0; e0v = e; i0 = i; } else if (e > e1v) { e1v = e; i1 = i; } }
        const float e1 = expf(e1v - e0v); const float wv[2] = {gw / (1.0f + e1), gw * e1 / (1.0f + e1)}; const int ev[2] = {gs * 8 + i0, gs * 8 + i1};
#pragma unroll
        for (int k = 0; k < 2; ++k) { const unsigned lr = __hip_atomic_fetch_add(lcnt + ev[k], 1u, __ATOMIC_RELAXED, __HIP_MEMORY_SCOPE_WORKGROUP); const int sl = ((wave * 8 + lane) * 2 + k) * 3;
            lasg[sl] = (unsigned)ev[k]; lasg[sl + 1] = lr; lasg[sl + 2] = __float_as_uint(wv[k]); }
    }
    if (MODE == 1) {
        __syncthreads();
        if (tid < NEXP) { const unsigned n = lcnt[tid]; lbase[tid] = n ? atomicAdd(P.cnt + tid * CNT_STRIDE, n) : 0u; }
        __syncthreads();
        if (tid < 128) { const int ex = (int)lasg[tid * 3], r = (int)(lbase[ex] + lasg[tid * 3 + 1]); const int row = rb * 64 + (tid >> 1);
            P.asg_e[row * 2 + (tid & 1)] = ex; P.asg_r[row * 2 + (tid & 1)] = r; P.capt[(size_t)ex * CAP + r] = row; P.capw[(size_t)ex * CAP + r] = __uint_as_float(lasg[tid * 3 + 2]); }
        __syncthreads();
        if (tid < NEXP) lcnt[tid] = 0u;
    }
    __syncthreads();
}
__device__ __forceinline__ void split3_bf16(float w, unsigned& h, unsigned& m, unsigned& l) { h = f2bf(w); const float r1 = w - __uint_as_float(h << 16); m = f2bf(r1); const float r2 = r1 - __uint_as_float(m << 16); l = f2bf(r2); }
template <int NC, int MODE>
__device__ __forceinline__ void norm_proj_block2(__attribute__((address_space(3))) unsigned char* lds, const NormProjArgs& P, int rb) {
    typedef __attribute__((address_space(3))) float lfloat; typedef __attribute__((address_space(3))) f32x4 lf32x4;
    constexpr int NCB = (NC + 15) / 16, PX = 260, KC = 256, NCHK = D / KC;
    int tid = threadIdx.x; asm volatile("" : "+v"(tid));
    const int lane = tid & 63, wave = __builtin_amdgcn_readfirstlane(tid >> 6);
    typedef short nb16x8 __attribute__((ext_vector_type(8))); typedef __attribute__((address_space(3))) nb16x8 lnb16x8; typedef __attribute__((address_space(3))) u32x2 lu32x2;
    constexpr int PB = 528;
    __attribute__((address_space(3))) unsigned char* Xb = lds; __attribute__((address_space(3))) unsigned char* Wh = lds + 64 * PB; __attribute__((address_space(3))) unsigned char* Wm = Wh + 48 * PB; __attribute__((address_space(3))) unsigned char* Wl = Wm + 48 * PB;
    lfloat* Xs = (lfloat*)lds; lfloat* Ws = Xs + 64 * PX; lfloat* Rs = MODE == 1 ? (lfloat*)(Wl + 48 * PB) : Ws + 48 * PX;
    typedef __attribute__((address_space(3))) unsigned luint;
    luint* lcnt = (luint*)(lds + 147456); luint* lbase = lcnt + 32; luint* lasg = lcnt + 64;
    if (MODE == 1 && tid < NEXP) lcnt[tid] = 0u;
    if (MODE == 1) { for (int i = tid; i < 3 * (48 - NC) * (PB / 4); i += NTHREADS_NP) { const int a_ = i / ((48 - NC) * (PB / 4)), o_ = i % ((48 - NC) * (PB / 4)); ((luint*)(Wh + a_ * 48 * PB + NC * PB))[o_] = 0u; } }
    else for (int i = tid; i < (48 - NC) * PX; i += NTHREADS_NP) Ws[NC * PX + i] = 0.f;
    const float* xrow = P.x + (size_t)(rb * 64 + wave * 8) * D + lane * 4;
    const bf16_t* xbrow = P.xb + (size_t)(rb * 64 + wave * 8) * D + lane * 4;
    f32x4 xrA[8], wrA[5], xrB[8], gA, gB; u32x2 xqA[8], xqB[8]; float ssq[8];
#pragma unroll
    for (int j = 0; j < 8; ++j) ssq[j] = 0.f;
#define NP2_FETCH(xr, xq, gx, ch_) do { gx = *(const f32x4*)(P.g + (ch_) * KC + lane * 4); _Pragma("unroll") for (int j = 0; j < 8; ++j) { if (MODE == 1) xq[j] = *(const u32x2*)(xbrow + (size_t)j * D + (ch_) * KC); else xr[j] = *(const f32x4*)(xrow + (size_t)j * D + (ch_) * KC); } } while (0)
#define NP2_FETCHW(wr, ch_) do { _Pragma("unroll") for (int j = 0; j < 5; ++j) if (j * NTHREADS_NP < NC * 64) { int i_ = tid + j * NTHREADS_NP; i_ = i_ < NC * 64 ? i_ : NC * 64 - 1;     \
            wr[j] = *(const f32x4*)(P.Wc + (size_t)(i_ >> 6) * D + (ch_) * KC + lane * 4); } } while (0)
#define NP2_PUT(xr, xq, wr, gx, ch_) do { _Pragma("unroll") for (int j = 0; j < 8; ++j) { const f32x4 xv_ = MODE == 1 ? (f32x4){__uint_as_float(xq[j].x << 16), __uint_as_float(xq[j].x & 0xffff0000u), __uint_as_float(xq[j].y << 16), __uint_as_float(xq[j].y & 0xffff0000u)} : xr[j]; \
            if (MODE == 1) *(lu32x2*)(Xb + (wave * 8 + j) * PB + lane * 8) = xq[j]; else *(lf32x4*)(Xs + (wave * 8 + j) * PX + lane * 4) = xv_; ssq[j] += (xv_.x * xv_.x + xv_.y * xv_.y) + (xv_.z * xv_.z + xv_.w * xv_.w); \
            const f32x4 y_ = xv_ * gx; const size_t e_ = (size_t)(rb * 64 + wave * 8 + j) * D + (ch_) * KC + lane * 4;     \
            if (MODE == 1) *(unsigned*)((unsigned char*)P.hn + e_) = pk4_fp8(y_.x, y_.y, y_.z, y_.w); else { u32x2 w_; w_.x = pk2(y_.x, y_.y); w_.y = pk2(y_.z, y_.w); *(u32x2*)(P.hn + e_) = w_; *(unsigned*)(P.hn8 + e_) = pk4_fp8(y_.x, y_.y, y_.z, y_.w); } } \
        _Pragma("unroll") for (int j = 0; j < 5; ++j) if (j * NTHREADS_NP < NC * 64) { const int i_ = tid + j * NTHREADS_NP; if (i_ < NC * 64) { const f32x4 wg_ = wr[j] * gx;     \
            if (MODE == 1) { unsigned h0, m0, l0, h1, m1, l1, h2, m2, l2, h3, m3, l3; split3_bf16(wg_.x, h0, m0, l0); split3_bf16(wg_.y, h1, m1, l1); split3_bf16(wg_.z, h2, m2, l2); split3_bf16(wg_.w, h3, m3, l3); \
                const int o_ = (i_ >> 6) * PB + lane * 8; *(lu32x2*)(Wh + o_) = (u32x2){h0 | (h1 << 16), h2 | (h3 << 16)}; *(lu32x2*)(Wm + o_) = (u32x2){m0 | (m1 << 16), m2 | (m3 << 16)}; *(lu32x2*)(Wl + o_) = (u32x2){l0 | (l1 << 16), l2 | (l3 << 16)}; } \
            else *(lf32x4*)(Ws + (i_ >> 6) * PX + lane * 4) = wg_; } } } while (0)
#define NP2_MMA() do { if (MODE == 1) { _Pragma("unroll") for (int ks = 0; ks < 4; ++ks) { const nb16x8 a_ = *(const lnb16x8*)(abase8 + ks * 64); \
            _Pragma("unroll") for (int cb = 0; cb < NCB; ++cb) { const nb16x8 bl_ = *(const lnb16x8*)(Wl + bbase8 + cb * 16 * PB + ks * 64), bm_ = *(const lnb16x8*)(Wm + bbase8 + cb * 16 * PB + ks * 64), bh_ = *(const lnb16x8*)(Wh + bbase8 + cb * 16 * PB + ks * 64); \
                acc[cb] = __builtin_amdgcn_mfma_f32_16x16x32_bf16(a_, bl_, acc[cb], 0, 0, 0); acc[cb] = __builtin_amdgcn_mfma_f32_16x16x32_bf16(a_, bm_, acc[cb], 0, 0, 0); acc[cb] = __builtin_amdgcn_mfma_f32_16x16x32_bf16(a_, bh_, acc[cb], 0, 0, 0); } } } \
        else _Pragma("unroll") for (int g8 = 0; g8 < 8; ++g8) { const f32x4 av = *(const lf32x4*)(abase + g8 * 16); f32x4 bv[NCB]; \
            _Pragma("unroll") for (int cb = 0; cb < NCB; ++cb) bv[cb] = *(const lf32x4*)(bbase + cb * 16 * PX + g8 * 16); \
            _Pragma("unroll") for (int e = 0; e < 4; ++e) _Pragma("unroll") for (int cb = 0; cb < NCB; ++cb) acc[cb] = __builtin_amdgcn_mfma_f32_16x16x4f32(av[e], bv[cb][e], acc[cb], 0, 0, 0); } } while (0)
    const int rbk = wave & 3, kh = wave >> 2;
    const lfloat* abase = Xs + (rbk * 16 + (lane & 15)) * PX + kh * 128 + (lane >> 4) * 4;
    const lfloat* bbase = Ws + (lane & 15) * PX + kh * 128 + (lane >> 4) * 4;
    const __attribute__((address_space(3))) unsigned char* abase8 = Xb + (rbk * 16 + (lane & 15)) * PB + (kh * 128 + (lane >> 4) * 8) * 2; const int bbase8 = (lane & 15) * PB + (kh * 128 + (lane >> 4) * 8) * 2;
    f32x4 acc[NCB];
#pragma unroll
    for (int cb = 0; cb < NCB; ++cb) acc[cb] = (f32x4){0.f, 0.f, 0.f, 0.f};
    NP2_FETCH(xrA, xqA, gA, 0); NP2_FETCH(xrB, xqB, gB, 1); NP2_FETCHW(wrA, 0);
    __syncthreads();
#pragma unroll 1
    for (int ch = 0; ch < NCHK; ch += 2) {
        NP2_PUT(xrA, xqA, wrA, gA, ch);
        __syncthreads();
        if (ch + 2 < NCHK) NP2_FETCH(xrA, xqA, gA, ch + 2);
        NP2_FETCHW(wrA, ch + 1);
        NP2_MMA();
        __syncthreads();
        NP2_PUT(xrB, xqB, wrA, gB, ch + 1);
        __syncthreads();
        if (ch + 3 < NCHK) NP2_FETCH(xrB, xqB, gB, ch + 3);
        { const int cw = ch + 2 < NCHK ? ch + 2 : ch + 1; NP2_FETCHW(wrA, cw); }
        NP2_MMA();
        __syncthreads();
    }
#undef NP2_FETCH
#undef NP2_FETCHW
#undef NP2_PUT
#undef NP2_MMA
#pragma unroll
    for (int j = 0; j < 8; ++j) { const float t = wave_sum(ssq[j]); if (lane == 0) { const float r_ = 1.0f / sqrtf(t * (1.0f / D) + RMS_EPS); Rs[wave * 8 + j] = r_; P.rstd[rb * 64 + wave * 8 + j] = r_; } }
    lfloat* Pk = Xs;
#pragma unroll
    for (int cb = 0; cb < NCB; ++cb)
#pragma unroll
        for (int r = 0; r < 4; ++r) Pk[(kh * 64 + rbk * 16 + 4 * (lane >> 4) + r) * 48 + cb * 16 + (lane & 15)] = acc[cb][r];
    __syncthreads();
    lfloat* Lg = Xs + 2 * 64 * 48;
    for (int i = tid; i < 64 * 48; i += NTHREADS_NP) Lg[i] = (Pk[i] + Pk[64 * 48 + i]) * Rs[i / 48];
    __syncthreads();
    const int r0 = rb * 64 + wave * 8;
    const lfloat* Lw = Lg + wave * 8 * 48;
    if (MODE == 0) {
        { const int col = tid & 7, row = tid >> 3; P.ip[(size_t)col * T + rb * 64 + row] = soft_cap(Lg[row * 48 + 8 + col] + P.m_ib[col]); }
        if (wave == 0) { const int cc = lane & 15, q = lane >> 4, h = cc & 7; const bool ml = cc >= 8; const int col = ml ? 16 + h : h;
            const float fb = ml ? P.m_fb[h] : P.fox_fb[h];
            float v[16]; float s = 0.f;
#pragma unroll
            for (int i = 0; i < 16; ++i) { const float z = Lg[(q * 16 + i) * 48 + col] + fb; const float lf = ml ? log_sigmoid(soft_cap(z)) : log_sigmoid(z); s += lf; v[i] = s; }
            const float t0 = __shfl(s, cc), t1 = __shfl(s, cc + 16), t2 = __shfl(s, cc + 32), t3 = __shfl(s, cc + 48);
            const float base = (q > 0 ? t0 : 0.f) + (q > 1 ? t1 : 0.f) + (q > 2 ? t2 : 0.f);
            float* out = (ml ? P.bm : P.cf) + (size_t)h * T + rb * 64 + q * 16;
#pragma unroll
            for (int i = 0; i < 16; i += 4) *(f32x4*)(out + i) = (f32x4){base + v[i], base + v[i + 1], base + v[i + 2], base + v[i + 3]};
            if (q == 0) P.gates[cc * (T / 64) + rb] = (t0 + t1) + (t2 + t3); }
    } else if (lane < 8) {
        const lfloat* lg = Lw + lane * 48;
        float gl[4]; int gs = 0;
#pragma unroll
        for (int i = 0; i < 4; ++i) gl[i] = lg[i] + P.gb[i];
        float gmax = gl[0];
#pragma unroll
        for (int i = 1; i < 4; ++i) if (gl[i] > gmax) { gmax = gl[i]; gs = i; }
        float se = 0.f;
#pragma unroll
        for (int i = 0; i < 4; ++i) se += expf(gl[i] - gmax);
        const float gw = 1.0f / se;
        float e0v = -3.0e38f, e1v = -3.0e38f; int i0 = 0, i1 = 0;
#pragma unroll
        for (int i = 0; i < 8; ++i) { const float e = lg[4 + gs * 8 + i] + P.eb[gs * 8 + i];
            if (e > e0v) { e1v = e0v; i1 = i0; e0v = e; i0 = i; } else if (e > e1v) { e1v = e; i1 = i; } }
        const float e1 = expf(e1v - e0v); const float wv[2] = {gw / (1.0f + e1), gw * e1 / (1.0f + e1)}; const int ev[2] = {gs * 8 + i0, gs * 8 + i1};
#pragma unroll
        for (int k = 0; k < 2; ++k) { const unsigned lr = __hip_atomic_fetch_add(lcnt + ev[k], 1u, __ATOMIC_RELAXED, __HIP_MEMORY_SCOPE_WORKGROUP); const int sl = ((wave * 8 + lane) * 2 + k) * 3;
            lasg[sl] = (unsigned)ev[k]; lasg[sl + 1] = lr; lasg[sl + 2] = __float_as_uint(wv[k]); }
    }
    if (MODE == 1) {
        __syncthreads();
        if (tid < NEXP) { const unsigned n = lcnt[tid]; lbase[tid] = n ? atomicAdd(P.cnt + tid * CNT_STRIDE, n) : 0u; }
        __syncthreads();
        if (tid < 128) { const int ex = (int)lasg[tid * 3], r = (int)(lbase[ex] + lasg[tid * 3 + 1]); const int row = rb * 64 + (tid >> 1);
            P.asg_e[row * 2 + (tid & 1)] = ex; P.asg_r[row * 2 + (tid & 1)] = r; P.capt[(size_t)ex * CAP + r] = row; P.capw[(size_t)ex * CAP + r] = __uint_as_float(lasg[tid * 3 + 2]); }
    }
    __syncthreads();
}
__device__ __forceinline__ void qknorm_rows8(bf16_t* rows, const float* g, int lane) {
    unsigned w[8];
#pragma unroll
    for (int i = 0; i < 8; ++i) w[i] = *((const unsigned*)(rows + (size_t)i * HD) + lane);
    const float g0 = g[2 * lane], g1 = g[2 * lane + 1];
#pragma unroll
    for (int i = 0; i < 8; ++i) { const float a = __uint_as_float(w[i] << 16), b = __uint_as_float(w[i] & 0xffff0000u);
        const float rstd = 1.0f / sqrtf(wave_sum(a * a + b * b) * (1.0f / HD) + RMS_EPS);
        w[i] = pk2(a * rstd * g0, b * rstd * g1); }
#pragma unroll
    for (int i = 0; i < 8; ++i) *((unsigned*)(rows + (size_t)i * HD) + lane) = w[i];
}
__device__ __forceinline__ void gates_scan_seq(int seq, const float* gates, const float* fox_fb, const float* m_ib, const float* m_fb, float* CF, float* BM, float* IP, __attribute__((address_space(3))) float* part) {
    const int h = seq & 7, tid = threadIdx.x; const bool ml = seq >= 8;
    float v[32], ipv[32]; float s = 0.f;
#pragma unroll
    for (int j = 0; j < 32; ++j) { const int t = tid * 32 + j; v[j] = gates[(size_t)t * NGATE + (ml ? 16 : 0) + h]; ipv[j] = ml ? gates[(size_t)t * NGATE + 8 + h] : 0.f; }
    const float fb = ml ? m_fb[h] : fox_fb[h], ib = ml ? m_ib[h] : 0.f;
#pragma unroll
    for (int j = 0; j < 32; ++j) { const float lf = ml ? log_sigmoid(soft_cap(v[j] + fb)) : log_sigmoid(v[j] + fb); s += lf; v[j] = s; }
    if (ml) {
#pragma unroll
        for (int j = 0; j < 32; j += 4) *(f32x4*)(IP + (size_t)h * T + tid * 32 + j) = (f32x4){soft_cap(ipv[j] + ib), soft_cap(ipv[j + 1] + ib), soft_cap(ipv[j + 2] + ib), soft_cap(ipv[j + 3] + ib)}; }
    part[tid] = s; __syncthreads();
    for (int o = 1; o < 512; o <<= 1) { const float a = tid >= o ? part[tid - o] : 0.f; __syncthreads(); part[tid] += a; __syncthreads(); }
    const float base = tid ? part[tid - 1] : 0.f; float* out = (ml ? BM : CF) + (size_t)h * T + tid * 32;
#pragma unroll
    for (int j = 0; j < 32; j += 4) *(f32x4*)(out + j) = (f32x4){base + v[j], base + v[j + 1], base + v[j + 2], base + v[j + 3]};
    __syncthreads();
}
__device__ __forceinline__ void gates_fixup(const float* bt, float* CF, float* BM, int rb, __attribute__((address_space(3))) float* pre) {
    const int tid = threadIdx.x, lane = tid & 63, wave = tid >> 6;
#pragma unroll
    for (int k = 0; k < 2; ++k) { const int seq = 2 * wave + k; float a = 0.f;
#pragma unroll
        for (int j = 0; j < 4; ++j) { const int idx = lane + 64 * j; const float b = bt[seq * (T / 64) + idx]; a += idx < rb ? b : 0.f; }
        a = wave_sum(a); if (lane == 0) pre[seq] = a; }
    __syncthreads();
    { const int seq = tid >> 5, r2 = (tid & 31) * 2; float* p = (seq < 8 ? CF + (size_t)seq * T : BM + (size_t)(seq - 8) * T) + rb * 64 + r2;
      typedef float f2_t __attribute__((ext_vector_type(2))); f2_t v = *(f2_t*)p; const float b = pre[seq]; v.x += b; v.y += b; *(f2_t*)p = v; }
    __syncthreads();
}
template <bool NORM>
__device__ __forceinline__ void combine_rows8(bf16_t* xb, float* xout, const unsigned char* YS, const int* asg_e, const int* asg_r, const __attribute__((address_space(3))) int* tstart, float* rstd_out, int rbase, int lane, int pre = -1) {
    int myrow = pre;
    if (pre < 0) { myrow = 0; if (lane < 16) { const int e = asg_e[rbase * 2 + lane], r = asg_r[rbase * 2 + lane]; myrow = tstart[e] * 256 + r; } }
    const unsigned loff = (unsigned)lane * 16u;
    u32x2 vn[8]; unsigned an[8], bn[8];
#define CMB_LOAD(i_) do { const int ra_ = __builtin_amdgcn_readlane(myrow, 2 * (i_)), rb_ = __builtin_amdgcn_readlane(myrow, 2 * (i_) + 1); \
        const char* xp_ = (const char*)(xb + (size_t)(rbase + (i_)) * D); const char* ap_ = (const char*)(YS + (size_t)ra_ * D); const char* bp_ = (const char*)(YS + (size_t)rb_ * D); \
        _Pragma("unroll") for (int j = 0; j < 8; ++j) { vn[j] = *(const u32x2*)(xp_ + (loff >> 1) + j * 512); an[j] = *(const unsigned*)(ap_ + (loff >> 2) + j * 256); bn[j] = *(const unsigned*)(bp_ + (loff >> 2) + j * 256); } } while (0)
    CMB_LOAD(0);
#pragma unroll
    for (int i = 0; i < 8; ++i) { f32x4 v[8]; float s = 0.f;
#pragma unroll
        for (int j = 0; j < 8; ++j) { f32x4 xx = (f32x4){__uint_as_float(vn[j].x << 16), __uint_as_float(vn[j].x & 0xffff0000u), __uint_as_float(vn[j].y << 16), __uint_as_float(vn[j].y & 0xffff0000u)}; typedef float f2_t __attribute__((ext_vector_type(2)));
            const f2_t a0 = __builtin_amdgcn_cvt_pk_f32_fp8((int)an[j], false), a1 = __builtin_amdgcn_cvt_pk_f32_fp8((int)an[j], true), b0 = __builtin_amdgcn_cvt_pk_f32_fp8((int)bn[j], false), b1 = __builtin_amdgcn_cvt_pk_f32_fp8((int)bn[j], true);
            xx.x += a0.x + b0.x; xx.y += a0.y + b0.y; xx.z += a1.x + b1.x; xx.w += a1.y + b1.y;
            v[j] = xx; s += (xx.x * xx.x + xx.y * xx.y) + (xx.z * xx.z + xx.w * xx.w); }
        if (i < 7) CMB_LOAD(i + 1);
        if (NORM) { char* xo = (char*)(xb + (size_t)(rbase + i) * D);
#pragma unroll
            for (int j = 0; j < 8; ++j) { u32x2 w; w.x = pk2(v[j].x, v[j].y); w.y = pk2(v[j].z, v[j].w); *(u32x2*)(xo + (loff >> 1) + j * 512) = w; }
            const float rstd = 1.0f / sqrtf(wave_sum(s) * (1.0f / D) + RMS_EPS); if (lane == 0) rstd_out[rbase + i] = rstd; }
        else { char* xo = (char*)(xout + (size_t)(rbase + i) * D);
#pragma unroll
            for (int j = 0; j < 8; ++j) *(f32x4*)(xo + loff + j * 1024) = v[j]; } }
#undef CMB_LOAD
}
__device__ __forceinline__ void pool_chunk(const bf16_t* xb, const float* rstd, const float* g, bf16_t* pooled, int t0, __attribute__((address_space(3))) float* rl) {
    const int c = (int)threadIdx.x * 4, w = 2 << (c >> 9);
    if (threadIdx.x < 80) { const int t = t0 - 16 + (int)threadIdx.x; rl[threadIdx.x] = t >= 0 ? rstd[t] : 0.f; }
    const f32x4 g4 = *(const f32x4*)(g + c);
    __syncthreads();
    f32x4 S = {0.f, 0.f, 0.f, 0.f};
#define CV4(q_) ((f32x4){__uint_as_float((q_).x << 16), __uint_as_float((q_).x & 0xffff0000u), __uint_as_float((q_).y << 16), __uint_as_float((q_).y & 0xffff0000u)})
    { u32x2 pre[16];
#pragma unroll
      for (int u = 0; u < 16; ++u) { const int t = t0 - 16 + u; pre[u] = (t >= 0 && u >= 16 - w) ? *(const u32x2*)(xb + (size_t)t * D + c) : (u32x2){0u, 0u}; }
#pragma unroll
      for (int u = 0; u < 16; ++u) S += CV4(pre[u]) * (g4 * rl[u]); }
#pragma unroll 1
    for (int tb = t0; tb < t0 + 64; tb += 8) { u32x2 sv[8], ov[8];
#pragma unroll
        for (int u = 0; u < 8; ++u) { const int t = tb + u; sv[u] = *(const u32x2*)(xb + (size_t)t * D + c); ov[u] = (t - w >= 0) ? *(const u32x2*)(xb + (size_t)(t - w) * D + c) : (u32x2){0u, 0u}; }
        u32x2 out[8];
#pragma unroll
        for (int u = 0; u < 8; ++u) { const int t = tb + u; const f32x4 self = CV4(sv[u]) * (g4 * rl[t - t0 + 16]); S += self; S -= CV4(ov[u]) * (g4 * rl[t - w - t0 + 16]);
            const float inv = 1.0f / (float)(t + 1 < w ? t + 1 : w); const f32x4 p = S * inv - self; out[u].x = pk2(p.x, p.y); out[u].y = pk2(p.z, p.w); }
#pragma unroll
        for (int u = 0; u < 8; ++u) *(u32x2*)(pooled + (size_t)(tb + u) * D + c) = out[u]; }
#undef CV4
    __syncthreads();
}

namespace pg {
#define LAS __attribute__((address_space(3)))
typedef short bf16x8 __attribute__((ext_vector_type(8)));
constexpr int BM = 256, BK = 64, HALF = 128, HTB = HALF * BK * 2, STAGE_BYTES = 8 * HTB, NXCD = 8, WGM = 8;
__host__ __device__ __forceinline__ int lds_byte(int r, int c) { const int st = (r >> 4) * 2 + (c >> 5), rr = r & 15, cc = c & 31, ob = rr * 64 + cc * 2; return st * 1024 + (ob ^ (((ob >> 9) & 1) << 5)); }
__host__ __device__ __forceinline__ void stage_rc(int b, int& R, int& C) { const int st = b / 1024, sb = b % 1024, swz = sb ^ (((sb >> 9) & 1) << 5); R = (st >> 1) * 16 + swz / 64; C = (st & 1) * 32 + (swz % 64) / 2; }
__host__ __device__ __forceinline__ int perm32(int rho) { const int n = rho >> 4, i = rho & 15; return 8 * (i >> 2) + 4 * n + (i & 3); }
__device__ __forceinline__ unsigned cvt_pk_bf16(float lo, float hi) { unsigned r; asm volatile("v_cvt_pk_bf16_f32 %0, %1, %2" : "=v"(r) : "v"(lo), "v"(hi)); return r; }

struct Unit { int pm, pn, ak, half; };
struct Gemm { const bf16_t* A; const bf16_t* Bt; int lda, ldb, K; };
__device__ __forceinline__ int xcd_remap(int L, int nwg) { const int q = nwg / NXCD, r = nwg % NXCD, xcd = L % NXCD, off = L / NXCD; return (xcd < r ? xcd * (q + 1) : r * (q + 1) + (xcd - r) * q) + off; }
struct StaticOrder { static constexpr bool HAS_HALF = false;
    int nM, nN, nwg, G, c, akdiv;
    __device__ void init(int M, int N, int G_, int c_, int akdiv_ = 0) { nM = M / BM; nN = N / BM; nwg = nM * nN; G = G_; c = c_; akdiv = akdiv_; }
    __device__ __forceinline__ bool next(int i, Unit& u) const {
        const int L = i * G + c; if (L >= nwg) return false;
        const int wgid = xcd_remap(L, nwg);
        const int nig = WGM * nN, gid = wgid / nig, fm = gid * WGM, gsz = (nM - fm) < WGM ? (nM - fm) : WGM;
        u.pm = fm + ((wgid % nig) % gsz); u.pn = (wgid % nig) / gsz; u.ak = akdiv ? (u.pn / akdiv) * 512 : 0; u.half = 0; return true;
    }
};
struct MoeOrder {
    static constexpr bool HAS_HALF = true; int nwg, G, c; const LAS int* tileE; const LAS int* tileS;
    __device__ __forceinline__ bool next(int i, Unit& u) const {
        const int L = i * G + c; if (L >= nwg) return false;
        const int rem = nwg - i * G, w = rem < G ? rem : G; const int k = (G & 7) ? L : i * G + (c & 7) * (w >> 3) + (c >> 3);
        const int sl = tileS[k >> 3]; u.pm = sl & 0x7fff; u.half = sl >> 15; u.pn = tileE[u.pm] * 8 + (k & 7); u.ak = 0; return true;
    }
};
template <int SET> struct EpiP7 {
    static constexpr bool PERM = true; bf16_t* P7; const float* gq; const float* gk; LAS float* tab; const float* rstd;
    __device__ __forceinline__ void operator()(const f32x4 (&acc)[2][2][4][2], const Unit& u, int, int wr, int wc, int fr, int fq, const LAS float*) const {
        const int gp = SET ? (u.pn < 4 ? 8 + u.pn : 16 + u.pn) : (u.pn < 8 ? u.pn : u.pn + 4);
        const bool qk = (SET == 0) && u.pn < 8;
        float rr[2][4];
#pragma unroll
        for (int ai = 0; ai < 2; ++ai)
#pragma unroll
            for (int m = 0; m < 4; ++m) rr[ai][m] = rstd[u.pm * BM + ai * HALF + wr * 64 + m * 16 + fr] * (SET ? W8_INV : 1.0f);
        f32x4 g0 = {1.f, 1.f, 1.f, 1.f}, g1 = g0;
        if (qk) {
#pragma unroll
            for (int ai = 0; ai < 2; ++ai)
#pragma unroll
                for (int m = 0; m < 4; ++m)
#pragma unroll
                    for (int bj = 0; bj < 2; ++bj) { const f32x4 v0 = acc[ai][bj][m][0] * rr[ai][m], v1 = acc[ai][bj][m][1] * rr[ai][m];
                        float ss = (v0[0] * v0[0] + v0[1] * v0[1]) + (v0[2] * v0[2] + v0[3] * v0[3]) + (v1[0] * v1[0] + v1[1] * v1[1]) + (v1[2] * v1[2] + v1[3] * v1[3]);
                        ss += __shfl_xor(ss, 16); ss += __shfl_xor(ss, 32);
                        if (fq == 0) tab[((ai * HALF + wr * 64 + m * 16 + fr) * 2 + bj) * 4 + wc] = ss; }
            asm volatile("s_waitcnt lgkmcnt(0)" ::: "memory"); __builtin_amdgcn_s_barrier(); asm volatile("" ::: "memory");
            const float* g = (gp < 4 ? gq : gk) + wc * 32 + 8 * fq; g0 = *(const f32x4*)g; g1 = *(const f32x4*)(g + 4);
            if (gp < 4) { g0 = g0 * (1.4426950408889634f * QK_SCALE); g1 = g1 * (1.4426950408889634f * QK_SCALE); }
        }
#pragma unroll
        for (int ai = 0; ai < 2; ++ai)
#pragma unroll
            for (int m = 0; m < 4; ++m) { const int row = u.pm * BM + ai * HALF + wr * 64 + m * 16 + fr;
#pragma unroll
                for (int bj = 0; bj < 2; ++bj) { f32x4 v0 = acc[ai][bj][m][0] * rr[ai][m], v1 = acc[ai][bj][m][1] * rr[ai][m];
                    if (qk) { const f32x4 p = *(const LAS f32x4*)(tab + ((ai * HALF + wr * 64 + m * 16 + fr) * 2 + bj) * 4);
                        const float r = 1.0f / sqrtf(((p[0] + p[1]) + (p[2] + p[3])) * (1.0f / HD) + RMS_EPS); v0 = v0 * r * g0; v1 = v1 * r * g1; }
                    u32x4 w; w.x = cvt_pk_bf16(v0[0], v0[1]); w.y = cvt_pk_bf16(v0[2], v0[3]); w.z = cvt_pk_bf16(v1[0], v1[1]); w.w = cvt_pk_bf16(v1[2], v1[3]);
                    *(u32x4*)(P7 + ((size_t)(2 * gp + bj) * T + row) * HD + wc * 32 + 8 * fq) = w; } }
    }
};
template <bool RB16, bool OB16> struct EpiRes {
    static constexpr bool PERM = false; const void* res; void* out; int ldc; const float* bias; const float* scale;
    __device__ __forceinline__ void operator()(const f32x4 (&acc)[2][2][4][2], const Unit& u, int, int wr, int wc, int fr, int fq, const LAS float*) const {
        const int col0 = u.pn * BM + wc * 32 + 4 * fq;
        f32x4 bv[2][2], sv[2][2];
#pragma unroll
        for (int bj = 0; bj < 2; ++bj)
#pragma unroll
            for (int n = 0; n < 2; ++n) { bv[bj][n] = bias ? *(const f32x4*)(bias + col0 + bj * HALF + n * 16) : (f32x4){0.f, 0.f, 0.f, 0.f}; sv[bj][n] = scale ? *(const f32x4*)(scale + col0 + bj * HALF + n * 16) : (f32x4){1.f, 1.f, 1.f, 1.f}; }
#pragma unroll
        for (int ai = 0; ai < 2; ++ai) { f32x4 rv[4][2][2]; u32x2 rq[4][2][2];
#pragma unroll
            for (int m = 0; m < 4; ++m) { const size_t off = (size_t)(u.pm * BM + ai * HALF + wr * 64 + m * 16 + fr) * ldc + col0;
#pragma unroll
                for (int bj = 0; bj < 2; ++bj)
#pragma unroll
                    for (int n = 0; n < 2; ++n) { if constexpr (RB16) rq[m][bj][n] = *(const u32x2*)((const bf16_t*)res + off + bj * HALF + n * 16); else rv[m][bj][n] = *(const f32x4*)((const float*)res + off + bj * HALF + n * 16); } }
#pragma unroll
            for (int m = 0; m < 4; ++m) { const size_t off = (size_t)(u.pm * BM + ai * HALF + wr * 64 + m * 16 + fr) * ldc + col0;
#pragma unroll
                for (int bj = 0; bj < 2; ++bj)
#pragma unroll
                    for (int n = 0; n < 2; ++n) { f32x4 r_;
                        if constexpr (RB16) { const u32x2 q_ = rq[m][bj][n]; r_ = (f32x4){__uint_as_float(q_.x << 16), __uint_as_float(q_.x & 0xffff0000u), __uint_as_float(q_.y << 16), __uint_as_float(q_.y & 0xffff0000u)}; } else r_ = rv[m][bj][n];
                        const f32x4 o_ = r_ + (acc[ai][bj][m][n] + bv[bj][n]) * sv[bj][n];
                        if constexpr (OB16) { u32x2 w_; w_.x = cvt_pk_bf16(o_.x, o_.y); w_.y = cvt_pk_bf16(o_.z, o_.w); *(u32x2*)((bf16_t*)out + off + bj * HALF + n * 16) = w_; }
                        else *(f32x4*)((float*)out + off + bj * HALF + n * 16) = o_; } } }
    }
};
struct EpiSilu {
    static constexpr bool PERM = true; unsigned char* Hb;
    __device__ __forceinline__ void operator()(const f32x4 (&acc)[2][2][4][2], const Unit& u, int ui, int wr, int wc, int fr, int fq, const LAS float* roww) const {
        const int col0 = (u.pn & 7) * HALF + wc * 32 + 8 * fq;
#pragma unroll
        for (int ai = 0; ai < 2; ++ai) if (!(ai == 1 && u.half))
#pragma unroll
            for (int m = 0; m < 4; ++m) { const int rl = ai * HALF + wr * 64 + m * 16 + fr; const size_t row = (size_t)u.pm * BM + rl; float h[8];
                const float W8_INV_R = W8_INV * roww[ui * 256 + rl];
#pragma unroll
                for (int n = 0; n < 2; ++n)
#pragma unroll
                    for (int j = 0; j < 4; ++j) { const float a = acc[ai][0][m][n][j] * W8_INV_R, up = acc[ai][1][m][n][j] * W8_INV_R; h[n * 4 + j] = __builtin_amdgcn_fmed3f(a * __builtin_amdgcn_rcpf(1.0f + __expf(-a)) * up, -448.0f, 448.0f); }
                u32x2 w; w.x = pk4_fp8(h[0], h[1], h[2], h[3]); w.y = pk4_fp8(h[4], h[5], h[6], h[7]);
                *(u32x2*)(Hb + row * DEXP + col0) = w; }
    }
};
struct EpiDown {
    static constexpr bool PERM = true; unsigned char* YSb;
    __device__ __forceinline__ void operator()(const f32x4 (&acc)[2][2][4][2], const Unit& u, int ui, int wr, int wc, int fr, int fq, const LAS float* roww) const {
        const int col0 = (u.pn & 7) * BM + wc * 32 + 8 * fq;
#pragma unroll
        for (int ai = 0; ai < 2; ++ai) if (!(ai == 1 && u.half))
#pragma unroll
            for (int m = 0; m < 4; ++m) { const int r = ai * HALF + wr * 64 + m * 16 + fr; const float w8 = roww[ui * 256 + r] * W8_INV; unsigned char* rowp = YSb + ((size_t)u.pm * BM + r) * D + col0;
#pragma unroll
                for (int bj = 0; bj < 2; ++bj) { const f32x4 v0 = acc[ai][bj][m][0] * w8, v1 = acc[ai][bj][m][1] * w8;
                    u32x2 w; w.x = pk4_fp8(v0[0], v0[1], v0[2], v0[3]); w.y = pk4_fp8(v1[0], v1[1], v1[2], v1[3]);
                    *(u32x2*)(rowp + bj * HALF) = w; } }
    }
};

template <class Epi, class Sched, bool GATHER, bool FP8 = false>
__device__ __forceinline__ void gemm_phase(LAS unsigned char* lds, const Gemm g, const Sched& S, const Epi& E, const LAS unsigned* rowoff, const LAS float* roww) {
    const int tid = threadIdx.x, wid = __builtin_amdgcn_readfirstlane(tid >> 6), lane = tid & 63, wr = wid >> 2, wc = wid & 3, fr = lane & 15, fq = lane >> 4;
    const int K = g.K; int nt = K / BK; asm volatile("" : "+s"(nt));
    unsigned voffA[2], voffB[2]; int Rst[2]; unsigned Cst2[2];
#pragma unroll
    for (int i = 0; i < 2; ++i) { int R, C; stage_rc(tid * 16 + i * 8192, R, C); const int Rb = Epi::PERM ? ((R & ~31) + perm32(R & 31)) : R;
        voffA[i] = (unsigned)(R * g.lda + C) * 2u; voffB[i] = (unsigned)(Rb * g.ldb + C) * 2u; Rst[i] = R; Cst2[i] = (unsigned)C * 2u; }
    const size_t kstep = (size_t)(BK * 2);
    const size_t hstepA = (size_t)HALF * g.lda * 2, hstepB = (size_t)HALF * g.ldb * 2, tstepA = 2 * hstepA, tstepB = 2 * hstepB;
    const unsigned ldsw = (unsigned)wid * 1024u;
    const int aoff = lds_byte(wr * 64 + fr, fq * 8), boff = lds_byte(wc * 32 + fr, fq * 8);
#define PG_SA(b, h) (((b) * 2 + (h)) * HTB)
#define PG_SB(b, h) ((4 + (b) * 2 + (h)) * HTB)
#define PG_STAGE_B(bufoff, gbase) do { _Pragma("unroll") for (int _i = 0; _i < 2; ++_i) \
        __builtin_amdgcn_global_load_lds((const unsigned*)((const char*)(gbase) + voffB[_i]), (LAS unsigned*)(lds + (bufoff) + ldsw + _i * 8192), 16, 0, 0); } while (0)
#define PG_STAGE_A(bufoff, gbase, h, OFS) do { _Pragma("unroll") for (int _i = 0; _i < 2; ++_i) \
        __builtin_amdgcn_global_load_lds((const unsigned*)((const char*)(gbase) + (OFS)[h][_i]), (LAS unsigned*)(lds + (bufoff) + ldsw + _i * 8192), 16, 0, 0); } while (0)
#define PG_LDA(dst, b, h) do { _Pragma("unroll") for (int m = 0; m < 4; ++m) { if constexpr (FP8) { dst##8[m].lo = *(const LAS i4_t*)(lds + PG_SA(b, h) + aoff + m * 2048); dst##8[m].hi = *(const LAS i4_t*)(lds + PG_SA(b, h) + aoff + m * 2048 + 1024); } \
        else { _Pragma("unroll") for (int k = 0; k < 2; ++k) dst[m][k] = *(const LAS bf16x8*)(lds + PG_SA(b, h) + aoff + m * 2048 + k * 1024); } } } while (0)
#define PG_LDB(dst, b, h) do { _Pragma("unroll") for (int n = 0; n < 2; ++n) { if constexpr (FP8) { dst##8[n].lo = *(const LAS i4_t*)(lds + PG_SB(b, h) + boff + n * 2048); dst##8[n].hi = *(const LAS i4_t*)(lds + PG_SB(b, h) + boff + n * 2048 + 1024); } \
        else { _Pragma("unroll") for (int k = 0; k < 2; ++k) dst[n][k] = *(const LAS bf16x8*)(lds + PG_SB(b, h) + boff + n * 2048 + k * 1024); } } } while (0)
#define PG_MMA(ai, bj, At, Bt) do { __builtin_amdgcn_s_setprio(1); _Pragma("unroll") for (int m = 0; m < 4; ++m) _Pragma("unroll") for (int n = 0; n < 2; ++n) { \
        if constexpr (FP8) acc[ai][bj][m][n] = __builtin_amdgcn_mfma_scale_f32_16x16x128_f8f6f4(Bt##8[n], At##8[m], acc[ai][bj][m][n], 0, 0, 0, 0x7F7F7F7F, 0, 0x7F7F7F7F); \
        else { _Pragma("unroll") for (int k = 0; k < 2; ++k) acc[ai][bj][m][n] = __builtin_amdgcn_mfma_f32_16x16x32_bf16(Bt[n][k], At[m][k], acc[ai][bj][m][n], 0, 0, 0); } } __builtin_amdgcn_s_setprio(0); } while (0)
#define PG_WAIT_V(n) asm volatile("s_waitcnt vmcnt(" #n ")" ::: "memory")
#define PG_WAIT_L(n) asm volatile("s_waitcnt lgkmcnt(" #n ")" ::: "memory")
#define PG_BAR __builtin_amdgcn_s_barrier()
#define PG_SCHED __builtin_amdgcn_sched_barrier(0)
#define PG_LOAD_OFS(o, slot) do { _Pragma("unroll") for (int _h = 0; _h < 2; ++_h) _Pragma("unroll") for (int _i = 0; _i < 2; ++_i) \
        o[_h][_i] = GATHER ? (rowoff[(slot) * 256 + _h * HALF + Rst[_i]] + Cst2[_i]) : (voffA[_i] + (unsigned)(_h * hstepA)); } while (0)
#define PG_ABASE(u) (GATHER ? (const char*)g.A + (size_t)(u).ak * 2 : (const char*)g.A + (size_t)(u).pm * tstepA + (size_t)(u).ak * 2)
    Unit cur, nxt; int ui = 0;
    if (!S.next(0, cur)) return;
    f32x4 acc[2][2][4][2];
#pragma unroll
    for (int a = 0; a < 2; ++a)
#pragma unroll
        for (int b = 0; b < 2; ++b)
#pragma unroll
            for (int m = 0; m < 4; ++m)
#pragma unroll
                for (int n = 0; n < 2; ++n) acc[a][b][m][n] = (f32x4){0.f, 0.f, 0.f, 0.f};
    typedef int i8_t __attribute__((ext_vector_type(8))); typedef int i4_t __attribute__((ext_vector_type(4)));
    bf16x8 At[4][2], B0[2][2], B1[2][2]; i8_t At8[4], B08[2], B18[2];
    unsigned ofsC[2][2];
    PG_LOAD_OFS(ofsC, 0);
    const char* cA = PG_ABASE(cur); const char* cB = (const char*)g.Bt + (size_t)cur.pn * tstepB;
    PG_STAGE_B(PG_SB(0, 0), cB); PG_STAGE_B(PG_SB(0, 1), cB + hstepB); PG_STAGE_A(PG_SA(0, 0), cA, 0, ofsC); PG_STAGE_A(PG_SA(0, 1), cA, 1, ofsC);
    if (wr == 1) PG_BAR;
    PG_WAIT_V(2); PG_BAR;
    PG_STAGE_B(PG_SB(1, 0), cB + kstep); PG_STAGE_A(PG_SA(1, 0), cA + kstep, 0, ofsC); PG_STAGE_B(PG_SB(1, 1), cB + hstepB + kstep);
    PG_WAIT_V(6); PG_BAR;
    for (;;) {
        const bool has_next = S.next(ui + 1, nxt);
        const bool hf = cur.half != 0;
        const char* nA = has_next ? PG_ABASE(nxt) : cA; const char* nB = has_next ? (const char*)g.Bt + (size_t)nxt.pn * tstepB : cB;
#define PG_KLOOP(HF_) \
        for (int t = 0; t < nt; t += 2) { \
            const bool last = (t == nt - 2); \
            asm volatile("" : "+v"(voffB[0]), "+v"(voffB[1]), "+v"(ofsC[0][0]), "+v"(ofsC[0][1]), "+v"(ofsC[1][0]), "+v"(ofsC[1][1])); \
            const char* a1 = cA + (size_t)(t + 1) * kstep; \
            const char* a2 = last ? nA : cA + (size_t)(t + 2) * kstep; const char* b2 = last ? nB : cB + (size_t)(t + 2) * kstep; \
            const char* a3 = a2 + kstep; const char* b3 = b2 + kstep; \
            PG_LDB(B0, 0, 0); PG_LDB(B1, 0, 1); PG_SCHED; PG_LDA(At, 0, 0); if (!(HF_)) PG_STAGE_A(PG_SA(1, 1), a1, 1, ofsC); \
            if (GATHER && last) PG_LOAD_OFS(ofsC, (has_next ? ui + 1 : ui)); \
            if (HF_) PG_WAIT_V(6); else PG_WAIT_V(8); PG_WAIT_L(0); PG_BAR; PG_MMA(0, 0, At, B0); PG_MMA(0, 1, At, B1); PG_BAR; PG_SCHED; \
            if (!(HF_)) PG_LDA(At, 0, 1); PG_STAGE_B(PG_SB(0, 0), b2); PG_STAGE_B(PG_SB(0, 1), b2 + hstepB); PG_STAGE_A(PG_SA(0, 0), a2, 0, ofsC); \
            if (HF_) PG_WAIT_V(6); else PG_WAIT_V(8); PG_WAIT_L(0); PG_BAR; if (!(HF_)) { PG_MMA(1, 0, At, B0); PG_MMA(1, 1, At, B1); } PG_BAR; PG_SCHED; \
            PG_LDB(B0, 1, 0); PG_LDB(B1, 1, 1); PG_SCHED; PG_LDA(At, 1, 0); if (!(HF_)) PG_STAGE_A(PG_SA(0, 1), a2, 1, ofsC); \
            if (HF_) PG_WAIT_V(6); else PG_WAIT_V(8); PG_WAIT_L(0); PG_BAR; PG_MMA(0, 0, At, B0); PG_MMA(0, 1, At, B1); PG_BAR; PG_SCHED; \
            if (!(HF_)) PG_LDA(At, 1, 1); PG_STAGE_B(PG_SB(1, 0), b3); PG_STAGE_B(PG_SB(1, 1), b3 + hstepB); PG_STAGE_A(PG_SA(1, 0), a3, 0, ofsC); \
            if (HF_) PG_WAIT_V(6); else PG_WAIT_V(8); PG_WAIT_L(0); PG_BAR; if (!(HF_)) { PG_MMA(1, 0, At, B0); PG_MMA(1, 1, At, B1); } PG_BAR; PG_SCHED; \
        }
        if (Sched::HAS_HALF && hf) {
#pragma unroll 1
            PG_KLOOP(1)
        } else {
#pragma unroll 1
            PG_KLOOP(0)
        }
#undef PG_KLOOP
        if (wr == 0) PG_BAR;
        { int t_ = (int)threadIdx.x; asm volatile("" : "+v"(t_)); const int fr_ = t_ & 15, fq_ = (t_ >> 4) & 3;
          E(acc, cur, ui, wr, wc, fr_, fq_, roww); }
        if (!has_next) break;
#pragma unroll
        for (int a = 0; a < 2; ++a)
#pragma unroll
            for (int b = 0; b < 2; ++b)
#pragma unroll
                for (int m = 0; m < 4; ++m)
#pragma unroll
                    for (int n = 0; n < 2; ++n) acc[a][b][m][n] = (f32x4){0.f, 0.f, 0.f, 0.f};
        cur = nxt; cA = nA; cB = nB; ++ui;
        if (wr == 1) PG_BAR;
    }
    PG_WAIT_V(0);
    PG_BAR;
#undef PG_SA
#undef PG_SB
#undef PG_STAGE_A
#undef PG_STAGE_B
#undef PG_LDA
#undef PG_LDB
#undef PG_MMA
#undef PG_WAIT_V
#undef PG_WAIT_L
#undef PG_BAR
#undef PG_SCHED
#undef PG_LOAD_OFS
#undef PG_ABASE
}
}

struct MkArgsFwd { const float* in[21]; float* out; unsigned char* ws; int ph_lo, ph_hi, pad0, pad1; };
namespace at {
constexpr int NTHREADS_C = 512;
typedef short bf16x8 __attribute__((ext_vector_type(8)));
typedef short s16x4 __attribute__((ext_vector_type(4)));
typedef float f32x16 __attribute__((ext_vector_type(16)));
typedef float f32x2v __attribute__((ext_vector_type(2)));
constexpr int NW = 8, QBLK = 32, KVBLK = 64, QB = NW * QBLK, DH = 128;
constexpr int SHM_V = KVBLK * DH * 2, SHM_K = KVBLK * DH * 2;
constexpr int OFF_WS = 2 * SHM_V + 2 * SHM_K, OFF_BIAS = OFF_WS + NW * 64 * 4, BIAS_BYTES = 65536, ATT_LDS = OFF_BIAS + BIAS_BYTES;
constexpr float LOG2E = 1.4426950408889634f, C2 = LOG2E * QK_SCALE, THR2 = 8.f * LOG2E;
#define KSWZ(row, colB) ((row) * 256 + ((colB) ^ (((row) & 7) << 4)))
#define SBAR() __builtin_amdgcn_sched_barrier(0)
__device__ __forceinline__ int v_st(int k, int c) { const int kk = (k & ~0xC) | ((k & 4) << 1) | ((k & 8) >> 1); return ((kk >> 3) * 4 + (c >> 5)) * 512 + ((kk & 7) * 32 + (c & 31)) * 2; }
__device__ __forceinline__ int v_rd_base(int lane) { return ((lane & 3) << 3) | (((lane >> 2) & 3) << 6) | (((lane >> 4) & 1) << 5) | (((lane >> 5) & 1) << 8); }
constexpr int v_rd_off(int d0, int ks, int half) { return d0 * 512 + ks * 4096 + half * 2048; }
__device__ __forceinline__ int crow(int r, int hi) { return (r & 3) + 8 * (r >> 2) + 4 * hi; }
__device__ __forceinline__ unsigned cvtpk(float lo, float hi) { unsigned r; asm volatile("v_cvt_pk_bf16_f32 %0, %1, %2" : "=v"(r) : "v"(lo), "v"(hi)); return r; }
__device__ __forceinline__ bf16x8 load8(const bf16_t* p) { return *reinterpret_cast<const bf16x8*>(p); }
__device__ __forceinline__ void mask_tile(f32x16& p0, f32x16& p1, int dq) {
    const float NEG = -__builtin_inff();
#pragma unroll
    for (int r = 0; r < 16; ++r) { const int c = (r & 3) + 8 * (r >> 2); if (dq - c < 0) p0[r] = NEG; if (dq - c - 32 < 0) p1[r] = NEG; }
}
__device__ __forceinline__ void bias_scale(f32x16& p0, f32x16& p1, const LAS float* bt, int hi) {
#pragma unroll
    for (int g = 0; g < 4; ++g) { const f32x4 b0 = *(const LAS f32x4*)(bt + 8 * g + 4 * hi);
#pragma unroll
        for (int j = 0; j < 4; ++j) p0[4 * g + j] = fmaf(p0[4 * g + j], C2, b0[j]); }
#pragma unroll
    for (int g = 0; g < 4; ++g) { const f32x4 b1 = *(const LAS f32x4*)(bt + 32 + 8 * g + 4 * hi);
#pragma unroll
        for (int j = 0; j < 4; ++j) p1[4 * g + j] = fmaf(p1[4 * g + j], C2, b1[j]); }
}
__device__ __forceinline__ void partialSM(f32x16& p0, f32x16& p1, float& m_reg, float& mn, float& alpha) {
    float pmax = p0[0]; for (int r = 1; r < 16; ++r) pmax = fmaxf(pmax, p0[r]); for (int r = 0; r < 16; ++r) pmax = fmaxf(pmax, p1[r]);
    { auto rr = __builtin_amdgcn_permlane32_swap(__float_as_uint(pmax), __float_as_uint(pmax), false, false); pmax = fmaxf(__uint_as_float(rr[0]), __uint_as_float(rr[1])); }
    if (__builtin_expect(__all((pmax - m_reg) <= THR2), 1)) { mn = m_reg; alpha = 1.f; }
    else { mn = fmaxf(m_reg, pmax); alpha = __builtin_amdgcn_exp2f(m_reg - mn); m_reg = mn; }
    for (int r = 0; r < 16; ++r) p0[r] = p0[r] - mn; for (int r = 0; r < 16; ++r) p1[r] = p1[r] - mn;
    for (int r = 0; r < 16; ++r) p0[r] = __builtin_amdgcn_exp2f(p0[r]);
}
__device__ __forceinline__ void finishSM(f32x16& p0, f32x16& p1, float alpha, float& l_reg, bf16x8& pa0, bf16x8& pa1, bf16x8& pa2, bf16x8& pa3) {
    for (int r = 0; r < 16; ++r) p1[r] = __builtin_amdgcn_exp2f(p1[r]);
    float ps = 0; for (int r = 0; r < 16; ++r) ps += p0[r]; for (int r = 0; r < 16; ++r) ps += p1[r];
    { auto rr = __builtin_amdgcn_permlane32_swap(__float_as_uint(ps), __float_as_uint(ps), false, false); ps = __uint_as_float(rr[0]) + __uint_as_float(rr[1]); }
    l_reg = l_reg * alpha + ps;
#define PK4(P, B_, OUT) do { unsigned a0 = cvtpk(P[B_+0], P[B_+1]), a1 = cvtpk(P[B_+2], P[B_+3]);                          \
        unsigned b0 = cvtpk(P[B_+4], P[B_+5]), b1 = cvtpk(P[B_+6], P[B_+7]);                                             \
        auto r0 = __builtin_amdgcn_permlane32_swap(a0, b0, false, false); auto r1 = __builtin_amdgcn_permlane32_swap(a1, b1, false, false); \
        u32x4 w = {r0[0], r1[0], r0[1], r1[1]}; OUT = *reinterpret_cast<bf16x8*>(&w); } while (0)
    PK4(p0, 0, pa0); PK4(p0, 8, pa1); PK4(p1, 0, pa2); PK4(p1, 8, pa3);
#undef PK4
}
template <int KB>
__device__ __forceinline__ void qkt(f32x16& p0, f32x16& p1, const char* K_lds, int r32, int hi, const bf16x8* qr, const LAS float* bt = nullptr) {
    if (bt) {
#pragma unroll
        for (int g = 0; g < 4; ++g) { const f32x4 b0 = *(const LAS f32x4*)(bt + 8 * g), b1 = *(const LAS f32x4*)(bt + 32 + 8 * g);
#pragma unroll
            for (int j = 0; j < 4; ++j) { p0[4 * g + j] = b0[j]; p1[4 * g + j] = b1[j]; } }
    } else { p0 = f32x16{}; p1 = f32x16{}; }
    const char* kb[4];
#pragma unroll
    for (int dd = 0; dd < 4; ++dd) kb[dd] = K_lds + KB * SHM_K + KSWZ(r32, (dd * 16 + hi * 8) * 2);
#pragma unroll
    for (int d0 = 0; d0 < 8; ++d0) { const char* a = kb[d0 & 3] + (d0 >> 2) * 128;
        bf16x8 b0 = *reinterpret_cast<const bf16x8*>(a);
        bf16x8 b1 = *reinterpret_cast<const bf16x8*>(a + 32 * 256);
        p0 = __builtin_amdgcn_mfma_f32_32x32x16_bf16(b0, qr[d0], p0, 0, 0, 0);
        p1 = __builtin_amdgcn_mfma_f32_32x32x16_bf16(b1, qr[d0], p1, 0, 0, 0); }
}
template <int VB>
__device__ __forceinline__ void pv_tile(f32x16* o, int vb0, bf16x8 pa0, bf16x8 pa1, bf16x8 pa2, bf16x8 pa3) {
#define TRRD(dst, off) asm volatile("ds_read_b64_tr_b16 %0, %1 offset:%2" : "=&v"(dst) : "v"(vb0), "i"(off) : "memory")
#define PV_D0(d0) do { s16x4 l0, l1, l2, l3, h0, h1, h2, h3; constexpr int b_ = VB * SHM_V + v_rd_off(d0, 0, 0); \
        TRRD(l0, b_); TRRD(h0, b_ + 2048); TRRD(l1, b_ + 4096); TRRD(h1, b_ + 6144); TRRD(l2, b_ + 8192); TRRD(h2, b_ + 10240); TRRD(l3, b_ + 12288); TRRD(h3, b_ + 14336); \
        asm volatile("s_waitcnt lgkmcnt(0)" ::: "memory"); SBAR();   \
        o[d0] = __builtin_amdgcn_mfma_f32_32x32x16_bf16(pa0, (bf16x8){l0[0], l0[1], l0[2], l0[3], h0[0], h0[1], h0[2], h0[3]}, o[d0], 0, 0, 0);   \
        o[d0] = __builtin_amdgcn_mfma_f32_32x32x16_bf16(pa1, (bf16x8){l1[0], l1[1], l1[2], l1[3], h1[0], h1[1], h1[2], h1[3]}, o[d0], 0, 0, 0);   \
        o[d0] = __builtin_amdgcn_mfma_f32_32x32x16_bf16(pa2, (bf16x8){l2[0], l2[1], l2[2], l2[3], h2[0], h2[1], h2[2], h2[3]}, o[d0], 0, 0, 0);   \
        o[d0] = __builtin_amdgcn_mfma_f32_32x32x16_bf16(pa3, (bf16x8){l3[0], l3[1], l3[2], l3[3], h3[0], h3[1], h3[2], h3[3]}, o[d0], 0, 0, 0); } while (0)
    PV_D0(0); PV_D0(1); PV_D0(2); PV_D0(3);
#undef PV_D0
#undef TRRD
}
struct BlockRef { int h, qb, jlo, jhi, part; };
struct AttnPtrs { unsigned char* ws; };
#define AP_P7(p) ((const bf16_t*)((p).ws + WS_P7))
#define BR_Q(p, r) (AP_P7(p) + ((size_t)(r).h * T + (size_t)(r).qb * QB) * DH)
#define BR_K(p, r) (AP_P7(p) + (size_t)(8 + (r).h) * T * DH)
#define BR_V(p, r) (AP_P7(p) + (size_t)(16 + (r).h) * T * DH)
#define BR_O(p, r) ((bf16_t*)((p).ws + WS_Y) + (size_t)(r).qb * QB * D + (r).h * DH)
#define BR_CB(p, r) ((const float*)((p).ws + WS_CF) + (size_t)(r).h * T)
struct Seam { bf16x8 qr[8]; bf16x8 st_v0, st_v1, st_k0, st_k1; };
#define LDG8(ubase, voff) (*(const bf16x8*)((const char*)(ubase) + (voff)))
#define VMW() asm volatile("s_waitcnt vmcnt(0)" ::: "memory")
#define VMWN(n) asm volatile("s_waitcnt vmcnt(%0)" :: "i"(n) : "memory")
#define SLOAD_H(Kp, Vp, k0) do { const bf16_t* vb_ = (Vp) + (size_t)(k0) * DH; const bf16_t* kb_ = (Kp) + (size_t)(k0) * DH; \
        S.st_v0 = LDG8(vb_, stoff); S.st_v1 = LDG8(vb_, stoff + 32 * DH * 2); S.st_k0 = LDG8(kb_, stoff); S.st_k1 = LDG8(kb_, stoff + 32 * DH * 2); } while (0)
#define SWRITE_HK(bf) do { *(bf16x8*)(K_lds + (bf) * SHM_K + kws) = S.st_k0; *(bf16x8*)(K_lds + (bf) * SHM_K + kws + 32 * 256) = S.st_k1; } while (0)
#define SWRITE_HV(bf) do { *(bf16x8*)(V_lds + (bf) * SHM_V + vst0) = S.st_v0; *(bf16x8*)(V_lds + (bf) * SHM_V + vst1) = S.st_v1; } while (0)
#define SWRITE_H(bf) do { SWRITE_HV(bf); SWRITE_HK(bf); } while (0)
__device__ __forceinline__ void attn_prime(const AttnPtrs& pp, const BlockRef& cur, char* lds, Seam& S) {
    const int tid = threadIdx.x, wid = __builtin_amdgcn_readfirstlane(tid >> 6), lane = tid & 63, r32 = lane & 31, hi = lane >> 5;
    const int sr = tid >> 4, sc = (tid & 15) * 8, kws = KSWZ(sr, sc * 2); char* K_lds = lds + 2 * SHM_V;
    const unsigned stoff = (unsigned)(sr * DH + sc) * 2u, qoff = (unsigned)(r32 * DH + hi * 8) * 2u;
    const int kb0 = cur.jlo * KVBLK;
    { const bf16_t* qb_ = BR_Q(pp, cur) + (size_t)(wid * QBLK) * DH;
#pragma unroll
      for (int d0 = 0; d0 < 8; ++d0) S.qr[d0] = LDG8(qb_, qoff + d0 * 32); }
    SLOAD_H(BR_K(pp, cur), BR_V(pp, cur), kb0); VMW(); SWRITE_HK(0);
    __syncthreads();
}
__device__ __forceinline__ void attn_block(const AttnPtrs& pp, const BlockRef& cur, const BlockRef& nxt, int ldo, char* lds, Seam& S) {
    const int tid = threadIdx.x, wid = __builtin_amdgcn_readfirstlane(tid >> 6), lane = tid & 63, r32 = lane & 31, hi = lane >> 5;
    const int P0 = cur.qb * QB; const int j_lo = cur.jlo, j_hi = cur.jhi;
    const int NT = j_hi - j_lo;
    const int kbn = nxt.jlo * KVBLK;
    const int qlo = P0 + wid * QBLK, qm = qlo + r32 - 4 * hi;
    char* V_lds = lds; char* K_lds = lds + 2 * SHM_V;
    float* ws = (float*)(lds + OFF_WS) + wid * 64; float* li_l = ws, * al_l = ws + 32;
    float* bias_l = (float*)(lds + OFF_BIAS); const LAS float* btp = (const LAS float*)bias_l + 4 * hi;
    { const float* cb_ = BR_CB(pp, cur); const float cref = cb_[P0]; const int nk = (j_hi - j_lo) * KVBLK; const float* csrc = cb_ + j_lo * KVBLK;
      const LAS float* bl_ = (const LAS float*)bias_l;
      unsigned i0_ = (unsigned)tid * 16u; asm volatile("" : "+v"(i0_));
#pragma unroll 1
      for (unsigned i = i0_; i < (unsigned)nk * 4u; i += 512u * 16u) { const f32x4 c4 = *(const f32x4*)((const char*)csrc + i); *(LAS f32x4*)((LAS char*)bl_ + i) = (cref - c4) * LOG2E; } }
    float m_reg = -1e30f, l_reg = 0; f32x16 o[4] = {};
#define TIDQ() ({ int t_ = (int)threadIdx.x; asm volatile("" : "+v"(t_)); t_; })
#define stoff ((unsigned)TIDQ() * 16u)
#define vst0 ({ const int t_ = TIDQ(); v_st(t_ >> 4, (t_ & 15) * 8); })
#define vst1 (vst0 + 8192)
#define kws ({ const int t_ = TIDQ(); KSWZ(t_ >> 4, (t_ & 15) * 16); })
#define qoff ({ const int t_ = TIDQ(); (unsigned)(((t_ & 31) * DH + ((t_ >> 5) & 1) * 8) * 2); })
    const int vb0 = (int)(uintptr_t)V_lds + v_rd_base(lane);
    const bf16_t* Kh = BR_K(pp, cur); const bf16_t* Vh = BR_V(pp, cur);
#define RESC(a) do { if (__any((a) < 1.f)) { if (hi == 0) al_l[r32] = (a); asm volatile("s_waitcnt lgkmcnt(0)" ::: "memory");              \
                     for (int d_ = 0; d_ < 4; ++d_) for (int r = 0; r < 16; ++r) o[d_][r] *= al_l[crow(r, hi)]; } } while (0)
#define KBASE(t) ((j_lo + (t)) * KVBLK)
#define MASKT(P0_, P1_, t) do { const int kb_ = KBASE(t); if (kb_ + KVBLK - 1 > qlo) mask_tile(P0_, P1_, qm - kb_); } while (0)
#define QKTB(KB_, P0_, P1_) do { qkt<KB_>(P0_, P1_, K_lds, r32, hi, S.qr, btp); btp += KVBLK; asm volatile("" : "+v"(btp)); } while (0)
    constexpr int NQL = 8;
#define SEAM_K0() do { VMWN(NQL); SWRITE_HK(0); SBAR(); } while (0)
    f32x16 pA0, pA1, pB0, pB1; float mnA, mnB, alA, alB; bf16x8 pa0, pa1, pa2, pa3;
    SWRITE_HV(0); SBAR();
    if (NT > 1) SLOAD_H(Kh, Vh, KBASE(1));
    __syncthreads();
    SBAR(); QKTB(0, pA0, pA1);
    MASKT(pA0, pA1, 0); partialSM(pA0, pA1, m_reg, mnA, alA);
    if (NT > 1) { VMW(); SWRITE_H(1); }
    __syncthreads();
#define HALF_STEP(PX0, PX1, mnX, alX, PY0, PY1, alY, t, KB, VB, SB) do {                                                      \
        SBAR(); QKTB(KB, PX0, PX1);                                             \
        finishSM(PY0, PY1, alY, l_reg, pa0, pa1, pa2, pa3); SBAR();                                                           \
        if ((t) + 1 < NT) { SLOAD_H(Kh, Vh, KBASE((t) + 1)); SBAR(); }                                               \
        pv_tile<VB>(o, vb0, pa0, pa1, pa2, pa3); MASKT(PX0, PX1, (t)); partialSM(PX0, PX1, m_reg, mnX, alX);                                        \
        __syncthreads();                                                                                                      \
        if ((t) + 1 < NT) { VMW(); SWRITE_H(SB); }                                                                          \
        RESC(alX); __syncthreads(); } while (0)
    for (int t = 1; t + 1 < NT; t += 2) {
        HALF_STEP(pB0, pB1, mnB, alB, pA0, pA1, alA, t, 1, 0, 0);
        HALF_STEP(pA0, pA1, mnA, alA, pB0, pB1, alB, t + 1, 0, 1, 1);
    }
    const bool even = (NT & 1) == 0;
    if (even) { SBAR(); QKTB(1, pB0, pB1); SBAR(); }
    { SLOAD_H(BR_K(pp, nxt), BR_V(pp, nxt), kbn); SBAR();
      const bf16_t* qb_ = BR_Q(pp, nxt) + (size_t)(wid * QBLK) * DH;
#pragma unroll
        for (int d0 = 0; d0 < 8; ++d0) S.qr[d0] = LDG8(qb_, qoff + d0 * 32); }
    SBAR();
    finishSM(pA0, pA1, alA, l_reg, pa0, pa1, pa2, pa3); SBAR();
    pv_tile<0>(o, vb0, pa0, pa1, pa2, pa3);
    if (even) { MASKT(pB0, pB1, NT - 1); partialSM(pB0, pB1, m_reg, mnB, alB); __syncthreads(); RESC(alB);
        finishSM(pB0, pB1, alB, l_reg, pa0, pa1, pa2, pa3); SBAR(); pv_tile<1>(o, vb0, pa0, pa1, pa2, pa3); }
    SBAR(); SEAM_K0();
    if (cur.part == 0) {
    if (hi == 0) li_l[r32] = l_reg; asm volatile("s_waitcnt lgkmcnt(0)" ::: "memory");
    float rli[16];
#pragma unroll
    for (int r = 0; r < 16; ++r) rli[r] = __builtin_amdgcn_rcpf(li_l[crow(r, hi)]);
    bf16_t* Ow = BR_O(pp, cur) + (size_t)(wid * QBLK) * ldo; const unsigned ooff = (unsigned)(4 * hi * ldo + r32) * 2u;
#pragma unroll
    for (int r = 0; r < 16; ++r) { const int orow0 = (r & 3) + 8 * (r >> 2);
#pragma unroll
        for (int d0 = 0; d0 < 4; ++d0) { const float v = o[d0][r] * rli[r]; const float vn = __shfl_xor(v, 1);
            if ((r32 & 1) == 0) *(unsigned*)((char*)(Ow + (size_t)orow0 * ldo + d0 * 32) + ooff) = cvtpk(v, vn); } }
    } else {
        const size_t sidx = (size_t)(cur.part - 1);
        unsigned poff = (unsigned)(4 * hi * DH + r32) * 4u, mlo = (unsigned)r32 * 4u; asm volatile("" : "+v"(poff), "+v"(mlo));
        float* Pw = (float*)(pp.ws + WS_PO) + (sidx * QB + (size_t)(wid * QBLK)) * DH;
#pragma unroll
        for (int r = 0; r < 16; ++r) { const int orow0 = (r & 3) + 8 * (r >> 2);
#pragma unroll
            for (int d0 = 0; d0 < 4; ++d0) *(float*)((char*)(Pw + (size_t)orow0 * DH + d0 * 32) + poff) = o[d0][r]; }
        if (hi == 0) { *(float*)((char*)((float*)(pp.ws + WS_PM) + sidx * QB + wid * QBLK) + mlo) = m_reg; *(float*)((char*)((float*)(pp.ws + WS_PL) + sidx * QB + wid * QBLK) + mlo) = l_reg; }
    }
    __syncthreads();
#undef TIDQ
#undef stoff
#undef vst0
#undef vst1
#undef kws
#undef qoff
#undef RESC
#undef KBASE
#undef MASKT
#undef QKTB
#undef SEAM_K0
#undef HALF_STEP
}
#undef LDG8
#undef VMW
#undef VMWN
#undef SLOAD_H
#undef SWRITE_HK
#undef SWRITE_HV
#undef SWRITE_H
__device__ __forceinline__ void attn_plan(char* lds, const float* BT, const float* gq, const float* gk, unsigned* ORD, unsigned* ORD2, unsigned* COMB) {
    unsigned* keys = (unsigned*)lds; unsigned* jl = keys + 512; float* pf = (float*)(keys + 2048); float* red = pf + 2048;
    const int tid = threadIdx.x, h = tid >> 6, qb = tid & 63;
    { float m = tid < 128 ? fabsf(gq[tid]) : (tid < 256 ? fabsf(gk[tid - 128]) : 0.f);
#pragma unroll
      for (int o = 32; o > 0; o >>= 1) m = fmaxf(m, __shfl_xor(m, o));
      if (qb == 0) red[h] = m;
      const f32x4 b = *(const f32x4*)(BT + h * (T / 64) + 4 * qb); const float s0 = b.x, s1 = s0 + b.y, s2 = s1 + b.z, s3 = s2 + b.w; float inc = s3;
#pragma unroll
      for (int o = 1; o < 64; o <<= 1) { const float t = __shfl_up(inc, o); inc += qb >= o ? t : 0.f; }
      const float ex = inc - s3; *(f32x4*)(pf + h * 256 + 4 * qb) = (f32x4){ex + s0, ex + s1, ex + s2, ex + s3}; }
    __syncthreads();
    const float mq = fmaxf(red[0], red[1]), mk = fmaxf(red[2], red[3]);
    const float thr = -(104.0f + 2.0f * 11.3137085f * mq * mk * 1.02f);
    const float* cf = pf + h * 256; const float cP = qb ? cf[4 * qb - 1] : 0.f;
    int lo = 0, hi = 4 * qb;
    while (lo < hi) { const int mid = (lo + hi) >> 1; if (cP - cf[mid] >= thr) hi = mid; else lo = mid + 1; }
    jl[tid] = (unsigned)lo; keys[tid] = ((unsigned)(4 * (qb + 1) - lo) << 16) | (unsigned)tid;
    for (int k = 2; k <= 512; k <<= 1)
        for (int j = k >> 1; j > 0; j >>= 1) { __syncthreads(); const int ixj = tid ^ j;
            if (ixj > tid) { const unsigned a = keys[tid], b = keys[ixj]; const bool desc = (tid & k) == 0; if (desc ? (a < b) : (a > b)) { keys[tid] = b; keys[ixj] = a; } } }
    __syncthreads();
    unsigned* pre = jl + 512;
    const unsigned key = keys[tid], idx = key & 0xffffu, cost = key >> 16, nch0 = (cost + AQ_CHK - 1) / AQ_CHK, nch = nch0 < 4u ? nch0 : 4u;
    pre[tid] = nch; __syncthreads();
    for (int o = 1; o < 512; o <<= 1) { const unsigned a = tid >= o ? pre[tid - o] : 0u; __syncthreads(); pre[tid] += a; __syncthreads(); }
    const unsigned base = pre[tid] - nch, total = pre[511];
    { const unsigned hh = idx >> 6, qq = idx & 63u, j0 = jl[idx], jh = 4u * (qq + 1u), len = (cost + nch - 1) / nch;
      for (unsigned k = 0; k < nch; ++k) { const unsigned ja = j0 + k * len, jb = (ja + len < jh) ? ja + len : jh, sidx = base + k;
          ORD2[1 + 2 * sidx] = hh | (qq << 8) | (ja << 16); ORD2[2 + 2 * sidx] = jb | ((nch > 1 ? sidx + 1u : 0u) << 12); }
      COMB[tid] = base | (nch << 16) | (hh << 20) | (qq << 24); }
    if (tid == 0) ORD2[0] = total;
    (void)ORD;
    __syncthreads();
}
constexpr int OFF_Q = 140000;
__device__ __forceinline__ void aq_decode(const unsigned* ORD2, unsigned n, BlockRef& b) {
    const unsigned w0 = ORD2[1 + 2 * n], w1 = ORD2[2 + 2 * n];
    b.h = (int)(w0 & 0xffu); b.qb = (int)((w0 >> 8) & 0xffu); b.jlo = (int)(w0 >> 16); b.jhi = (int)(w1 & 0xfffu); b.part = (int)(w1 >> 12);
}
constexpr int AQ_CONV_PER = 8, AQ_NCONV = BI_TOTAL / AQ_CONV_PER;
static_assert(BI_TOTAL % AQ_CONV_PER == 0, "copy work-items");
__device__ __forceinline__ void attn_phase(char* lds, unsigned char* ws, const unsigned* ORD2, unsigned* qctr, __attribute__((address_space(3))) unsigned char* ldsl) {
    unsigned* qw = (unsigned*)(lds + OFF_Q);
    const int tid = threadIdx.x;
    int par = 0;
#define AQ_FETCH() ({ if (tid == 0) { qw[par] = atomicAdd(qctr, 1u); qw[2] = ORD2[0]; } __syncthreads(); const unsigned v_ = qw[par]; par ^= 1; v_; })
    unsigned n = AQ_FETCH();
    const unsigned nsub = qw[2], nq = nsub + AQ_NCONV;
#define AQ_CNUM(p) ((unsigned)(((unsigned long long)(p) * (unsigned)AQ_NCONV) / nq))
#define AQ_ISCONV(p) (AQ_CNUM((p) + 1u) > AQ_CNUM(p))
    AttnPtrs pp; pp.ws = ws;
    while (n < nq) {
        if (AQ_ISCONV(n)) {
            const int c = (int)AQ_CNUM(n);
            { const auto A = (const __attribute__((address_space(4))) MkArgsFwd*)__builtin_amdgcn_kernarg_segment_ptr();
              PrepArgs pa; pa.w_in = nullptr; pa.w_out = nullptr; pa.pool_w = nullptr; pa.rgw = nullptr; pa.rew = nullptr; pa.w_gate = A->in[18]; pa.w_up = A->in[19]; pa.w_down = A->in[20]; pa.ws = ws;
              prep_block8(pa, ldsl, c * AQ_CONV_PER, 1, (c + 1) * AQ_CONV_PER); }
            n = AQ_FETCH();
            continue;
        }
        BlockRef cur; aq_decode(ORD2, n - AQ_CNUM(n), cur);
        Seam S;
        attn_prime(pp, cur, lds, S);
        for (;;) {
            n = AQ_FETCH();
            const bool chain = n < nq && !AQ_ISCONV(n);
            BlockRef nxt = cur; if (chain) aq_decode(ORD2, n - AQ_CNUM(n), nxt);
            attn_block(pp, cur, nxt, D, lds, S);
            if (!chain) break;
            cur = nxt;
        }
    }
#undef AQ_FETCH
#undef AQ_CNUM
#undef AQ_ISCONV
}
__device__ __forceinline__ void attn_combine(const unsigned* COMB, const float* PO, const float* PM, const float* PL, bf16_t* Y, int gw, int ngw, int lane) {
#pragma unroll 1
    for (int u = gw; u < 512 * 32; u += ngw) {
        const unsigned cw = COMB[u >> 5]; const unsigned nch = (cw >> 16) & 0xfu; if (nch <= 1u) continue;
        const unsigned base = cw & 0xffffu, hh = (cw >> 20) & 0xfu, qq = cw >> 24;
#pragma unroll 1
        for (int rr = 0; rr < 8; ++rr) { const int row = (u & 31) * 8 + rr;
            float m[4], l[4]; f32x2v ov[4]; float M = -3.0e38f;
#pragma unroll
            for (unsigned k = 0; k < 4; ++k) { const bool on = k < nch; const size_t si = (size_t)(base + (on ? k : 0u)) * QB + row;
                m[k] = on ? PM[si] : -3.0e38f; l[k] = on ? PL[si] : 0.f; ov[k] = *(const f32x2v*)(PO + si * DH + 2 * lane); M = fmaxf(M, m[k]); }
            float L = 0.f; f32x2v O = {0.f, 0.f};
#pragma unroll
            for (unsigned k = 0; k < 4; ++k) { const float f = (k < nch) ? __builtin_amdgcn_exp2f(m[k] - M) : 0.f; L += l[k] * f; O += ov[k] * f; }
            const float r = 1.0f / L;
            *(unsigned*)(Y + ((size_t)qq * QB + row) * D + hh * DH + 2 * lane) = cvtpk(O.x * r, O.y * r); }
    }
}
constexpr int MCH = 256, NCH = T / MCH;
#define TRRDB(dst, base, off) asm volatile("ds_read_b64_tr_b16 %0, %1 offset:%2" : "=&v"(dst) : "v"(base), "i"(off) : "memory")
#define FRAG8(l, h) (bf16x8){l[0], l[1], l[2], l[3], h[0], h[1], h[2], h[3]}
__device__ __forceinline__ bf16x8 scale8(bf16x8 v, float w) {
    u32x4 u = *reinterpret_cast<u32x4*>(&v); u32x4 o;
#pragma unroll
    for (int j = 0; j < 4; ++j) o[j] = cvtpk(__uint_as_float(u[j] << 16) * w, __uint_as_float(u[j] & 0xffff0000u) * w);
    return *reinterpret_cast<bf16x8*>(&o);
}
__device__ __forceinline__ void mlstm_c1_unit(char* lds, const bf16_t* P7, const float* BM, const float* IP, float* DC, float* NDp, int h, int c) {
    const int tid = threadIdx.x, wid = __builtin_amdgcn_readfirstlane(tid >> 6), lane = tid & 63, r32 = lane & 31, hi = lane >> 5;
    const int sr = tid >> 4, sc = (tid & 15) * 8, vst0 = v_st(sr, sc), vst1 = vst0 + 8192;
    const unsigned stoff = (unsigned)(sr * DH + sc) * 2u;
    char* V_lds = lds; char* K_lds = lds + 2 * SHM_V;
    const bf16_t* Kh = P7 + (size_t)(32 + h) * T * DH; const bf16_t* Vh = P7 + (size_t)(40 + h) * T * DH;
    const float* bm = BM + (size_t)h * T; const float* ip = IP + (size_t)h * T;
    const int t0 = c * MCH; const float bmend = bm[t0 + MCH - 1];
    const int db = wid & 3, vg = wid >> 2;
    const int kbase = (int)(uintptr_t)K_lds + v_rd_base(lane) + db * 512, vbase = (int)(uintptr_t)V_lds + v_rd_base(lane) + vg * 1024;
    f32x16 acc0 = {}, acc1 = {}, accn = {};
    const bf16x8 ones = (bf16x8){0x3F80, 0x3F80, 0x3F80, 0x3F80, 0x3F80, 0x3F80, 0x3F80, 0x3F80};
    bf16x8 nv0, nv1, nk0, nk1; float nb0, ni0, nb1, ni1;
#define C1_LOAD(j_) do { const int k0_ = t0 + (j_) * KVBLK; const char* vb_ = (const char*)(Vh + (size_t)k0_ * DH); const char* kb_ = (const char*)(Kh + (size_t)k0_ * DH); \
        nv0 = *(const bf16x8*)(vb_ + stoff); nv1 = *(const bf16x8*)(vb_ + stoff + 32 * DH * 2); nk0 = *(const bf16x8*)(kb_ + stoff); nk1 = *(const bf16x8*)(kb_ + stoff + 32 * DH * 2); \
        nb0 = bm[k0_ + sr]; ni0 = ip[k0_ + sr]; nb1 = bm[k0_ + 32 + sr]; ni1 = ip[k0_ + 32 + sr]; } while (0)
    C1_LOAD(0);
    for (int j = 0; j < 4; ++j) {
        const bf16x8 v0 = nv0, v1 = nv1;
        const float w0 = __expf(bmend - nb0 + ni0) * QK_SCALE, w1 = __expf(bmend - nb1 + ni1) * QK_SCALE;
        const bf16x8 kk0 = scale8(nk0, w0), kk1 = scale8(nk1, w1);
        __syncthreads();
        *(bf16x8*)(V_lds + vst0) = v0; *(bf16x8*)(V_lds + vst1) = v1; *(bf16x8*)(K_lds + vst0) = kk0; *(bf16x8*)(K_lds + vst1) = kk1;
        __syncthreads();
        { const int jn = j < 3 ? j + 1 : 3; C1_LOAD(jn); }
#define C1_KS(ks) do { s16x4 kl, kh, al, ah, bl, bh; TRRDB(kl, kbase, (ks) * 4096); TRRDB(kh, kbase, (ks) * 4096 + 2048); \
            TRRDB(al, vbase, (ks) * 4096); TRRDB(ah, vbase, (ks) * 4096 + 2048); TRRDB(bl, vbase, 512 + (ks) * 4096); TRRDB(bh, vbase, 512 + (ks) * 4096 + 2048); \
            asm volatile("s_waitcnt lgkmcnt(0)" ::: "memory"); SBAR(); \
            const bf16x8 kf = FRAG8(kl, kh); acc0 = __builtin_amdgcn_mfma_f32_32x32x16_bf16(kf, FRAG8(al, ah), acc0, 0, 0, 0); acc1 = __builtin_amdgcn_mfma_f32_32x32x16_bf16(kf, FRAG8(bl, bh), acc1, 0, 0, 0); \
            if (vg == 0) accn = __builtin_amdgcn_mfma_f32_32x32x16_bf16(kf, ones, accn, 0, 0, 0); } while (0)
        C1_KS(0); C1_KS(1); C1_KS(2); C1_KS(3);
#undef C1_KS
    }
#undef C1_LOAD
    float* Dp = DC + ((size_t)(h * NCH + c) * HD + db * 32) * HD + vg * 64 + r32;
#pragma unroll
    for (int r = 0; r < 16; ++r) { const int drow = crow(r, hi); Dp[(size_t)drow * HD] = acc0[r]; Dp[(size_t)drow * HD + 32] = acc1[r]; }
    if (vg == 0 && r32 == 0) { float* np = NDp + (size_t)(h * NCH + c) * HD + db * 32;
#pragma unroll
        for (int r = 0; r < 16; ++r) np[crow(r, hi)] = accn[r]; }
    __syncthreads();
}
__device__ __forceinline__ void mlstm_c2(char* lds, const float* BM, const float* DC, const float* NDp, bf16_t* CST, float* NST, int G, int bx) {
    float* aL = (float*)lds;
    { const int h = threadIdx.x >> 6, c = threadIdx.x & 63; const float* bm = BM + (size_t)h * T; aL[threadIdx.x] = __expf(bm[c * MCH + MCH - 1] - (c ? bm[c * MCH - 1] : 0.f)); }
    __syncthreads();
    for (int eb = bx; eb < NH * HD * HD / NTHREADS_C; eb += G) {
        int tid = threadIdx.x; asm volatile("" : "+v"(tid));
        const int e = eb * NTHREADS_C + tid, h = e >> 14, i = e & 16383, n = eb * 4 + (tid & 3), jn = n & 127;
        const float* dp = DC + (size_t)h * NCH * HD * HD + i; const float* np = NDp + (size_t)h * NCH * HD + jn;
        bf16_t* cs = CST + (size_t)h * NCH * HD * HD + i; float* ns = NST + (size_t)h * NCH * HD + jn;
        float C = 0.f, N = 0.f; float dv[16], nv[16], dn[16], nn[16];
#define C2_LOAD(dd, nd, c0_) do { _Pragma("unroll") for (int j = 0; j < 16; ++j) { const int c_ = ((c0_) + j) < NCH - 1 ? ((c0_) + j) : NCH - 2; dd[j] = dp[(size_t)c_ * HD * HD]; nd[j] = np[(size_t)c_ * HD]; } } while (0)
        C2_LOAD(dv, nv, 0);
#pragma unroll
        for (int c0 = 0; c0 < NCH; c0 += 16) {
            if (c0 + 16 < NCH) C2_LOAD(dn, nn, c0 + 16);
#pragma unroll
            for (int j = 0; j < 16; ++j) { const int c = c0 + j; if (c < NCH - 1) { const float a = aL[h * 64 + c]; C = a * C + dv[j]; N = a * N + nv[j];
                cs[(size_t)c * HD * HD] = (bf16_t)f2bf(C); if (tid < 4) ns[(size_t)c * HD] = N; } }
#pragma unroll
            for (int j = 0; j < 16; ++j) { dv[j] = dn[j]; nv[j] = nn[j]; }
        }
#undef C2_LOAD
    }
    __syncthreads();
}
__device__ __forceinline__ void mlstm_c3_unit(char* lds, const bf16_t* P7, const float* BM, const float* IP, const bf16_t* CST, const float* NST, const float* ogain, bf16_t* Y, int h, int c) {
    const int tid = threadIdx.x, wid = __builtin_amdgcn_readfirstlane(tid >> 6), lane = tid & 63, r32 = lane & 31, hi = lane >> 5;
    const int sr = tid >> 4, sc = (tid & 15) * 8, vst0 = v_st(sr, sc), vst1 = vst0 + 8192, kws = KSWZ(sr, sc * 2);
    const unsigned stoff = (unsigned)(sr * DH + sc) * 2u, qoff = (unsigned)(r32 * DH + hi * 8) * 2u;
    char* V_lds = lds; char* K_lds = lds + 2 * SHM_V;
    float* ws = (float*)(lds + OFF_WS) + wid * 64; float* li_l = ws, * al_l = ws + 32;
    float* colb = (float*)(lds + OFF_BIAS); float* nprev = colb + 256;
    const int vb0 = (int)(uintptr_t)V_lds + v_rd_base(lane);
    const bf16_t* Qh = P7 + (size_t)(24 + h) * T * DH; const bf16_t* Kh = P7 + (size_t)(32 + h) * T * DH; const bf16_t* Vh = P7 + (size_t)(40 + h) * T * DH; const bf16_t* Mh = P7 + (size_t)(48 + h) * T * DH;
    const float* bm = BM + (size_t)h * T; const float* ip = IP + (size_t)h * T;
    const int t0 = c * MCH; const float bmref = c ? bm[t0 - 1] : 0.f;
    bf16x8 qr[8];
    { const bf16_t* qb_ = Qh + (size_t)(t0 + wid * QBLK) * DH;
#pragma unroll
      for (int d0 = 0; d0 < 8; ++d0) qr[d0] = *(const bf16x8*)((const char*)qb_ + qoff + d0 * 32); }
    const float rowb = (bm[t0 + wid * QBLK + r32] - bmref) * LOG2E;
    if (tid < 256) colb[tid] = (bmref - bm[t0 + tid] + ip[t0 + tid]) * LOG2E;
    else if (tid < 384 && c) nprev[tid - 256] = NST[(size_t)(h * NCH + c - 1) * HD + (tid - 256)];
    f32x16 o[4] = {}; float den = 0.f;
    bf16x8 nv0, nv1, nk0, nk1;
#define C3_LOADKV(j_) do { const int k0_ = t0 + (j_) * KVBLK; const char* vb_ = (const char*)(Vh + (size_t)k0_ * DH); const char* kb_ = (const char*)(Kh + (size_t)k0_ * DH); \
        nv0 = *(const bf16x8*)(vb_ + stoff); nv1 = *(const bf16x8*)(vb_ + stoff + 32 * DH * 2); nk0 = *(const bf16x8*)(kb_ + stoff); nk1 = *(const bf16x8*)(kb_ + stoff + 32 * DH * 2); } while (0)
    if (c) {
        const char* Cp = (const char*)(CST + (size_t)(h * NCH + c - 1) * HD * HD);
        nv0 = *(const bf16x8*)(Cp + stoff); nv1 = *(const bf16x8*)(Cp + stoff + 32 * DH * 2);
#pragma unroll
        for (int hf = 0; hf < 2; ++hf) {
            const bf16x8 v0 = nv0, v1 = nv1;
            __syncthreads();
            *(bf16x8*)(V_lds + vst0) = v0; *(bf16x8*)(V_lds + vst1) = v1;
            __syncthreads();
            if (hf == 0) { nv0 = *(const bf16x8*)(Cp + 64 * DH * 2 + stoff); nv1 = *(const bf16x8*)(Cp + 64 * DH * 2 + stoff + 32 * DH * 2); } else C3_LOADKV(0);
            if (hf == 0) pv_tile<0>(o, vb0, qr[0], qr[1], qr[2], qr[3]); else pv_tile<0>(o, vb0, qr[4], qr[5], qr[6], qr[7]);
        }
        float dn = 0.f;
#pragma unroll
        for (int d0 = 0; d0 < 8; ++d0) { const u32x4 u = *reinterpret_cast<const u32x4*>(&qr[d0]); const float* np_ = nprev + d0 * 16 + hi * 8;
#pragma unroll
            for (int j = 0; j < 4; ++j) dn += __uint_as_float(u[j] << 16) * np_[2 * j] + __uint_as_float(u[j] & 0xffff0000u) * np_[2 * j + 1]; }
        { auto rr = __builtin_amdgcn_permlane32_swap(__float_as_uint(dn), __float_as_uint(dn), false, false); dn = __uint_as_float(rr[0]) + __uint_as_float(rr[1]); }
        const float rs = __builtin_amdgcn_exp2f(rowb); den = rs * dn;
        if (hi == 0) al_l[r32] = rs; asm volatile("s_waitcnt lgkmcnt(0)" ::: "memory");
        for (int d_ = 0; d_ < 4; ++d_) for (int r = 0; r < 16; ++r) o[d_][r] *= al_l[crow(r, hi)];
    } else C3_LOADKV(0);
    const int qrel = wid * QBLK + r32;
    for (int j = 0; j < 4; ++j) {
        const bf16x8 v0 = nv0, v1 = nv1, kk0 = nk0, kk1 = nk1;
        __syncthreads();
        *(bf16x8*)(V_lds + vst0) = v0; *(bf16x8*)(V_lds + vst1) = v1; *(bf16x8*)(K_lds + kws) = kk0; *(bf16x8*)(K_lds + kws + 32 * 256) = kk1;
        __syncthreads();
        { const int jn = j < 3 ? j + 1 : 3; C3_LOADKV(jn); }
        if (j * KVBLK <= wid * QBLK + QBLK - 1) {
            f32x16 p0, p1; qkt<0>(p0, p1, K_lds, r32, hi, qr);
            const float* bt = colb + j * KVBLK;
#pragma unroll
            for (int g = 0; g < 4; ++g) { const f32x4 b0 = *(const f32x4*)(bt + 8 * g + 4 * hi), b1 = *(const f32x4*)(bt + 32 + 8 * g + 4 * hi);
#pragma unroll
                for (int jj = 0; jj < 4; ++jj) { const int r = 4 * g + jj, kk = j * KVBLK + jj + 8 * g + 4 * hi;
                    const float a0 = p0[r] * QK_SCALE * __builtin_amdgcn_exp2f(rowb + b0[jj]), a1 = p1[r] * QK_SCALE * __builtin_amdgcn_exp2f(rowb + b1[jj]);
                    p0[r] = kk <= qrel ? a0 : 0.f; p1[r] = kk + 32 <= qrel ? a1 : 0.f; } }
            float ps = 0.f; for (int r = 0; r < 16; ++r) ps += p0[r]; for (int r = 0; r < 16; ++r) ps += p1[r];
            { auto rr = __builtin_amdgcn_permlane32_swap(__float_as_uint(ps), __float_as_uint(ps), false, false); ps = __uint_as_float(rr[0]) + __uint_as_float(rr[1]); }
            den += ps;
            bf16x8 pa0, pa1, pa2, pa3;
#define PK4(P, B_, OUT) do { unsigned a0_ = cvtpk(P[B_+0], P[B_+1]), a1_ = cvtpk(P[B_+2], P[B_+3]); unsigned b0_ = cvtpk(P[B_+4], P[B_+5]), b1_ = cvtpk(P[B_+6], P[B_+7]); \
        auto r0_ = __builtin_amdgcn_permlane32_swap(a0_, b0_, false, false); auto r1_ = __builtin_amdgcn_permlane32_swap(a1_, b1_, false, false); \
        u32x4 w_ = {r0_[0], r1_[0], r0_[1], r1_[1]}; OUT = *reinterpret_cast<bf16x8*>(&w_); } while (0)
            PK4(p0, 0, pa0); PK4(p0, 8, pa1); PK4(p1, 0, pa2); PK4(p1, 8, pa3);
#undef PK4
            pv_tile<0>(o, vb0, pa0, pa1, pa2, pa3);
        }
    }
#undef C3_LOADKV
    if (hi == 0) li_l[r32] = 1.0f / fmaxf(fabsf(den), 1.0f); asm volatile("s_waitcnt lgkmcnt(0)" ::: "memory");
    bf16_t* Ow = Y + (size_t)(t0 + wid * QBLK) * D + 1024 + h * DH; const unsigned ooff = (unsigned)(4 * hi * D + r32) * 2u;
    const bf16_t* Mw = Mh + (size_t)(t0 + wid * QBLK) * DH; const unsigned moff = (unsigned)(4 * hi * DH + r32) * 2u;
    float gn[4];
#pragma unroll
    for (int d0 = 0; d0 < 4; ++d0) gn[d0] = ogain[h * DH + d0 * 32 + r32];
    bf16_t mov[16][4];
#pragma unroll
    for (int r = 0; r < 16; ++r) { const int orow0 = (r & 3) + 8 * (r >> 2);
#pragma unroll
        for (int d0 = 0; d0 < 4; ++d0) mov[r][d0] = *(const bf16_t*)((const char*)(Mw + (size_t)orow0 * DH + d0 * 32) + moff); }
#pragma unroll
    for (int r = 0; r < 16; ++r) { const int orow0 = (r & 3) + 8 * (r >> 2); const float rl = li_l[crow(r, hi)];
        float hv[4], ss = 0.f;
#pragma unroll
        for (int d0 = 0; d0 < 4; ++d0) { hv[d0] = o[d0][r] * rl; ss += hv[d0] * hv[d0]; }
#pragma unroll
        for (int m = 1; m < 32; m <<= 1) ss += __shfl_xor(ss, m);
        const float rstd = 1.0f / sqrtf(ss * (1.0f / DH) + RMS_EPS);
#pragma unroll
        for (int d0 = 0; d0 < 4; ++d0) { const float mo = bf2f(mov[r][d0]);
            const float v = hv[d0] * rstd * gn[d0] * (1.0f / (1.0f + __expf(-mo))); const float vn = __shfl_xor(v, 1);
            if ((r32 & 1) == 0) *(unsigned*)((char*)(Ow + (size_t)orow0 * D + d0 * 32) + ooff) = cvtpk(v, vn); } }
    __syncthreads();
}
#undef TRRDB
#undef FRAG8
#undef KSWZ
#undef SBAR
}

constexpr int NWAVES = 8, NTHREADS = 512;
constexpr int LDS_STAGE = 0, LDS_TILEE = 131072, LDS_TSTART = LDS_TILEE + 4 * MAXTILES, LDS_CNT = LDS_TSTART + 4 * 64, LDS_TILES = LDS_CNT + 4 * 32, LDS_ROWOFF = 133120, LDS_ROWW = LDS_ROWOFF + 8 * 1024, LDS_CTL = LDS_ROWW + 8 * 1024, LDS_ROWW2 = LDS_CTL + 512, LDS_BYTES = LDS_ROWW2 + 8 * 1024;
static_assert(LDS_TILES + 4 * MAXTILES <= LDS_ROWOFF && LDS_BYTES <= 160 * 1024 && at::ATT_LDS <= LDS_CTL, "LDS map");
constexpr int MAXU = 8;
constexpr int CW_BAR = 4096;

#define XB_TMO      128
#define XB_XCNT(j)  (256  + 64 * (j))
#define XB_XSUB(j)  (1280 + 64 * (j))
#define XB_XGEN(j)  (2304 + 64 * (j))
#define XB_TOP      3328
#define XB_TOPGEN   3392
#define XCD_BAR_WORDS 3456
#define XB_SPIN_CAP (1u << 18)
__device__ __forceinline__ unsigned xb_ld(unsigned* p)              { return __hip_atomic_load(p, __ATOMIC_RELAXED, __HIP_MEMORY_SCOPE_AGENT); }
__device__ __forceinline__ unsigned xb_add(unsigned* p, unsigned v) { return __hip_atomic_fetch_add(p, v, __ATOMIC_RELAXED, __HIP_MEMORY_SCOPE_AGENT); }
__device__ __forceinline__ unsigned xb_xcc_id() { return (unsigned)__builtin_amdgcn_s_getreg((3 << 11) | 20) & 0xFu; }
#define XB_SPIN(cond, bar) do { unsigned _sp = 0; while (cond) { __builtin_amdgcn_s_sleep(1); \
    if ((++_sp & 255u) == 0u) { if (xb_ld(&(bar)[XB_TMO])) break; if (_sp > XB_SPIN_CAP) { atomicAdd(&(bar)[XB_TMO], 1u); break; } } } } while (0)
struct XcdBarrier { unsigned* bar; unsigned x; volatile LAS unsigned* st; };
__device__ __forceinline__ XcdBarrier xcd_barrier_post(unsigned* bar, volatile LAS unsigned* st) {
    XcdBarrier b; b.bar = bar; b.x = xb_xcc_id(); b.st = st;
    if (threadIdx.x == 0) (void)xb_add(&bar[XB_XCNT(b.x)], 1u);
    return b;
}
__device__ __forceinline__ void xcd_barrier_complete(unsigned* bar, unsigned x, unsigned& nloc, unsigned& nx) {
    const unsigned G = gridDim.x * gridDim.y * gridDim.z;
    unsigned sum, cnt, mine, sp = 0u;
    for (;;) {
        sum = 0u; cnt = 0u; mine = 0u;
#pragma unroll
        for (unsigned j = 0; j < 16; ++j) { const unsigned c = xb_ld(&bar[XB_XCNT(j)]); sum += c; cnt += (c > 0u) ? 1u : 0u; mine = (j == x) ? c : mine; }
        if (sum == G) break;
        __builtin_amdgcn_s_sleep(1);
        if ((++sp & 255u) == 0u) { if (xb_ld(&bar[XB_TMO])) break; if (sp > XB_SPIN_CAP) { atomicAdd(&bar[XB_TMO], 1u); break; } }
    }
    nloc = mine > 0u ? mine : 1u; nx = cnt > 0u ? cnt : 1u;
}
__device__ __forceinline__ void xcd_barrier(const XcdBarrier& b) {
    asm volatile("s_waitcnt vmcnt(0)" ::: "memory");
    __syncthreads();
    if (threadIdx.x == 0) {
        unsigned* bar = b.bar;
        __builtin_amdgcn_s_waitcnt(0);
        unsigned nloc = b.st[0], nx = b.st[1];
        if (nloc == 0u) { xcd_barrier_complete(bar, b.x, nloc, nx); b.st[0] = nloc; b.st[1] = nx; }
        const unsigned old = xb_add(&bar[XB_XSUB(b.x)], 1u);
        const unsigned gen = old / nloc;
        if (old + 1u == (gen + 1u) * nloc) {
            __builtin_amdgcn_fence(__ATOMIC_RELEASE, "agent");
            asm volatile("s_waitcnt vmcnt(0)" ::: "memory");
            const unsigned og = xb_add(&bar[XB_TOP], 1u);
            const unsigned tg = og / nx;
            if (og + 1u == (tg + 1u) * nx) xb_add(&bar[XB_TOPGEN], 1u);
            else XB_SPIN(xb_ld(&bar[XB_TOPGEN]) == tg, bar);
            __builtin_amdgcn_fence(__ATOMIC_ACQUIRE, "agent");
            xb_add(&bar[XB_XGEN(b.x)], 1u);
            asm volatile("s_waitcnt vmcnt(0)" ::: "memory");
        } else {
            XB_SPIN(xb_ld(&bar[XB_XGEN(b.x)]) == gen, bar);
            __builtin_amdgcn_fence(__ATOMIC_ACQUIRE, "agent");
            asm volatile("s_waitcnt vmcnt(0)" ::: "memory");
        }
    }
    __syncthreads();
}

enum { PH_PREP = 0, PH_NORM0 = 1, PH_INPROJ = 2, PH_QKN_C1 = 3, PH_MC2 = 4, PH_MIX = 5, PH_ACOMB = 6, PH_OUTPROJ = 7,
       PH_ROUTE0 = 8, PH_GU0 = 9, PH_DOWN0 = 10, PH_COMB0 = 11, PH_POOL = 12, PH_POOLG = 13,
       PH_ROUTE1 = 14, PH_GU1 = 15, PH_DOWN1 = 16, PH_COMB1 = 17, PH_END = 18 };
struct MkArgs { const float* in[21]; float* out; unsigned char* ws; int ph_lo, ph_hi, pad0, pad1; };

__device__ __forceinline__ void moe_tables(LAS unsigned char* lds, const unsigned* cnt) {
    LAS int* tileE = (LAS int*)(lds + LDS_TILEE); LAS int* tstart = (LAS int*)(lds + LDS_TSTART); LAS int* cntL = (LAS int*)(lds + LDS_CNT); LAS int* tileS = (LAS int*)(lds + LDS_TILES);
    if (threadIdx.x < 64) {
        const int e = (int)threadIdx.x, ce = e < NEXP ? (int)cnt[e * CNT_STRIDE] : 0, ntl = (ce + 255) >> 8, hf = ((ce & 255) >= 1 && (ce & 255) <= HALF_ROWS) ? 1 : 0, nfu = ntl - hf;
        int inc = ntl, incf = nfu, inch = hf;
#pragma unroll
        for (int o = 1; o < 32; o <<= 1) { const int t = __shfl_up(inc, o), tf = __shfl_up(incf, o), th = __shfl_up(inch, o); inc += e >= o ? t : 0; incf += e >= o ? tf : 0; inch += e >= o ? th : 0; }
        const int st = inc - ntl, fst = incf - nfu, hst = inch - hf, totf = __shfl(incf, NEXP - 1);
        if (e < NEXP) { cntL[e] = ce; tstart[e] = st; for (int j = 0; j < ntl; ++j) tileE[st + j] = e;
            for (int j = 0; j < nfu; ++j) tileS[fst + j] = st + j;
            if (hf) tileS[totf + hst] = (st + ntl - 1) | 0x8000; }
        if (e == NEXP - 1) tstart[NEXP] = inc; }
    __syncthreads();
}
__device__ __forceinline__ void moe_setup(LAS unsigned char* lds, const unsigned* cnt, const int* capt, const float* capw, pg::MoeOrder& S, int G, int c, unsigned lda_bytes, bool seq_rows, const float* tokscale) {
    moe_tables(lds, cnt);
    LAS int* tileE = (LAS int*)(lds + LDS_TILEE); LAS int* tstart = (LAS int*)(lds + LDS_TSTART); LAS int* cntL = (LAS int*)(lds + LDS_CNT);
    LAS unsigned* rowoff = (LAS unsigned*)(lds + LDS_ROWOFF); LAS float* roww = (LAS float*)(lds + LDS_ROWW);
    const int tid = threadIdx.x, r = tid & 255;
    S.nwg = tstart[NEXP] * 8; S.G = G; S.c = c; S.tileE = tileE; S.tileS = (const LAS int*)(lds + LDS_TILES);
    static_assert(MAXU == 8, "four batched steps of two units");
    int idx[4], pmr[4], tok[4]; bool has[4], val[4]; float w[4];
#pragma unroll
    for (int k = 0; k < 4; ++k) { pg::Unit u; u.pm = 0; u.pn = 0; u.ak = 0; has[k] = S.next(2 * k + (tid >> 8), u);
        const int e = has[k] ? (u.pn >> 3) : 0, rank = (u.pm - tstart[e]) * 256 + r; val[k] = has[k] && rank < cntL[e]; idx[k] = val[k] ? e * CAP + rank : 0; pmr[k] = u.pm * 256 + r; }
    float wc[4]; LAS float* roww2 = (LAS float*)(lds + LDS_ROWW2);
#pragma unroll
    for (int k = 0; k < 4; ++k) { tok[k] = capt[idx[k]]; w[k] = capw[idx[k]]; wc[k] = w[k]; }
#pragma unroll
    for (int k = 0; k < 4; ++k) tok[k] = val[k] ? tok[k] : 0;
    if (tokscale) {
#pragma unroll
        for (int k = 0; k < 4; ++k) w[k] = tokscale[tok[k]]; }
#pragma unroll
    for (int k = 0; k < 4; ++k) if (has[k]) { const int s = 2 * k + (tid >> 8);
        rowoff[s * 256 + r] = seq_rows ? (unsigned)pmr[k] * lda_bytes : (unsigned)tok[k] * lda_bytes; roww[s * 256 + r] = val[k] ? w[k] : 0.f; roww2[s * 256 + r] = val[k] ? wc[k] : 0.f; }
    __syncthreads();
}
__device__ __forceinline__ void moe_setup_down(LAS unsigned char* lds, pg::MoeOrder& S, int G, int c, unsigned lda_bytes) {
    LAS int* tileE = (LAS int*)(lds + LDS_TILEE); LAS int* tstart = (LAS int*)(lds + LDS_TSTART); LAS unsigned* rowoff = (LAS unsigned*)(lds + LDS_ROWOFF);
    const int tid = threadIdx.x, r = tid & 255;
    S.nwg = tstart[NEXP] * 8; S.G = G; S.c = c; S.tileE = tileE; S.tileS = (const LAS int*)(lds + LDS_TILES);
#pragma unroll
    for (int k = 0; k < 4; ++k) { pg::Unit u; u.pm = 0; u.pn = 0; u.ak = 0; u.half = 0; const int s_ = 2 * k + (tid >> 8); if (S.next(s_, u)) rowoff[s_ * 256 + r] = (unsigned)(u.pm * 256 + r) * lda_bytes; }
    __syncthreads();
}

typedef const __attribute__((address_space(4))) MkArgs* KArgs;
__device__ __forceinline__ KArgs kargs() { KArgs p = (KArgs)__builtin_amdgcn_kernarg_segment_ptr(); asm volatile("" : "+s"(p)); return p; }
#define WSP(T_, off) ((T_*)(A->ws + (off)))
#define LANE_ ((int)(threadIdx.x & 63))
#define WAVE_ (__builtin_amdgcn_readfirstlane((int)(threadIdx.x >> 6)))
#define GW_ ((int)blockIdx.x * NWAVES + WAVE_)
#define NGW_ ((int)gridDim.x * NWAVES)
#define GRID_BAR() do { KArgs A = kargs(); XcdBarrier b_; b_.bar = WSP(unsigned, WS_CTL) + CW_BAR; b_.x = xb_xcc_id(); b_.st = (volatile LAS unsigned*)(lds + LDS_CTL + 32); xcd_barrier(b_); } while (0)
__global__ void __launch_bounds__(NTHREADS, 2) mk_fwd(MkArgs a_unused) {
    extern __shared__ __attribute__((aligned(16))) unsigned char lds_raw[];
    LAS unsigned char* lds = (LAS unsigned char*)lds_raw;
    if (threadIdx.x < 128) ((LAS unsigned*)(lds + LDS_CTL))[threadIdx.x] = 0u;
    __syncthreads();
    { KArgs A = kargs(); (void)xcd_barrier_post(WSP(unsigned, WS_CTL) + CW_BAR, (volatile LAS unsigned*)(lds + LDS_CTL + 32)); }
#define IN(k) (kargs()->ph_lo <= (k) && (k) < kargs()->ph_hi)
#define SEAM(k) do { if (IN(k) && IN((k) + 1)) GRID_BAR(); } while (0)

    if (IN(PH_PREP)) { KArgs A = kargs();
        PrepArgs pa; pa.w_in = A->in[3]; pa.w_out = A->in[10]; pa.pool_w = A->in[11]; pa.w_gate = A->in[18]; pa.w_up = A->in[19]; pa.w_down = A->in[20]; pa.rgw = A->in[14]; pa.rew = A->in[16]; pa.ws = A->ws;
        float* WG = WSP(float, WS_WG); float* WR = WSP(float, WS_WR);
        const int gt = (int)blockIdx.x * NTHREADS + (int)threadIdx.x, ngt = (int)gridDim.x * NTHREADS;
#pragma unroll 1
        for (int i = gt; i < NGATE * D; i += ngt) { const int c = i / D, k = i % D; const int col = c < 8 ? 3072 + c : 6152 + (c - 8); WG[i] = pa.w_in[(size_t)k * INC + col]; }
#pragma unroll 1
        for (int i = gt; i < 2 * NROUTE * D; i += ngt) { const int l = i / (NROUTE * D), r = i % (NROUTE * D), c = r / D, k = r % D;
            WR[i] = c < 4 ? pa.rgw[((size_t)l * D + k) * NGRP + c] : pa.rew[((size_t)l * D + k) * NEXP + (c - 4)]; }
        LAS float* scr = (LAS float*)(lds + WAVE_ * 16896); const int ngw = NGW_;
        prep_loop(pa, GW_, ngw, scr, LANE_);
    }
    SEAM(PH_PREP);
    if (IN(PH_NORM0)) { KArgs A = kargs();
        NormProjArgs P{}; P.x = A->in[0]; P.g = A->in[1]; P.Wc = WSP(const float, WS_WG); P.hn = WSP(bf16_t, WS_HN); P.hn8 = WSP(unsigned char, WS_HN8); P.rstd = WSP(float, WS_RSTD0); P.gates = WSP(float, WS_GATES); P.cf = WSP(float, WS_CF); P.bm = WSP(float, WS_BM); P.ip = WSP(float, WS_IP); P.fox_fb = A->in[4]; P.m_ib = A->in[7]; P.m_fb = A->in[8];
#pragma unroll 1
        for (int rb = blockIdx.x; rb < T / 64; rb += gridDim.x) norm_proj_block2<NGATE, 0>(lds, P, rb);
    }
    SEAM(PH_NORM0);
    if (IN(PH_INPROJ)) { KArgs A = kargs();
        if (blockIdx.x == gridDim.x - 1) at::attn_plan((char*)lds_raw, WSP(const float, WS_GATES), A->in[5], A->in[6], WSP(unsigned, WS_AQORD), WSP(unsigned, WS_AQORD2), WSP(unsigned, WS_AQCOMB));
#pragma unroll 1
        for (int rb = blockIdx.x; rb < T / 64; rb += gridDim.x) gates_fixup(WSP(const float, WS_GATES), WSP(float, WS_CF), WSP(float, WS_BM), rb, (LAS float*)lds);
        { pg::Gemm g{WSP(const bf16_t, WS_HN), WSP(const bf16_t, WS_WINP), D, D, D}; pg::StaticOrder S; S.init(T, NP16, (int)gridDim.x, (int)blockIdx.x);
          pg::EpiP7<0> E{WSP(bf16_t, WS_P7), A->in[5], A->in[6], (LAS float*)(lds + 131072), WSP(const float, WS_RSTD0)};
          pg::gemm_phase<pg::EpiP7<0>, pg::StaticOrder, false>(lds + LDS_STAGE, g, S, E, nullptr, nullptr); }
        { pg::StaticOrder S; S.init(T, NP8, (int)gridDim.x, (int)blockIdx.x);
          LAS unsigned* rowoff = (LAS unsigned*)(lds + LDS_ROWOFF);
          for (int s0 = 0; s0 < MAXU; s0 += 2) { const int s_ = s0 + ((int)threadIdx.x >> 8), r_ = (int)threadIdx.x & 255; pg::Unit u_; if (S.next(s_, u_)) rowoff[s_ * 256 + r_] = (unsigned)(u_.pm * 256 + r_) * (unsigned)D; }
          __syncthreads();
          pg::Gemm g{WSP(const bf16_t, WS_HN8), WSP(const bf16_t, WS_WINP8), D / 2, D / 2, D / 2};
          pg::EpiP7<1> E{WSP(bf16_t, WS_P7), A->in[5], A->in[6], (LAS float*)(lds + 131072), WSP(const float, WS_RSTD0)};
          pg::gemm_phase<pg::EpiP7<1>, pg::StaticOrder, true, true>(lds + LDS_STAGE, g, S, E, (const LAS unsigned*)(lds + LDS_ROWOFF), nullptr); }
    }
    SEAM(PH_INPROJ);
    if (IN(PH_QKN_C1)) { KArgs A = kargs();
#pragma unroll 1
        for (int u = blockIdx.x; u < NH * at::NCH; u += gridDim.x) at::mlstm_c1_unit((char*)lds_raw, WSP(const bf16_t, WS_P7), WSP(const float, WS_BM), WSP(const float, WS_IP), WSP(float, WS_DC), WSP(float, WS_ND), u / at::NCH, u % at::NCH);
    }
    SEAM(PH_QKN_C1);
    if (IN(PH_MC2)) { KArgs A = kargs(); at::mlstm_c2((char*)lds_raw, WSP(const float, WS_BM), WSP(const float, WS_DC), WSP(const float, WS_ND), WSP(bf16_t, WS_CST), WSP(float, WS_NST), (int)gridDim.x, (int)blockIdx.x); }
    SEAM(PH_MC2);
    if (IN(PH_MIX)) { KArgs A = kargs();
        at::attn_phase((char*)lds_raw, A->ws, WSP(const unsigned, WS_AQORD2), WSP(unsigned, WS_CTL) + CW_AQ, lds);
        { LAS unsigned* bq = (LAS unsigned*)(lds + LDS_CTL + 256);
#pragma unroll 1
          for (;;) { __syncthreads(); if (threadIdx.x == 0) *bq = atomicAdd(WSP(unsigned, WS_CTL) + CW_C3Q, 1u); __syncthreads(); const unsigned u = *bq; if (u >= (unsigned)(NH * at::NCH)) break;
              at::mlstm_c3_unit((char*)lds_raw, WSP(const bf16_t, WS_P7), WSP(const float, WS_BM), WSP(const float, WS_IP), WSP(const bf16_t, WS_CST), WSP(const float, WS_NST), A->in[9], WSP(bf16_t, WS_Y), (int)(u / at::NCH), (int)(u % at::NCH)); } }
    }
    SEAM(PH_MIX);
    if (IN(PH_ACOMB)) { KArgs A = kargs(); at::attn_combine(WSP(const unsigned, WS_AQCOMB), WSP(const float, WS_PO), WSP(const float, WS_PM), WSP(const float, WS_PL), WSP(bf16_t, WS_Y), GW_, NGW_, LANE_); }
    SEAM(PH_ACOMB);
    if (IN(PH_OUTPROJ)) { KArgs A = kargs();
        pg::Gemm g{WSP(const bf16_t, WS_Y), WSP(const bf16_t, WS_WOUT), D, D, D}; pg::StaticOrder S; S.init(T, D, (int)gridDim.x, (int)blockIdx.x);
        pg::EpiRes<false, true> E{A->in[0], WSP(bf16_t, WS_XB), D, nullptr, nullptr};
        pg::gemm_phase<pg::EpiRes<false, true>, pg::StaticOrder, false>(lds + LDS_STAGE, g, S, E, nullptr, nullptr);
    }
    SEAM(PH_OUTPROJ);
    {
        constexpr int l = 0; constexpr int pb = l ? PH_ROUTE1 : PH_ROUTE0;
        if (l == 1) {
            if (IN(PH_POOL)) { KArgs A = kargs();
#pragma unroll 1
                for (int ch = blockIdx.x; ch < T / 64; ch += gridDim.x) pool_chunk(WSP(const bf16_t, WS_XB), WSP(const float, WS_RSTD0), A->in[1] + D, WSP(bf16_t, WS_POOLED), ch * 64, (LAS float*)lds); }
            SEAM(PH_POOL);
            if (IN(PH_POOLG)) { KArgs A = kargs();
                pg::Gemm g{WSP(const bf16_t, WS_POOLED), WSP(const bf16_t, WS_WPOOL), D, 512, 512}; pg::StaticOrder S; S.init(T, D, (int)gridDim.x, (int)blockIdx.x, 2);
                pg::EpiRes<true, true> E{WSP(const bf16_t, WS_XB), WSP(bf16_t, WS_XB), D, A->in[12], A->in[13]};
                pg::gemm_phase<pg::EpiRes<true, true>, pg::StaticOrder, false>(lds + LDS_STAGE, g, S, E, nullptr, nullptr);
            }
            SEAM(PH_POOLG);
        }
        if (IN(pb)) { KArgs A = kargs();
            NormProjArgs P{}; P.xb = WSP(const bf16_t, WS_XB); P.g = A->in[2] + (size_t)l * D; P.Wc = WSP(const float, WS_WR) + (size_t)l * NROUTE * D; P.hn = WSP(bf16_t, WS_HN); P.rstd = WSP(float, WS_RSTD);
            P.gb = A->in[15] + l * NGRP; P.eb = A->in[17] + l * NEXP; P.cnt = WSP(unsigned, WS_CTL) + CW_CNT + CNT_LSTRIDE * l; P.asg_e = WSP(int, WS_ASGE); P.asg_r = WSP(int, WS_ASGR); P.capt = WSP(int, WS_CAPT); P.capw = WSP(float, WS_CAPW);
#pragma unroll 1
            for (int rb = blockIdx.x; rb < T / 64; rb += gridDim.x) norm_proj_block2<NROUTE, 1>(lds, P, rb);
        }
        SEAM(pb);
        if (IN(pb + 1)) { KArgs A = kargs();
            pg::MoeOrder S; moe_setup(lds, WSP(const unsigned, WS_CTL) + CW_CNT + CNT_LSTRIDE * l, WSP(const int, WS_CAPT), WSP(const float, WS_CAPW), S, (int)gridDim.x, (int)blockIdx.x, (unsigned)D, false, WSP(const float, WS_RSTD));
            pg::Gemm g{WSP(const bf16_t, WS_HN), (const bf16_t*)(WSP(const unsigned char, WS_WGU) + (size_t)l * NEXP * 2048 * D), D / 2, D / 2, D / 2};
            pg::EpiSilu E{WSP(unsigned char, WS_H)};
            pg::gemm_phase<pg::EpiSilu, pg::MoeOrder, true, true>(lds + LDS_STAGE, g, S, E, (const LAS unsigned*)(lds + LDS_ROWOFF), (const LAS float*)(lds + LDS_ROWW));
        }
        SEAM(pb + 1);
        int cmb_pre = -1;
        if (IN(pb + 2)) { KArgs A = kargs();
            pg::MoeOrder S; moe_setup_down(lds, S, (int)gridDim.x, (int)blockIdx.x, (unsigned)DEXP);
            pg::Gemm g{WSP(const bf16_t, WS_H), (const bf16_t*)(WSP(const unsigned char, WS_WD) + (size_t)l * NEXP * D * DEXP), DEXP / 2, DEXP / 2, DEXP / 2};
            pg::EpiDown E{WSP(unsigned char, WS_YS)};
            pg::gemm_phase<pg::EpiDown, pg::MoeOrder, true, true>(lds + LDS_STAGE, g, S, E, (const LAS unsigned*)(lds + LDS_ROWOFF), (const LAS float*)(lds + LDS_ROWW2));
            { const int r8_ = GW_, ln_ = LANE_; cmb_pre = 0;
              if (r8_ < T / 8 && ln_ < 16) { const int e_ = WSP(const int, WS_ASGE)[r8_ * 16 + ln_], rr_ = WSP(const int, WS_ASGR)[r8_ * 16 + ln_]; cmb_pre = ((const LAS int*)(lds + LDS_TSTART))[e_] * 256 + rr_; } }
        }
        SEAM(pb + 2);
        if (IN(pb + 3)) { KArgs A = kargs();
            const LAS int* tstart = (const LAS int*)(lds + LDS_TSTART); const int ngw = NGW_, lane = LANE_;
#pragma unroll 1
            for (int r8 = GW_; r8 < T / 8; r8 += ngw) {
                if (l == 0) combine_rows8<true>(WSP(bf16_t, WS_XB), nullptr, WSP(const unsigned char, WS_YS), WSP(const int, WS_ASGE), WSP(const int, WS_ASGR), tstart, WSP(float, WS_RSTD0), r8 * 8, lane, r8 == GW_ ? cmb_pre : -1);
                else combine_rows8<false>(WSP(bf16_t, WS_XB), A->out, WSP(const unsigned char, WS_YS), WSP(const int, WS_ASGE), WSP(const int, WS_ASGR), tstart, nullptr, r8 * 8, lane, r8 == GW_ ? cmb_pre : -1); }
        }
        SEAM(pb + 3);
        }
    {
        constexpr int l = 1; constexpr int pb = l ? PH_ROUTE1 : PH_ROUTE0;
        if (l == 1) {
            if (IN(PH_POOL)) { KArgs A = kargs();
#pragma unroll 1
                for (int ch = blockIdx.x; ch < T / 64; ch += gridDim.x) pool_chunk(WSP(const bf16_t, WS_XB), WSP(const float, WS_RSTD0), A->in[1] + D, WSP(bf16_t, WS_POOLED), ch * 64, (LAS float*)lds); }
            SEAM(PH_POOL);
            if (IN(PH_POOLG)) { KArgs A = kargs();
                pg::Gemm g{WSP(const bf16_t, WS_POOLED), WSP(const bf16_t, WS_WPOOL), D, 512, 512}; pg::StaticOrder S; S.init(T, D, (int)gridDim.x, (int)blockIdx.x, 2);
                pg::EpiRes<true, true> E{WSP(const bf16_t, WS_XB), WSP(bf16_t, WS_XB), D, A->in[12], A->in[13]};
                pg::gemm_phase<pg::EpiRes<true, true>, pg::StaticOrder, false>(lds + LDS_STAGE, g, S, E, nullptr, nullptr);
            }
            SEAM(PH_POOLG);
        }
        if (IN(pb)) { KArgs A = kargs();
            NormProjArgs P{}; P.xb = WSP(const bf16_t, WS_XB); P.g = A->in[2] + (size_t)l * D; P.Wc = WSP(const float, WS_WR) + (size_t)l * NROUTE * D; P.hn = WSP(bf16_t, WS_HN); P.rstd = WSP(float, WS_RSTD);
            P.gb = A->in[15] + l * NGRP; P.eb = A->in[17] + l * NEXP; P.cnt = WSP(unsigned, WS_CTL) + CW_CNT + CNT_LSTRIDE * l; P.asg_e = WSP(int, WS_ASGE); P.asg_r = WSP(int, WS_ASGR); P.capt = WSP(int, WS_CAPT); P.capw = WSP(float, WS_CAPW);
#pragma unroll 1
            for (int rb = blockIdx.x; rb < T / 64; rb += gridDim.x) norm_proj_block2<NROUTE, 1>(lds, P, rb);
        }
        SEAM(pb);
        if (IN(pb + 1)) { KArgs A = kargs();
            pg::MoeOrder S; moe_setup(lds, WSP(const unsigned, WS_CTL) + CW_CNT + CNT_LSTRIDE * l, WSP(const int, WS_CAPT), WSP(const float, WS_CAPW), S, (int)gridDim.x, (int)blockIdx.x, (unsigned)D, false, WSP(const float, WS_RSTD));
            pg::Gemm g{WSP(const bf16_t, WS_HN), (const bf16_t*)(WSP(const unsigned char, WS_WGU) + (size_t)l * NEXP * 2048 * D), D / 2, D / 2, D / 2};
            pg::EpiSilu E{WSP(unsigned char, WS_H)};
            pg::gemm_phase<pg::EpiSilu, pg::MoeOrder, true, true>(lds + LDS_STAGE, g, S, E, (const LAS unsigned*)(lds + LDS_ROWOFF), (const LAS float*)(lds + LDS_ROWW));
        }
        SEAM(pb + 1);
        int cmb_pre = -1;
        if (IN(pb + 2)) { KArgs A = kargs();
            pg::MoeOrder S; moe_setup_down(lds, S, (int)gridDim.x, (int)blockIdx.x, (unsigned)DEXP);
            pg::Gemm g{WSP(const bf16_t, WS_H), (const bf16_t*)(WSP(const unsigned char, WS_WD) + (size_t)l * NEXP * D * DEXP), DEXP / 2, DEXP / 2, DEXP / 2};
            pg::EpiDown E{WSP(unsigned char, WS_YS)};
            pg::gemm_phase<pg::EpiDown, pg::MoeOrder, true, true>(lds + LDS_STAGE, g, S, E, (const LAS unsigned*)(lds + LDS_ROWOFF), (const LAS float*)(lds + LDS_ROWW2));
            { const int r8_ = GW_, ln_ = LANE_; cmb_pre = 0;
              if (r8_ < T / 8 && ln_ < 16) { const int e_ = WSP(const int, WS_ASGE)[r8_ * 16 + ln_], rr_ = WSP(const int, WS_ASGR)[r8_ * 16 + ln_]; cmb_pre = ((const LAS int*)(lds + LDS_TSTART))[e_] * 256 + rr_; } }
        }
        SEAM(pb + 2);
        if (IN(pb + 3)) { KArgs A = kargs();
            const LAS int* tstart = (const LAS int*)(lds + LDS_TSTART); const int ngw = NGW_, lane = LANE_;
#pragma unroll 1
            for (int r8 = GW_; r8 < T / 8; r8 += ngw) {
                if (l == 0) combine_rows8<true>(WSP(bf16_t, WS_XB), nullptr, WSP(const unsigned char, WS_YS), WSP(const int, WS_ASGE), WSP(const int, WS_ASGR), tstart, WSP(float, WS_RSTD0), r8 * 8, lane, r8 == GW_ ? cmb_pre : -1);
                else combine_rows8<false>(WSP(bf16_t, WS_XB), A->out, WSP(const unsigned char, WS_YS), WSP(const int, WS_ASGE), WSP(const int, WS_ASGR), tstart, nullptr, r8 * 8, lane, r8 == GW_ ? cmb_pre : -1); }
        }
        SEAM(pb + 3);
        }
#undef IN
#undef SEAM
}

extern "C" void kernel_launch(void* const* d_in, const int* in_sizes, int n_in, void* d_out, int out_size, void* d_ws, size_t ws_size, hipStream_t stream) {
    static int grid = 0;
    if (grid == 0) {
        if (n_in != 21 || ws_size < WS_END || out_size != T * D || in_sizes[0] != T * D) { fprintf(stderr, "kernel_launch: unexpected shapes (n_in %d, ws %zu need %zu, out %d)\n", n_in, ws_size, (size_t)WS_END, out_size); grid = -1; return; }
        int dev = 0, cus = 0;
        if (hipGetDevice(&dev) != hipSuccess || hipDeviceGetAttribute(&cus, hipDeviceAttributeMultiprocessorCount, dev) != hipSuccess || cus < 160) { fprintf(stderr, "kernel_launch: device query failed or too few CUs (%d)\n", cus); grid = -1; return; }
        if (hipFuncSetAttribute((const void*)mk_fwd, hipFuncAttributeMaxDynamicSharedMemorySize, LDS_BYTES) != hipSuccess) { fprintf(stderr, "kernel_launch: hipFuncSetAttribute failed\n"); grid = -1; return; }
        int per_cu = 0;
        if (hipOccupancyMaxActiveBlocksPerMultiprocessor(&per_cu, (const void*)mk_fwd, NTHREADS, LDS_BYTES) != hipSuccess || per_cu < 1) fprintf(stderr, "kernel_launch: note: occupancy query reports %d workgroups per CU\n", per_cu);
        (void)hipGetLastError();
        grid = cus;
    }
    if (grid < 0) return;
    if (hipMemsetAsync((char*)d_ws + WS_CTL, 0, CTL_BYTES, stream) != hipSuccess) { fprintf(stderr, "kernel_launch: memset failed\n"); return; }
    MkArgs ma{}; for (int i = 0; i < 21; ++i) ma.in[i] = (const float*)d_in[i]; ma.out = (float*)d_out; ma.ws = (unsigned char*)d_ws;
#if MK_CUTS
    for (int p = 0; p < PH_END; ++p) { ma.ph_lo = p; ma.ph_hi = p + 1; hipLaunchKernelGGL(mk_fwd, dim3(grid), dim3(NTHREADS), LDS_BYTES, stream, ma); }
#else
    ma.ph_lo = 0; ma.ph_hi = PH_END;
    hipLaunchKernelGGL(mk_fwd, dim3(grid), dim3(NTHREADS), LDS_BYTES, stream, ma);
#endif
    const hipError_t le = hipPeekAtLastError();
    if (le != hipSuccess) fprintf(stderr, "kernel_launch: launch failed: %s\n", hipGetErrorName(le));
}
```
